# Optimizing an MI355X kernel written in HIP

```python
import math
import jax, jax.numpy as jnp
from jax import lax
import numpy as np

D_MODEL = 1024
BATCH = 4
SEQ = 8192
DEPTH = 2

N_EVEN = (DEPTH + 1) // 2
N_ODD = DEPTH // 2
D_FF = 2816
EPS = 1e-6
ROPE_THETA = 500000.0
HEAD_DIM = 64
ROT_DIM = HEAD_DIM // 4
Q_BLOCK = 128
NEG = -1e30
BIG = 1e30

LRU_WIDTH = D_MODEL // 2
LRU_BLOCKS = 8
LRU_BLOCK_DIM = LRU_WIDTH // LRU_BLOCKS
CONV_WIDTH = 4
LRU_C = 8.0
MOBA_HEADS = (D_MODEL // 2) // HEAD_DIM
MOBA_WIDTH = MOBA_HEADS * HEAD_DIM
MOBA_BLOCK = 256
MOBA_TOPK = 3
IN0_WIDTH = 2 * LRU_WIDTH + 3 * MOBA_WIDTH
MIX0_WIDTH = LRU_WIDTH + MOBA_WIDTH

NSA_HEADS = D_MODEL // HEAD_DIM
NSA_KV_GROUPS = 2
NSA_HPG = NSA_HEADS // NSA_KV_GROUPS
CMP_LEN = 32
CMP_STRIDE = 16
SEL_BLOCK = 64
SEL_TOPK = 16
WINDOW = 512
CMP_HIDDEN = 128
NSA_QD = NSA_HEADS * HEAD_DIM
NSA_KVD = NSA_KV_GROUPS * HEAD_DIM
IN1_WIDTH = NSA_QD + 6 * NSA_KVD + 3 * NSA_HEADS
MIX1_WIDTH = NSA_QD

kernel_name = "hybrid_lru_moba_nsa_macaron_adaln"


def rmsnorm(x, g):
    xf = x.astype(jnp.float32)
    y = xf * lax.rsqrt(jnp.mean(xf * xf, axis=-1, keepdims=True) + EPS)
    return (y * g.astype(jnp.float32)).astype(x.dtype)


def modulate(h, shift, scale):
    return h * (1.0 + scale[:, None, :]) + shift[:, None, :]


def swiglu(h, w1, w2):
    a, b = jnp.split(h @ w1, 2, axis=-1)
    return (jax.nn.silu(a) * b) @ w2


def rope_partial(x, pos):
    half = ROT_DIM // 2
    freqs = ROPE_THETA ** (-jnp.arange(half, dtype=jnp.float32) * 2.0 / ROT_DIM)
    ang = pos[:, None] * freqs[None, :]
    cos = jnp.cos(ang).astype(x.dtype)
    sin = jnp.sin(ang).astype(x.dtype)
    x1 = x[..., :half]
    x2 = x[..., half:ROT_DIM]
    return jnp.concatenate([x1 * cos - x2 * sin, x2 * cos + x1 * sin, x[..., ROT_DIM:]], axis=-1)


def masked_softmax(logits, mask):
    p = jax.nn.softmax(jnp.where(mask, logits, NEG), axis=-1)
    return jnp.where(mask, p, 0.0)


def causal_depthwise_conv(x, w, b):
    y = lax.conv_general_dilated(x, w[:, None, :], window_strides=(1,),
                                 padding=((CONV_WIDTH - 1, 0),),
                                 dimension_numbers=('NWC', 'WIO', 'NWC'),
                                 feature_group_count=x.shape[-1])
    return y + b


def rg_lru(x, wa, ba, wx, bx, lam):
    B, S, C = x.shape
    xb = x.reshape(B, S, LRU_BLOCKS, LRU_BLOCK_DIM)
    r = jax.nn.sigmoid(jnp.einsum('bsni,nij->bsnj', xb, wa) + ba).reshape(B, S, C)
    i = jax.nn.sigmoid(jnp.einsum('bsni,nij->bsnj', xb, wx) + bx).reshape(B, S, C)
    log_a = -LRU_C * r.astype(jnp.float32) * jax.nn.softplus(-lam.astype(jnp.float32))
    a = jnp.exp(log_a)
    mult = jnp.sqrt(-jnp.expm1(2.0 * log_a))
    bterm = mult * (i * x).astype(jnp.float32)

    def combine(left, right):
        a_l, b_l = left
        a_r, b_r = right
        return a_l * a_r, a_r * b_l + b_r

    _, h = lax.associative_scan(combine, (a, bterm), axis=1)
    return h.astype(x.dtype)


def moba_attention(q, k, v):
    B, H, S, dh = q.shape
    scale = dh ** -0.5
    nb = -(-S // MOBA_BLOCK)
    pad = nb * MOBA_BLOCK - S
    kp = jnp.pad(k, ((0, 0), (0, 0), (0, pad), (0, 0))).reshape(B, H, nb, MOBA_BLOCK, dh)
    vp = jnp.pad(v, ((0, 0), (0, 0), (0, pad), (0, 0))).reshape(B, H, nb, MOBA_BLOCK, dh)
    centroid = jnp.mean(kp.astype(jnp.float32), axis=3)
    t = jnp.arange(S)
    qblk = t // MOBA_BLOCK
    gate = jnp.einsum('bhsd,bhnd->bhsn', q.astype(jnp.float32), centroid)
    past = jnp.arange(nb)[None, :] < qblk[:, None]
    gate = jnp.where(past, gate, -jnp.inf)
    _, top_idx = lax.top_k(gate, min(MOBA_TOPK, nb))
    own = jnp.broadcast_to(qblk[:, None], (B, H, S, 1)).astype(top_idx.dtype)
    sel_idx = jnp.concatenate([top_idx, own], axis=-1)
    sel_valid = jnp.concatenate([top_idx < qblk[:, None], jnp.ones((B, H, S, 1), bool)], axis=-1)

    nq = S // Q_BLOCK

    def to_blocks(a):
        return jnp.moveaxis(a.reshape(B, H, nq, Q_BLOCK, *a.shape[3:]), 2, 0)

    b_ix = jnp.arange(B)[:, None, None, None]
    h_ix = jnp.arange(H)[None, :, None, None]
    offs = jnp.arange(MOBA_BLOCK)

    def step(args):
        qb, idx, valid, t0 = args
        kg = kp[b_ix, h_ix, idx]
        vg = vp[b_ix, h_ix, idx]
        s = jnp.einsum('bhqd,bhqnkd->bhqnk', qb, kg).astype(jnp.float32) * scale
        tq = t0 + jnp.arange(Q_BLOCK)
        kpos = idx[..., None] * MOBA_BLOCK + offs
        mask = valid[..., None] & (kpos <= tq[:, None, None])
        p = masked_softmax(s.reshape(B, H, Q_BLOCK, -1), mask.reshape(B, H, Q_BLOCK, -1)).reshape(s.shape)
        return jnp.einsum('bhqnk,bhqnkd->bhqd', p.astype(v.dtype), vg)

    out = lax.map(step, (to_blocks(q), to_blocks(sel_idx), to_blocks(sel_valid), jnp.arange(nq) * Q_BLOCK))
    return jnp.moveaxis(out, 0, 2).reshape(B, H, S, dh)


def mixer_lru_moba(h, in_w, conv_w, conv_b, wa, ba, wx, bx, lam, out_w, pos):
    B, S, _ = h.shape
    u = h @ in_w
    o1 = LRU_WIDTH
    o2 = 2 * LRU_WIDTH
    x_lru, g_lru, q, k, v = jnp.split(u, [o1, o2, o2 + MOBA_WIDTH, o2 + 2 * MOBA_WIDTH], axis=-1)
    xc = causal_depthwise_conv(x_lru, conv_w, conv_b)
    y_lru = rg_lru(xc, wa, ba, wx, bx, lam) * jax.nn.gelu(g_lru)

    def heads(a):
        return a.reshape(B, S, MOBA_HEADS, HEAD_DIM).transpose(0, 2, 1, 3)

    q = rope_partial(heads(q), pos)
    k = rope_partial(heads(k), pos)
    y_att = moba_attention(q, k, heads(v)).transpose(0, 2, 1, 3).reshape(B, S, MOBA_WIDTH)
    return jnp.concatenate([y_lru, y_att], axis=-1) @ out_w


def compress(kv, pos_emb, w1, w2):
    B, G, S, dh = kv.shape
    c = kv.reshape(B, G, S // CMP_STRIDE, CMP_STRIDE, dh)
    blocks = jnp.concatenate([c[:, :, :-1], c[:, :, 1:]], axis=3)
    nc = blocks.shape[2]
    blocks = (blocks + pos_emb).reshape(B, G, nc, CMP_LEN * dh)
    return jax.nn.gelu(blocks @ w1) @ w2


def mixer_nsa(h, in_w, cmp_pos, cmp_w1, cmp_w2, out_w, pos):
    B, S, _ = h.shape
    G, R, dh = NSA_KV_GROUPS, NSA_HPG, HEAD_DIM
    scale = dh ** -0.5
    u = h @ in_w
    cuts = [NSA_QD + i * NSA_KVD for i in range(7)]
    q, kc, vc, ks, vs, kw, vw, gl = jnp.split(u, cuts, axis=-1)
    q = q.reshape(B, S, G, R, dh).transpose(0, 2, 3, 1, 4)

    def kvh(a):
        return a.reshape(B, S, G, dh).transpose(0, 2, 1, 3)

    q_rope = rope_partial(q, pos)
    kcmp = compress(kvh(kc), cmp_pos[0], cmp_w1[0], cmp_w2[0])
    vcmp = compress(kvh(vc), cmp_pos[1], cmp_w1[1], cmp_w2[1])
    nc = kcmp.shape[2]
    ns = S // SEL_BLOCK
    ks_blocks = rope_partial(kvh(ks), pos).reshape(B, G, ns, SEL_BLOCK, dh)
    vs_blocks = kvh(vs).reshape(B, G, ns, SEL_BLOCK, dh)
    kw_pad = jnp.pad(rope_partial(kvh(kw), pos), ((0, 0), (0, 0), (WINDOW, 0), (0, 0)))
    vw_pad = jnp.pad(kvh(vw), ((0, 0), (0, 0), (WINDOW, 0), (0, 0)))
    gates = jax.nn.sigmoid(gl).reshape(B, S, NSA_HEADS, 3)

    cmp_end = jnp.arange(nc) * CMP_STRIDE + CMP_LEN - 1
    ci = jnp.arange(nc)[:, None] * CMP_STRIDE
    sj = jnp.arange(ns)[None, :] * SEL_BLOCK
    overlap = jnp.clip(jnp.minimum(ci + CMP_LEN, sj + SEL_BLOCK) - jnp.maximum(ci, sj), 0, None).astype(jnp.float32) / CMP_LEN
    n_sel = min(SEL_TOPK, ns)
    b_ix = jnp.arange(B)[:, None, None, None]
    g_ix = jnp.arange(G)[None, :, None, None]
    offs = jnp.arange(SEL_BLOCK)
    jn = jnp.arange(ns)
    nq = S // Q_BLOCK

    def to_blocks(a):
        return jnp.moveaxis(a.reshape(B, G, R, nq, Q_BLOCK, dh), 3, 0)

    def step(args):
        qn, qr, t0 = args
        tq = t0 + jnp.arange(Q_BLOCK)
        s_c = jnp.einsum('bgrqd,bgcd->bgrqc', qn, kcmp).astype(jnp.float32) * scale
        p_c = masked_softmax(s_c, cmp_end[None, :] <= tq[:, None])
        o_c = jnp.einsum('bgrqc,bgcd->bgrqd', p_c.astype(vcmp.dtype), vcmp)
        imp = jnp.einsum('bgrqc,cn->bgqn', p_c, overlap)
        blk_t = tq // SEL_BLOCK
        forced = (jn[None, :] == 0) | (jn[None, :] == blk_t[:, None]) | (jn[None, :] == blk_t[:, None] - 1)
        imp = jnp.where(forced, BIG, imp)
        imp = jnp.where(jn[None, :] <= blk_t[:, None], imp, -jnp.inf)
        _, idx = lax.top_k(imp, n_sel)
        kg = ks_blocks[b_ix, g_ix, idx]
        vg = vs_blocks[b_ix, g_ix, idx]
        s_s = jnp.einsum('bgrqd,bgqnkd->bgrqnk', qr, kg).astype(jnp.float32) * scale
        kpos = idx[..., None] * SEL_BLOCK + offs
        m_s = (kpos <= tq[:, None, None])[:, :, None]
        p_s = masked_softmax(s_s.reshape(B, G, R, Q_BLOCK, -1), m_s.reshape(B, G, 1, Q_BLOCK, -1)).reshape(s_s.shape)
        o_s = jnp.einsum('bgrqnk,bgqnkd->bgrqd', p_s.astype(vg.dtype), vg)
        kwb = lax.dynamic_slice_in_dim(kw_pad, t0, Q_BLOCK + WINDOW, axis=2)
        vwb = lax.dynamic_slice_in_dim(vw_pad, t0, Q_BLOCK + WINDOW, axis=2)
        s_w = jnp.einsum('bgrqd,bgkd->bgrqk', qr, kwb).astype(jnp.float32) * scale
        kpos_w = t0 - WINDOW + jnp.arange(Q_BLOCK + WINDOW)
        diff = tq[:, None] - kpos_w[None, :]
        m_w = (diff >= 0) & (diff < WINDOW) & (kpos_w[None, :] >= 0)
        p_w = masked_softmax(s_w, m_w)
        o_w = jnp.einsum('bgrqk,bgkd->bgrqd', p_w.astype(vwb.dtype), vwb)
        return jnp.stack([o_c, o_s, o_w], axis=-2)

    out = lax.map(step, (to_blocks(q), to_blocks(q_rope), jnp.arange(nq) * Q_BLOCK))
    out = out.transpose(1, 0, 4, 2, 3, 5, 6).reshape(B, S, NSA_HEADS, 3, dh)
    y = jnp.einsum('bshc,bshcd->bshd', gates, out).reshape(B, S, MIX1_WIDTH)
    return y @ out_w


def setup_inputs(seed: int = 0) -> dict:
    key = jax.random.key(seed)
    ks = jax.random.split(key, 24)
    f32 = jnp.float32
    D = D_MODEL

    def nrm(k, shape, s):
        return s * jax.random.normal(k, shape, f32)

    a8 = jax.random.uniform(ks[14], (N_EVEN, LRU_WIDTH), f32, 0.9, 0.999)
    sig = a8 ** (1.0 / LRU_C)
    return {
        "x": nrm(ks[0], (BATCH, SEQ, D), 1.0),
        "c": nrm(ks[1], (BATCH, D), 1.0),
        "mod_w": nrm(ks[2], (DEPTH, D, 9 * D), 0.5 * D ** -0.5),
        "mod_b": nrm(ks[3], (DEPTH, 9 * D), 0.02),
        "norm_g": 1.0 + nrm(ks[4], (DEPTH, 3, D), 0.05),
        "ffn_w1": nrm(ks[5], (DEPTH, 2, D, 2 * D_FF), D ** -0.5),
        "ffn_w2": nrm(ks[6], (DEPTH, 2, D_FF, D), D_FF ** -0.5),
        "mix0_in_w": nrm(ks[7], (N_EVEN, D, IN0_WIDTH), D ** -0.5),
        "lru_conv_w": nrm(ks[8], (N_EVEN, CONV_WIDTH, LRU_WIDTH), CONV_WIDTH ** -0.5),
        "lru_conv_b": nrm(ks[9], (N_EVEN, LRU_WIDTH), 0.02),
        "lru_wa": nrm(ks[10], (N_EVEN, LRU_BLOCKS, LRU_BLOCK_DIM, LRU_BLOCK_DIM), LRU_BLOCK_DIM ** -0.5),
        "lru_ba": nrm(ks[11], (N_EVEN, LRU_BLOCKS, LRU_BLOCK_DIM), 0.02),
        "lru_wx": nrm(ks[12], (N_EVEN, LRU_BLOCKS, LRU_BLOCK_DIM, LRU_BLOCK_DIM), LRU_BLOCK_DIM ** -0.5),
        "lru_bx": nrm(ks[13], (N_EVEN, LRU_BLOCKS, LRU_BLOCK_DIM), 0.02),
        "lru_lambda": jnp.log(sig) - jnp.log1p(-sig),
        "mix0_out_w": nrm(ks[15], (N_EVEN, MIX0_WIDTH, D), MIX0_WIDTH ** -0.5),
        "mix1_in_w": nrm(ks[16], (N_ODD, D, IN1_WIDTH), D ** -0.5),
        "cmp_pos": nrm(ks[17], (N_ODD, 2, CMP_LEN, HEAD_DIM), 0.1),
        "cmp_w1": nrm(ks[18], (N_ODD, 2, CMP_LEN * HEAD_DIM, CMP_HIDDEN), (CMP_LEN * HEAD_DIM) ** -0.5),
        "cmp_w2": nrm(ks[19], (N_ODD, 2, CMP_HIDDEN, HEAD_DIM), CMP_HIDDEN ** -0.5),
        "mix1_out_w": nrm(ks[20], (N_ODD, MIX1_WIDTH, D), MIX1_WIDTH ** -0.5),
        "final_norm_g": 1.0 + nrm(ks[21], (D,), 0.05),
    }


def reference(x, c, mod_w, mod_b, norm_g, ffn_w1, ffn_w2, mix0_in_w, lru_conv_w, lru_conv_b,
              lru_wa, lru_ba, lru_wx, lru_bx, lru_lambda, mix0_out_w, mix1_in_w, cmp_pos,
              cmp_w1, cmp_w2, mix1_out_w, final_norm_g):
    B, S, D = x.shape
    pos = jnp.arange(S, dtype=jnp.float32)
    cond = jax.nn.silu(c)
    for l in range(DEPTH):
        mod = (cond @ mod_w[l] + mod_b[l]).reshape(B, 9, D)
        h = modulate(rmsnorm(x, norm_g[l, 0]), mod[:, 0], mod[:, 1])
        x = x + 0.5 * mod[:, 2][:, None, :] * swiglu(h, ffn_w1[l, 0], ffn_w2[l, 0])
        h = modulate(rmsnorm(x, norm_g[l, 1]), mod[:, 3], mod[:, 4])
        j = l // 2
        if l % 2 == 0:
            y = mixer_lru_moba(h, mix0_in_w[j], lru_conv_w[j], lru_conv_b[j], lru_wa[j], lru_ba[j],
                               lru_wx[j], lru_bx[j], lru_lambda[j], mix0_out_w[j], pos)
        else:
            y = mixer_nsa(h, mix1_in_w[j], cmp_pos[j], cmp_w1[j], cmp_w2[j], mix1_out_w[j], pos)
        x = x + mod[:, 5][:, None, :] * y
        h = modulate(rmsnorm(x, norm_g[l, 2]), mod[:, 6], mod[:, 7])
        x = x + 0.5 * mod[:, 8][:, None, :] * swiglu(h, ffn_w1[l, 1], ffn_w2[l, 1])
    return rmsnorm(x, final_norm_g)
```

```cpp
#include <hip/hip_runtime.h>
#include <hip/hip_cooperative_groups.h>
#include <stdint.h>
#include <stdio.h>
#include <string.h>
namespace cg = cooperative_groups;

typedef unsigned short u16;
typedef __attribute__((ext_vector_type(8))) short bf16x8;
typedef __attribute__((ext_vector_type(4))) short s16x4;
typedef __attribute__((ext_vector_type(4))) float f32x4;
typedef __attribute__((ext_vector_type(16))) float f32x16;
typedef __attribute__((ext_vector_type(4))) int i32x4;
typedef __attribute__((ext_vector_type(4))) unsigned u32x4;
typedef __attribute__((ext_vector_type(2))) unsigned u32x2;

#define DI __device__ __forceinline__
#define MFMA32(a, b, c) __builtin_amdgcn_mfma_f32_32x32x16_bf16((a), (b), (c), 0, 0, 0)
#define MFMA16(a, b, c) __builtin_amdgcn_mfma_f32_16x16x32_bf16((a), (b), (c), 0, 0, 0)

constexpr int NB = 4, SEQ = 8192, DM = 1024, NT = NB * SEQ, DFF = 2816;
constexpr int IN0 = 2560, IN1 = 1840, IN1P = 2048;
constexpr int NTHR = 512;
constexpr int NJOBS = 32;

struct TJob { const float* src; u16* dst; int K, N, ldn, perm, tile0, ntn; };

struct Params {
  const float *x, *c, *mod_w, *mod_b, *norm_g, *ffn_w1, *ffn_w2, *mix0_in_w, *conv_w, *conv_b, *wa, *ba, *wx, *bx, *lam,
      *mix0_out_w, *mix1_in_w, *cmp_pos, *cmp_w1, *cmp_w2, *mix1_out_w, *fng;
  float* out;
  u16 *wt1, *wt2, *wtin0, *wtout0, *wtin1, *wtout1, *wtcmp, *wat;
  float *mod, *rope, *cvec, *cent, *lrusum, *pq;
  u16 *h, *big, *vt, *kcmp, *vcmpT;
  unsigned *mcnt, *mlist, *ctr;
  u16* part;
  TJob jobs[NJOBS];
  int njobs, ntr_tiles;
};

typedef const __attribute__((address_space(4))) Params* PP;
DI PP launder_p(PP p) { asm volatile("" : "+s"(p)); return p; }

typedef __attribute__((ext_vector_type(2))) float f32x2_;
typedef __attribute__((ext_vector_type(2))) __bf16 bf16x2_;
DI uint32_t pack2(float a, float b) {
  f32x2_ v = {a, b};
  return __builtin_bit_cast(uint32_t, __builtin_convertvector(v, bf16x2_));
}
DI u16 f2bf(float f) { return (u16)(pack2(f, 0.f) & 0xffffu); }
DI float bf2f(u16 h) { return __uint_as_float(((uint32_t)h) << 16); }
DI float bflo(uint32_t w) { return __uint_as_float(w << 16); }
DI float bfhi(uint32_t w) { return __uint_as_float(w & 0xffff0000u); }

DI void wt16(u16* p, u16 v) { *p = v; }
DI void wt32u(unsigned* p, unsigned v) { *p = v; }
DI void wt32f(float* p, float v) { *p = v; }
DI void wt64(void* p, u32x2 v) { *(u32x2*)p = v; }
DI void wt128(void* p, u32x4 v) { *(u32x4*)p = v; }
DI bf16x8 pack8(float a0, float a1, float a2, float a3, float a4, float a5, float a6, float a7) {
  u32x4 p;
  asm volatile("v_cvt_pk_bf16_f32 %0, %4, %5\n\tv_cvt_pk_bf16_f32 %1, %6, %7\n\tv_cvt_pk_bf16_f32 %2, %8, %9\n\tv_cvt_pk_bf16_f32 %3, %10, %11\n\ts_nop 1"
               : "=&v"(p[0]), "=&v"(p[1]), "=&v"(p[2]), "=&v"(p[3])
               : "v"(a0), "v"(a1), "v"(a2), "v"(a3), "v"(a4), "v"(a5), "v"(a6), "v"(a7));
  return __builtin_bit_cast(bf16x8, p);
}
DI int launder(int v) { asm volatile("" : "+v"(v)); return v; }
DI int lane_id_() { int l = __builtin_amdgcn_mbcnt_hi(-1, __builtin_amdgcn_mbcnt_lo(-1, 0)); asm volatile("" : "+v"(l)); return l; }
DI int grab_begin(int ws, unsigned* ctr) {
  int v = 0;
  if (ws == 0 && lane_id_() == 0) v = (int)atomicAdd(ctr, 1u);
  return v;
}
DI int grab_end(int ws, int v, char* shm) {
  int* slot = (int*)(shm + 150016);
  __syncthreads();
  if (ws == 0 && lane_id_() == 0) *slot = v;
  __syncthreads();
  return *slot;
}
DI int grab(int ws, unsigned* ctr, char* shm) { return grab_end(ws, grab_begin(ws, ctr), shm); }
DI int mytid(int ws) { return launder(ws * 64 + lane_id_()); }
template <int M> DI int shxi(int v) {
  if (M < 32) return __builtin_amdgcn_ds_swizzle(v, (M << 10) | 0x1f);
  auto r = __builtin_amdgcn_permlane32_swap((unsigned)v, (unsigned)v, false, false);
  return (int)(r[0] ^ r[1] ^ (unsigned)v);
}
DI float sum8(float v) {
  v += __int_as_float(__builtin_amdgcn_update_dpp(0, __float_as_int(v), 0xB1, 0xF, 0xF, true));
  v += __int_as_float(__builtin_amdgcn_update_dpp(0, __float_as_int(v), 0x4E, 0xF, 0xF, true));
  v += __int_as_float(__builtin_amdgcn_update_dpp(0, __float_as_int(v), 0x141, 0xF, 0xF, true));
  return v;
}
DI float xmax32(float v) {
  auto r = __builtin_amdgcn_permlane32_swap(__float_as_uint(v), __float_as_uint(v), false, false);
  return fmaxf(__uint_as_float(r[0]), __uint_as_float(r[1]));
}
DI float xsum32(float v) {
  auto r = __builtin_amdgcn_permlane32_swap(__float_as_uint(v), __float_as_uint(v), false, false);
  return __uint_as_float(r[0]) + __uint_as_float(r[1]);
}
template <int M> DI float shxf(float v) { return __int_as_float(shxi<M>(__float_as_int(v))); }
DI float sigmoidf_(float x) { return __builtin_amdgcn_rcpf(1.f + __expf(-x)); }
DI float gelu_tanh(float x) {
  const float z = 0.7978845608028654f * (x + 0.044715f * x * x * x);
  const float th = 1.f - 2.f * __builtin_amdgcn_rcpf(1.f + __expf(2.f * z));
  return 0.5f * x * (1.f + th);
}

template <int KS> DI int lds_byte(int r, int c) {
  int st = (r >> 4) * KS + (c >> 5), ob = (r & 15) * 64 + (c & 31) * 2;
  return st * 1024 + (ob ^ (((ob >> 9) & 1) << 5));
}
template <int KS> DI void stage_rc(int b, int& R, int& C) {
  int st = b >> 10, sb = b & 1023, swz = sb ^ (((sb >> 9) & 1) << 5);
  R = (st / KS) * 16 + swz / 64;
  C = (st % KS) * 32 + (swz % 64) / 2;
}
#define WAIT_V(n) asm volatile("s_waitcnt vmcnt(%0)" ::"n"(n) : "memory")

struct TileDesc { const u16* a; long lda, kts; const u16* b; long ldb; int nt; };

typedef f32x4 Acc8[2][2][4][2];
template <class Epi>
DI void gemm_tile(int ws, char* shmc, const TileDesc& td, Epi& epi, int pm, int pn, bool first, bool has_next, const TileDesc& tdn) {
  constexpr int BK = 64, HALF = 128, HT = HALF * BK;
  u16* shm = (u16*)shmc;
  const int tid = mytid(ws), wid = tid >> 6, lane = tid & 63, wr = wid >> 2, wc = wid & 3, fr = lane & 15, fq = lane >> 4;
  const u16* ABASE = td.a;
  const u16* BBASE = td.b;
  const long lda = td.lda, kts = td.kts, ldb = td.ldb;
  const int nt = td.nt;
#define SA(b, h) (shm + ((b) * 2 + (h)) * HT)
#define SB(b, h) (shm + (4 + (b) * 2 + (h)) * HT)
  unsigned voffA, voffB;
  {
    int r0_, c0_;
    stage_rc<2>(tid * 16, r0_, c0_);
    voffA = (unsigned)(r0_ * (int)lda + c0_);
    voffB = (unsigned)(r0_ * (int)ldb + c0_);
  }
#define STAGE_A(P, hf, kt)                                                                                     \
  do {                                                                                                         \
    _Pragma("unroll") for (int _i = 0; _i < 2; ++_i)                                                           \
      __builtin_amdgcn_global_load_lds((const unsigned*)((ABASE + (long)((hf) * HALF + 64 * _i) * lda + (long)(kt) * kts) + voffA), \
                                       (__attribute__((address_space(3))) unsigned*)((char*)(P) + tid * 16 + _i * 8192), 16, 0, 0); \
  } while (0)
#define STAGE_B(P, hf, kt)                                                                                     \
  do {                                                                                                         \
    _Pragma("unroll") for (int _i = 0; _i < 2; ++_i)                                                           \
      __builtin_amdgcn_global_load_lds((const unsigned*)((BBASE + (long)((hf) * HALF + 64 * _i) * ldb + (long)(kt) * BK) + voffB), \
                                       (__attribute__((address_space(3))) unsigned*)((char*)(P) + tid * 16 + _i * 8192), 16, 0, 0); \
  } while (0)
#define LDA_(dst, b, h)                                    \
  _Pragma("unroll") for (int m = 0; m < 4; ++m)            \
  _Pragma("unroll") for (int k = 0; k < 2; ++k)            \
      dst[m][k] = *(const bf16x8*)((const char*)SA(b, h) + lds_byte<2>(wr * 64 + m * 16 + fr, k * 32 + fq * 8))
#define LDB_(dst, b, h)                                    \
  _Pragma("unroll") for (int n = 0; n < 2; ++n)            \
  _Pragma("unroll") for (int k = 0; k < 2; ++k)            \
      dst[n][k] = *(const bf16x8*)((const char*)SB(b, h) + lds_byte<2>(wc * 32 + n * 16 + fr, k * 32 + fq * 8))
#define MMA_(ai, bj, AT, BT)                                                           \
  do {                                                                                 \
    __builtin_amdgcn_s_setprio(1);                                                     \
    _Pragma("unroll") for (int m = 0; m < 4; ++m)                                      \
    _Pragma("unroll") for (int n = 0; n < 2; ++n)                                      \
    _Pragma("unroll") for (int k = 0; k < 2; ++k)                                      \
        acc[ai][bj][m][n] = MFMA16(AT[m][k], BT[n][k], acc[ai][bj][m][n]);             \
    __builtin_amdgcn_s_setprio(0);                                                     \
  } while (0)
#define WV(n) asm volatile("s_waitcnt vmcnt(" #n ")" ::: "memory")
#define WL(n) asm volatile("s_waitcnt lgkmcnt(" #n ")" ::: "memory")
#define BAR __builtin_amdgcn_s_barrier()
#define SCHED __builtin_amdgcn_sched_barrier(0)
  Acc8 acc;
#pragma unroll
  for (int a = 0; a < 2; ++a)
#pragma unroll
    for (int b = 0; b < 2; ++b)
#pragma unroll
      for (int m = 0; m < 4; ++m)
#pragma unroll
        for (int n = 0; n < 2; ++n) acc[a][b][m][n] = f32x4{0.f, 0.f, 0.f, 0.f};
  bf16x8 At[4][2], B0[2][2], B1[2][2];
  if (first) {
    STAGE_B(SB(0, 0), 0, 0); STAGE_A(SA(0, 0), 0, 0);
    STAGE_B(SB(0, 1), 1, 0); STAGE_A(SA(0, 1), 1, 0);
  }
  if (wr == 1) BAR;
  WV(4); BAR;
  STAGE_B(SB(1, 0), 0, 1); STAGE_A(SA(1, 0), 0, 1); STAGE_B(SB(1, 1), 1, 1);
  WV(6); BAR;
  for (int t = 0; t < nt - 2; t += 2) {
    LDB_(B0, 0, 0); SCHED; LDA_(At, 0, 0); STAGE_A(SA(1, 1), 1, t + 1);
    WL(8); BAR; WL(0); MMA_(0, 0, At, B0); BAR; SCHED;
    LDB_(B1, 0, 1); STAGE_B(SB(0, 0), 0, t + 2);
    BAR; WL(0); MMA_(0, 1, At, B1); BAR;
    LDA_(At, 0, 1); STAGE_A(SA(0, 0), 0, t + 2);
    BAR; WL(0); MMA_(1, 0, At, B0); BAR; SCHED;
    STAGE_B(SB(0, 1), 1, t + 2);
    WV(6); BAR; MMA_(1, 1, At, B1); BAR;
    LDB_(B0, 1, 0); SCHED; LDA_(At, 1, 0); STAGE_A(SA(0, 1), 1, t + 2);
    WL(8); BAR; WL(0); MMA_(0, 0, At, B0); BAR; SCHED;
    LDB_(B1, 1, 1); STAGE_B(SB(1, 0), 0, t + 3);
    BAR; WL(0); MMA_(0, 1, At, B1); BAR;
    LDA_(At, 1, 1); STAGE_A(SA(1, 0), 0, t + 3);
    BAR; WL(0); MMA_(1, 0, At, B0); BAR; SCHED;
    STAGE_B(SB(1, 1), 1, t + 3);
    WV(6); BAR; MMA_(1, 1, At, B1); BAR;
  }
  { LDB_(B0, 0, 0); LDA_(At, 0, 0); STAGE_A(SA(1, 1), 1, nt - 1);
    BAR; WL(0); MMA_(0, 0, At, B0); BAR;
    LDB_(B1, 0, 1); BAR; WL(0); MMA_(0, 1, At, B1); BAR;
    LDA_(At, 0, 1); WV(4); BAR; WL(0); MMA_(1, 0, At, B0); MMA_(1, 1, At, B1); BAR; }
  { LDB_(B0, 1, 0); LDA_(At, 1, 0); WV(2); BAR; WL(0); MMA_(0, 0, At, B0); BAR;
    LDB_(B1, 1, 1); WV(0); BAR; WL(0); MMA_(0, 1, At, B1); BAR;
    LDA_(At, 1, 1); BAR; WL(0); MMA_(1, 0, At, B0); MMA_(1, 1, At, B1); BAR; }
  if (wr == 0) BAR;
  if (has_next) {
    ABASE = tdn.a;
    BBASE = tdn.b;
    STAGE_B(SB(0, 0), 0, 0); STAGE_A(SA(0, 0), 0, 0);
    STAGE_B(SB(0, 1), 1, 0); STAGE_A(SA(0, 1), 1, 0);
  }
  epi(pm, pn, acc, wr, wc, fr, fq);
  asm volatile("s_waitcnt vmcnt(0)" ::: "memory");
  __syncthreads();
#undef SA
#undef SB
#undef STAGE_A
#undef STAGE_B
#undef LDA_
#undef LDB_
#undef MMA_
#undef WV
#undef WL
#undef BAR
#undef SCHED
}

template <class Desc, class Epi>
DI void gemm_phase(int ws, char* shm, int nM, int nN, Desc desc, Epi epi) {
  const int ntiles = nM * nN;
  const int G = gridDim.x, bid = blockIdx.x;
  const bool xcdmap = (G % 8 == 0) && (ntiles % 8 == 0);
  const int per = ntiles / 8, slots = G / 8;
  auto tile_at = [&](int i, int& pm, int& pn) -> bool {
    int t;
    if (xcdmap) {
      int lt = (bid >> 3) + slots * i;
      if (lt >= per) return false;
      t = (bid & 7) * per + lt;
    } else {
      t = bid + G * i;
      if (t >= ntiles) return false;
    }
    const int WGM = 8;
    int nig = WGM * nN, gid = t / nig, fm = gid * WGM, gsz = min(nM - fm, WGM);
    pm = fm + ((t % nig) % gsz);
    pn = (t % nig) / gsz;
    return true;
  };
  __syncthreads();
  int pm, pn;
  if (!tile_at(0, pm, pn)) return;
  TileDesc td = desc(pm, pn);
  bool first = true;
  for (int i = 0;; ++i) {
    int pmn = 0, pnn = 0;
    const bool more = tile_at(i + 1, pmn, pnn);
    TileDesc tdn = td;
    if (more) tdn = desc(pmn, pnn);
    gemm_tile(ws, shm, td, epi, pm, pn, first, more, tdn);
    if (!more) break;
    td = tdn; pm = pmn; pn = pnn; first = false;
  }
}

DI float wave_sum(float v) {
  v += shxf<32>(v); v += shxf<16>(v); v += shxf<8>(v); v += shxf<4>(v); v += shxf<2>(v); v += shxf<1>(v);
  return v;
}

DI void norm_phase(int ws, const float* __restrict__ x, u16* __restrict__ h, const float* __restrict__ g, const float* __restrict__ shift,
                   const float* __restrict__ scale  ) {
  const int tid_ = mytid(ws), wid = tid_ >> 6, lane = tid_ & 63;
  for (int row = blockIdx.x * 8 + wid; row < NT; row += gridDim.x * 8) {
    const float4* xr = (const float4*)(x + (long)row * DM);
    float4 v[4];
    float ss = 0.f;
#pragma unroll
    for (int i = 0; i < 4; ++i) {
      v[i] = xr[lane + 64 * i];
      ss += v[i].x * v[i].x + v[i].y * v[i].y + v[i].z * v[i].z + v[i].w * v[i].w;
    }
    ss = wave_sum(ss);
    const float rs = rsqrtf(ss * (1.f / DM) + 1e-6f);
    const int b = row >> 13;
#pragma unroll
    for (int i = 0; i < 4; ++i) {
      const int c4 = lane + 64 * i;
      const float4 gg = ((const float4*)g)[c4];
      const float4 sc = ((const float4*)(scale + (long)b * 9216))[c4];
      const float4 sh = ((const float4*)(shift + (long)b * 9216))[c4];
      float y0 = v[i].x * rs * gg.x * (1.f + sc.x) + sh.x;
      float y1 = v[i].y * rs * gg.y * (1.f + sc.y) + sh.y;
      float y2 = v[i].z * rs * gg.z * (1.f + sc.z) + sh.z;
      float y3 = v[i].w * rs * gg.w * (1.f + sc.w) + sh.w;
      u32x2 pk = {pack2(y0, y1), pack2(y2, y3)};
      wt64(h + (long)row * DM + c4 * 4, pk);
    }
  }
}

DI void final_norm_phase(int ws, float* __restrict__ x, const float* __restrict__ g) {
  const int tid_ = mytid(ws), wid = tid_ >> 6, lane = tid_ & 63;
  for (int row = blockIdx.x * 8 + wid; row < NT; row += gridDim.x * 8) {
    float4* xr = (float4*)(x + (long)row * DM);
    float4 v[4];
    float ss = 0.f;
#pragma unroll
    for (int i = 0; i < 4; ++i) {
      v[i] = xr[lane + 64 * i];
      ss += v[i].x * v[i].x + v[i].y * v[i].y + v[i].z * v[i].z + v[i].w * v[i].w;
    }
    ss = wave_sum(ss);
    const float rs = rsqrtf(ss * (1.f / DM) + 1e-6f);
#pragma unroll
    for (int i = 0; i < 4; ++i) {
      const int c4 = lane + 64 * i;
      const float4 gg = ((const float4*)g)[c4];
      float4 o = {v[i].x * rs * gg.x, v[i].y * rs * gg.y, v[i].z * rs * gg.z, v[i].w * rs * gg.w};
      xr[c4] = o;
    }
  }
}

DI void prep_phase(int ws, PP p, char* shm) {
  const int tid = mytid(ws);
  float* fs = (float*)shm;
  const int n_tr = p->ntr_tiles;
  const int n_mod = 2 * 144;
  const int n_cv = 8;
  const int n_rope = 128;
  const int n_misc = 1;
  const int total = n_tr + n_mod + n_cv + n_rope + n_misc;
  for (int it = blockIdx.x; it < total; it += gridDim.x) {
    if (it < n_tr) {
      int j = 0;
      for (int q = 1; q < p->njobs; ++q)
        if (it >= p->jobs[q].tile0) j = q;
      TJob jb;
      jb.src = p->jobs[j].src; jb.dst = p->jobs[j].dst; jb.K = p->jobs[j].K; jb.N = p->jobs[j].N; jb.ldn = p->jobs[j].ldn; jb.perm = p->jobs[j].perm; jb.tile0 = p->jobs[j].tile0; jb.ntn = p->jobs[j].ntn;
      const int lt = it - jb.tile0;
      const int ngn = (jb.ntn + 3) >> 2;
      const int tk = lt / ngn, tg4 = lt % ngn;
      const int k0 = tk * 64;
      float4 v[4][2];
#pragma unroll
      for (int u = 0; u < 4; ++u)
#pragma unroll
        for (int rep = 0; rep < 2; ++rep) {
          const int idx = tid + rep * 512, r = idx >> 4, c4 = idx & 15;
          const int n = (tg4 * 4 + u) * 64 + c4 * 4;
          v[u][rep] = float4{0.f, 0.f, 0.f, 0.f};
          if (tg4 * 4 + u < jb.ntn && n < jb.N) v[u][rep] = *(const float4*)(jb.src + (long)(k0 + r) * jb.ldn + n);
        }
#pragma unroll
      for (int u = 0; u < 4; ++u)
#pragma unroll
        for (int rep = 0; rep < 2; ++rep) {
          const int idx = tid + rep * 512, r = idx >> 4, c4 = idx & 15;
          float* f = fs + u * (64 * 65) + r * 65 + c4 * 4;
          f[0] = v[u][rep].x; f[1] = v[u][rep].y; f[2] = v[u][rep].z; f[3] = v[u][rep].w;
        }
      __syncthreads();
#pragma unroll
      for (int u = 0; u < 4; ++u) {
        if (tg4 * 4 + u < jb.ntn) {
          const int n = tid >> 3, ks = tid & 7;
          float e[8];
#pragma unroll
          for (int q = 0; q < 8; ++q) e[q] = fs[u * (64 * 65) + (ks * 8 + q) * 65 + n];
          int ng = (tg4 * 4 + u) * 64 + n, drow = ng;
          if (jb.perm == 1) {
            int isb = ng >= DFF ? 1 : 0, jj = ng - isb * DFF;
            drow = (jj >> 4) * 32 + isb * 16 + (jj & 15);
          }
          u32x4 pk = {pack2(e[0], e[1]), pack2(e[2], e[3]), pack2(e[4], e[5]), pack2(e[6], e[7])};
          wt128(jb.dst + (long)drow * jb.K + k0 + ks * 8, pk);
        }
      }
      __syncthreads();
    } else if (it < n_tr + n_mod) {
      const int q = it - n_tr, l = q / 144, cg0 = (q % 144) * 64;
      for (int i = tid; i < 4096; i += NTHR) {
        float cv = p->c[i];
        fs[i] = cv / (1.f + __expf(-cv));
      }
      __syncthreads();
      const int col = tid & 63, kg = tid >> 6;
      const float* w = p->mod_w + (long)l * DM * 9216 + cg0 + col;
      float a0 = 0.f, a1 = 0.f, a2 = 0.f, a3 = 0.f;
#pragma unroll 16
      for (int k = kg * 128; k < kg * 128 + 128; ++k) {
        float wv = w[(long)k * 9216];
        a0 += fs[k] * wv;
        a1 += fs[1024 + k] * wv;
        a2 += fs[2048 + k] * wv;
        a3 += fs[3072 + k] * wv;
      }
      __syncthreads();
      float* red = fs;
      red[(kg * 4 + 0) * 64 + col] = a0;
      red[(kg * 4 + 1) * 64 + col] = a1;
      red[(kg * 4 + 2) * 64 + col] = a2;
      red[(kg * 4 + 3) * 64 + col] = a3;
      __syncthreads();
      if (tid < 256) {
        int b = tid >> 6;
        float s = 0.f;
#pragma unroll
        for (int g = 0; g < 8; ++g) s += red[(g * 4 + b) * 64 + col];
        wt32f(p->mod + ((long)l * 4 + b) * 9216 + cg0 + col, s + p->mod_b[(long)l * 9216 + cg0 + col]);
      }
      __syncthreads();
    } else if (it < n_tr + n_mod + n_cv) {
      const int q = it - n_tr - n_mod, kv = q >> 2, n = (q & 3) * 32 + (tid & 31), kg = tid >> 5;
      const float* w1 = p->cmp_w1 + (long)kv * 2048 * 128;
      const float* pe = p->cmp_pos + (long)kv * 2048;
      float a = 0.f;
      for (int k = kg * 128; k < kg * 128 + 128; ++k) a += pe[k] * w1[(long)k * 128 + n];
      fs[kg * 32 + (tid & 31)] = a;
      __syncthreads();
      if (tid < 32) {
        float s = 0.f;
        for (int g = 0; g < 16; ++g) s += fs[g * 32 + tid];
        p->cvec[kv * 128 + (q & 3) * 32 + tid] = s;
      }
      __syncthreads();
    } else if (it < n_tr + n_mod + n_cv + n_rope) {
      const int q = it - n_tr - n_mod - n_cv;
      const int e = q * 512 + tid, pos = e >> 3, i = e & 7;
      const float freq = powf(500000.f, -(float)i * 0.125f);
      const float angf = (float)pos * freq;
      const double ang = (double)angf;
      const double n = rint(ang * 0.15915494309189535);
      double r = fma(-n, 6.283185307179586, ang);
      r = fma(-n, 2.4492935982947064e-16, r);
      const float rf = (float)r;
      p->rope[pos * 16 + i] = cosf(rf);
      p->rope[pos * 16 + 8 + i] = sinf(rf);
    } else {
      if (tid < 512) {
        int bg = tid >> 6, d = tid & 63;
        p->kcmp[((long)bg * 512 + 511) * 64 + d] = 0;
        p->vcmpT[((long)bg * 64 + d) * 512 + 511] = 0;
        p->mcnt[tid] = 0u;
        p->mcnt[512 + tid] = 0u;
        if (tid < 64) p->ctr[tid] = 0u;
      }
    }
  }
}

constexpr int KVS = 72;
constexpr int KVT = 64 * KVS;
constexpr float SCL2 = 0.125f * 1.4426950408889634f;

DI void qk_tile(const u16* Ks, const bf16x8* qf, f32x16* s, int rl, int hh) {
#pragma unroll
  for (int kb = 0; kb < 2; ++kb) {
#pragma unroll
    for (int i = 0; i < 16; ++i) s[kb][i] = 0.f;
#pragma unroll
    for (int ks = 0; ks < 4; ++ks) {
      bf16x8 a = *(const bf16x8*)(Ks + (kb * 32 + rl) * KVS + ks * 16 + hh * 8);
      s[kb] = MFMA32(a, qf[ks], s[kb]);
    }
  }
}
DI void pv_tile(const u16* Vs, const f32x16* s, f32x16* o, int rl, int hh) {
#pragma unroll
  for (int kk = 0; kk < 4; ++kk) {
    const int kb = kk >> 1, i0 = 8 * (kk & 1);
    bf16x8 pf = pack8(s[kb][i0], s[kb][i0 + 1], s[kb][i0 + 2], s[kb][i0 + 3], s[kb][i0 + 4], s[kb][i0 + 5], s[kb][i0 + 6], s[kb][i0 + 7]);
#pragma unroll
    for (int db = 0; db < 2; ++db) {
      const u16* vp = Vs + (db * 32 + rl) * KVS + kk * 16 + hh * 4;
      s16x4 lo = *(const s16x4*)vp, hi = *(const s16x4*)(vp + 8);
      bf16x8 a = __builtin_shufflevector(lo, hi, 0, 1, 2, 3, 4, 5, 6, 7);
      o[db] = MFMA32(a, pf, o[db]);
    }
  }
}
DI float fexp2(float x) { return __builtin_amdgcn_exp2f(x); }
template <int MODE>
DI void osm(f32x16* s, uint32_t vm, float& m, float& l, f32x16* o) {
  float mx = -1e30f;
#pragma unroll
  for (int kb = 0; kb < 2; ++kb)
#pragma unroll
    for (int i = 0; i < 16; ++i) {
      if (MODE == 2) s[kb][i] = ((vm >> (kb * 16 + i)) & 1u) ? s[kb][i] : -1e30f;
      mx = fmaxf(mx, s[kb][i]);
    }
  mx *= SCL2;
  if (MODE == 1) mx = vm ? mx : -1e30f;
  mx = xmax32(mx);
  const float mn = fmaxf(m, mx);
  const float alpha = fexp2(m - mn);
  const bool rowok = (MODE == 1) ? (vm != 0u) : true;
  const float mu = (rowok && mn > -1e29f) ? mn : 1e30f;
  float rs = 0.f;
#pragma unroll
  for (int kb = 0; kb < 2; ++kb)
#pragma unroll
    for (int i = 0; i < 16; ++i) {
      const float pv = fexp2(__builtin_fmaf(s[kb][i], SCL2, -mu));
      s[kb][i] = pv;
      rs += pv;
    }
  rs = xsum32(rs);
  l = l * alpha + rs;
  if (__ballot(mn > m) != 0ull) {
#pragma unroll
    for (int db = 0; db < 2; ++db)
#pragma unroll
      for (int i = 0; i < 16; ++i) o[db][i] *= alpha;
  }
  m = mn;
}
DI void online_softmax(f32x16* s, uint32_t vm, float& m, float& l, f32x16* o) {
  const unsigned long long ball = __ballot(vm == 0xffffffffu), bnone = __ballot(vm == 0u);
  if (ball == ~0ull) osm<0>(s, vm, m, l, o);
  else if ((ball | bnone) == ~0ull) osm<1>(s, vm, m, l, o);
  else osm<2>(s, vm, m, l, o);
}
DI uint32_t range_mask(int kpos0, int lo, int hi, int hh) {
  if (kpos0 >= lo && kpos0 + 63 <= hi) return 0xffffffffu;
  if (kpos0 > hi || kpos0 + 63 < lo) return 0u;
  uint32_t vm = 0;
#pragma unroll
  for (int kb = 0; kb < 2; ++kb)
#pragma unroll
    for (int i = 0; i < 16; ++i) {
      int kp = kpos0 + kb * 32 + hh * 4 + (i & 3) + 8 * (i >> 2);
      vm |= (kp >= lo && kp <= hi) ? (1u << (kb * 16 + i)) : 0u;
    }
  return vm;
}

struct KVRegs { u32x4 k, v; };
DI void kv_issue(KVRegs& r, const u16* kptr, long ldk, const u16* vptr, long ldv, int tid) {
  const int row = tid >> 3, seg = tid & 7;
  r.k = *(const u32x4*)(kptr + (long)row * ldk + seg * 8);
  r.v = *(const u32x4*)(vptr + (long)row * ldv + seg * 8);
}
DI void kv_write(const KVRegs& r, u16* Ks, u16* Vs, int tid) {
  const int row = tid >> 3, seg = tid & 7;
  *(u32x4*)(Ks + row * KVS + seg * 8) = r.k;
  *(u32x4*)(Vs + row * KVS + seg * 8) = r.v;
}
template <class TF, class BODY>
DI void kv_loop(u16* kvb, int ntiles, int tid, TF tf, BODY body) {
  KVRegs r;
  const u16 *kp, *vp;
  long ldk, ldv;
  __syncthreads();
  if (ntiles > 0) {
    tf(0, kp, ldk, vp, ldv);
    kv_issue(r, kp, ldk, vp, ldv, tid);
    kv_write(r, kvb, kvb + KVT, tid);
  }
  __syncthreads();
  for (int i = 0; i < ntiles; ++i) {
    const int cur = i & 1;
    if (i + 1 < ntiles) {
      tf(i + 1, kp, ldk, vp, ldv);
      kv_issue(r, kp, ldk, vp, ldv, tid);
    }
    body(i, kvb + cur * 2 * KVT, kvb + cur * 2 * KVT + KVT);
    if (i + 1 < ntiles) kv_write(r, kvb + (cur ^ 1) * 2 * KVT, kvb + (cur ^ 1) * 2 * KVT + KVT, tid);
    __syncthreads();
  }
}
DI void load_qf(bf16x8* qf, const u16* qrow, int hh) {
#pragma unroll
  for (int ks = 0; ks < 4; ++ks) qf[ks] = *(const bf16x8*)(qrow + ks * 16 + hh * 8);
}
DI bf16x8 rope_frag(bf16x8 f, const float* cs  , int hh) {
  u32x4 w = __builtin_bit_cast(u32x4, f), ow;
#pragma unroll
  for (int q = 0; q < 4; ++q) ow[q] = shxi<32>((int)w[q]);
  float mine[8], oth[8], res[8];
#pragma unroll
  for (int q = 0; q < 4; ++q) {
    mine[2 * q] = bflo(w[q]); mine[2 * q + 1] = bfhi(w[q]);
    oth[2 * q] = bflo(ow[q]); oth[2 * q + 1] = bfhi(ow[q]);
  }
  const float sg = hh ? 1.f : -1.f;
#pragma unroll
  for (int i = 0; i < 8; ++i) res[i] = mine[i] * cs[i] + sg * oth[i] * cs[8 + i];
  u32x4 r = {pack2(res[0], res[1]), pack2(res[2], res[3]), pack2(res[4], res[5]), pack2(res[6], res[7])};
  return __builtin_bit_cast(bf16x8, r);
}
DI void store_o(u16* yrow, const f32x16* o, float scale, int hh) {
#pragma unroll
  for (int db = 0; db < 2; ++db)
#pragma unroll
    for (int q = 0; q < 4; ++q) {
      u32x2 pk = {pack2(o[db][4 * q] * scale, o[db][4 * q + 1] * scale), pack2(o[db][4 * q + 2] * scale, o[db][4 * q + 3] * scale)};
      wt64(yrow + db * 32 + 8 * q + 4 * hh, pk);
    }
}

DI void kprep0_phase(int ws, PP p, char* shm) {
  const int tid = mytid(ws);
  float* fs = (float*)shm;
  u16* u = p->big;
  for (int item = blockIdx.x; item < 256; item += gridDim.x) {
    const int b = item >> 6, n = (item >> 1) & 31, hg = item & 1;
    const int cc = tid & 31, tg = tid >> 5, head = hg * 4 + (cc >> 3), dch = cc & 7;
    float sum[8];
#pragma unroll
    for (int e = 0; e < 8; ++e) sum[e] = 0.f;
#pragma unroll 1
    for (int tb = 0; tb < 16; tb += 8) {
    u32x4 wv[8];
#pragma unroll
    for (int t8 = 0; t8 < 8; ++t8) wv[t8] = *(const u32x4*)(u + ((long)b * SEQ + n * 256 + tg * 16 + tb + t8) * IN0 + 1536 + head * 64 + dch * 8);
#pragma unroll
    for (int t8 = 0; t8 < 8; ++t8) {
      const int tt = tb + t8;
      const int tok = n * 256 + tg * 16 + tt;
      u16* ptr = u + ((long)b * SEQ + tok) * IN0 + 1536 + head * 64 + dch * 8;
      u32x4 w = wv[t8], ow;
#pragma unroll
      for (int q = 0; q < 4; ++q) ow[q] = shxi<1>((int)w[q]);
      float mine[8], oth[8];
#pragma unroll
      for (int q = 0; q < 4; ++q) {
        mine[2 * q] = bflo(w[q]); mine[2 * q + 1] = bfhi(w[q]);
        oth[2 * q] = bflo(ow[q]); oth[2 * q + 1] = bfhi(ow[q]);
      }
      if (dch < 2) {
        const float* cs = p->rope + tok * 16;
        const float sg = dch ? 1.f : -1.f;
        float res[8];
#pragma unroll
        for (int i = 0; i < 8; ++i) res[i] = mine[i] * cs[i] + sg * oth[i] * cs[8 + i];
        u32x4 r = {pack2(res[0], res[1]), pack2(res[2], res[3]), pack2(res[4], res[5]), pack2(res[6], res[7])};
        wt128(ptr, r);
#pragma unroll
        for (int q = 0; q < 4; ++q) { mine[2 * q] = bflo(r[q]); mine[2 * q + 1] = bfhi(r[q]); }
      }
#pragma unroll
      for (int e = 0; e < 8; ++e) sum[e] += mine[e];
    }
    }
    __syncthreads();
#pragma unroll
    for (int e = 0; e < 8; ++e) fs[tg * 256 + cc * 8 + e] = sum[e];
    __syncthreads();
    if (tid < 256) {
      float t = 0.f;
#pragma unroll
      for (int g = 0; g < 16; ++g) t += fs[g * 256 + tid];
      wt32f(p->cent + (((long)b * 8 + hg * 4 + (tid >> 6)) * 32 + n) * 64 + (tid & 63), t * (1.f / 256.f));
    }
    __syncthreads();
  }
}

template <bool FINAL>
DI void lru_item(int ws, PP p, char* shm, int item) {
  const int tid = mytid(ws), wid = tid >> 6, lane = tid & 63, rl = lane & 31, hh = lane >> 5;
  const int b = item & 3, c = 127 - (item >> 2), t0 = c * 64;
  const u16* u = p->big;
  u16* XC = (u16*)shm + wid * KVT;
  {
    const int ch = wid * 64 + lane;
    const float w0 = p->conv_w[ch], w1 = p->conv_w[512 + ch], w2 = p->conv_w[1024 + ch], w3 = p->conv_w[1536 + ch], cb = p->conv_b[ch];
    const u16* up = u + ((long)b * SEQ + t0) * IN0 + ch;
    u16 raw[67];
#pragma unroll
    for (int i = 0; i < 67; ++i) raw[i] = (i >= 3 || t0 > 0) ? up[(long)(i - 3) * IN0] : (u16)0;
#pragma unroll
    for (int t = 0; t < 64; ++t) {
      const float xc = w0 * bf2f(raw[t]) + w1 * bf2f(raw[t + 1]) + w2 * bf2f(raw[t + 2]) + w3 * bf2f(raw[t + 3]) + cb;
      XC[t * KVS + lane] = f2bf(xc);
    }
  }
  __syncthreads();
  const u16* wat = p->wat + (long)wid * 4096;
  const u16* wxt = p->wat + (long)(8 + wid) * 4096;
#pragma unroll 1
  for (int nb = 0; nb < 2; ++nb) {
    f32x16 ar[2], ai[2];
#pragma unroll
    for (int mb = 0; mb < 2; ++mb)
#pragma unroll
      for (int i = 0; i < 16; ++i) { ar[mb][i] = 0.f; ai[mb][i] = 0.f; }
#pragma unroll
    for (int ks = 0; ks < 4; ++ks) {
      bf16x8 ba_ = *(const bf16x8*)(wat + (nb * 32 + rl) * 64 + ks * 16 + hh * 8);
      bf16x8 bx_ = *(const bf16x8*)(wxt + (nb * 32 + rl) * 64 + ks * 16 + hh * 8);
#pragma unroll
      for (int mb = 0; mb < 2; ++mb) {
        bf16x8 a = *(const bf16x8*)(XC + (mb * 32 + rl) * KVS + ks * 16 + hh * 8);
        ar[mb] = MFMA32(a, ba_, ar[mb]);
        ai[mb] = MFMA32(a, bx_, ai[mb]);
      }
    }
    const int j = nb * 32 + rl, chj = wid * 64 + j;
    const float baj = p->ba[chj], bxj = p->bx[chj];
    const float la = -8.f * log1pf(__expf(-p->lam[chj]));
#pragma unroll
    for (int mb = 0; mb < 2; ++mb)
#pragma unroll
      for (int i = 0; i < 16; ++i) {
        const int tok = mb * 32 + hh * 4 + (i & 3) + 8 * (i >> 2);
        const float xc = bf2f(XC[tok * KVS + j]);
        const float r = sigmoidf_(ar[mb][i] + baj), ig = sigmoidf_(ai[mb][i] + bxj);
        const float aa = __expf(r * la);
        ar[mb][i] = aa;
        ai[mb][i] = __builtin_amdgcn_sqrtf(__builtin_fmaf(-aa, aa, 1.f)) * ig * xc;
      }
    float carry = 0.f, atot = 1.f;
    if (FINAL) {
      const float* sm = p->lrusum + ((long)b * 128 * 512 + chj) * 2;
#pragma unroll 8
      for (int cp = 0; cp < c; ++cp) {
        float2 ab = *(const float2*)(sm + (long)cp * 1024);
        carry = ab.y + ab.x * carry;
      }
    }
#pragma unroll
    for (int mb = 0; mb < 2; ++mb)
#pragma unroll
      for (int q = 0; q < 4; ++q) {
        float P = 1.f, H = 0.f;
#pragma unroll
        for (int e = 0; e < 4; ++e) {
          const int idx = 4 * q + e;
          H = ar[mb][idx] * H + ai[mb][idx];
          P *= ar[mb][idx];
          ar[mb][idx] = P;
          ai[mb][idx] = H;
        }
        const float Po = shxf<32>(P), Ho = shxf<32>(H);
        const float A0 = hh ? Po : P, B0 = hh ? Ho : H, A1 = hh ? P : Po, B1 = hh ? H : Ho;
        const float mid = B0 + A0 * carry;
        const float cin = hh ? mid : carry;
        carry = B1 + A1 * mid;
        atot *= A0 * A1;
        if (FINAL) {
          const int tl0 = launder(hh * 4);
#pragma unroll
          for (int e = 0; e < 4; ++e) {
            const int idx = 4 * q + e;
            const int tok = mb * 32 + tl0 + e + 8 * q;
            const float hv = ai[mb][idx] + ar[mb][idx] * cin;
            const long trow = (long)b * SEQ + t0 + tok;
            const float g = bf2f(u[trow * IN0 + 512 + chj]);
            wt16(p->h + trow * DM + chj, f2bf(hv * gelu_tanh(g)));
          }
        }
      }
    if (!FINAL && hh == 0) {
      float2 ab = {atot, carry};
      wt64(p->lrusum + (((long)b * 128 + c) * 512 + chj) * 2, __builtin_bit_cast(u32x2, ab));
    }
  }
  __syncthreads();
}

DI int moba_off(int n) { return 256 * (31 * n - (n * (n - 1)) / 2); }

DI void moba_gate_item(int ws, PP p, char* shm, int item) {
  const int tid = mytid(ws);
  const int qb = 31 - (item >> 5), b = (item >> 3) & 3, h = item & 7;
  if (qb == 0) return;
  const int t0 = qb * 256;
  const u16* u = p->big;
  float* cs = (float*)shm;
  float* tv = (float*)(shm + 8192);
  int* ti = (int*)(shm + 11264);
  __syncthreads();
  for (int i = tid; i < qb * 64; i += NTHR) cs[i] = p->cent[((long)(b * 8 + h) * 32) * 64 + i];
  __syncthreads();
  const int ql = tid & 255, half = tid >> 8, tq = t0 + ql;
  const u16* qp = u + ((long)b * SEQ + tq) * IN0 + 1024 + h * 64;
  float q[64];
#pragma unroll
  for (int s8 = 0; s8 < 8; ++s8) {
    u32x4 w = *(const u32x4*)(qp + s8 * 8);
#pragma unroll
    for (int e = 0; e < 4; ++e) { q[s8 * 8 + 2 * e] = bflo(w[e]); q[s8 * 8 + 2 * e + 1] = bfhi(w[e]); }
  }
  {
    const float* rc = p->rope + tq * 16;
#pragma unroll
    for (int i = 0; i < 8; ++i) {
      float x1 = q[i], x2 = q[8 + i], cc = rc[i], sn = rc[8 + i];
      q[i] = bf2f(f2bf(x1 * cc - x2 * sn));
      q[8 + i] = bf2f(f2bf(x2 * cc + x1 * sn));
    }
  }
  float v0 = -INFINITY, v1 = -INFINITY, v2 = -INFINITY;
  int i0 = -1, i1 = -1, i2 = -1;
  for (int n = half; n < qb; n += 2) {
    const float4* cr = (const float4*)(cs + n * 64);
    float d = 0.f;
#pragma unroll
    for (int e = 0; e < 16; ++e) {
      float4 cv = cr[e];
      d += q[4 * e] * cv.x + q[4 * e + 1] * cv.y + q[4 * e + 2] * cv.z + q[4 * e + 3] * cv.w;
    }
    if (d > v0) { v2 = v1; i2 = i1; v1 = v0; i1 = i0; v0 = d; i0 = n; }
    else if (d > v1) { v2 = v1; i2 = i1; v1 = d; i1 = n; }
    else if (d > v2) { v2 = d; i2 = n; }
  }
  if (half == 1) {
    tv[ql * 3] = v0; tv[ql * 3 + 1] = v1; tv[ql * 3 + 2] = v2;
    ti[ql * 3] = i0; ti[ql * 3 + 1] = i1; ti[ql * 3 + 2] = i2;
  }
  __syncthreads();
  if (half == 0) {
#pragma unroll
    for (int e = 0; e < 3; ++e) {
      const float d = tv[ql * 3 + e];
      const int n = ti[ql * 3 + e];
      if (n >= 0) {
        if (d > v0 || (d == v0 && n < i0)) { v2 = v1; i2 = i1; v1 = v0; i1 = i0; v0 = d; i0 = n; }
        else if (d > v1 || (d == v1 && n < i1)) { v2 = v1; i2 = i1; v1 = d; i1 = n; }
        else if (d > v2 || (d == v2 && n < i2)) { v2 = d; i2 = n; }
      }
    }
  }
  int* lcnt = (int*)(shm + 14336);
  if (tid < 64) lcnt[tid] = 0;
  __syncthreads();
  int r0 = 0, r1 = 0, r2 = 0;
  if (half == 0) {
    if (i0 >= 0) r0 = atomicAdd(&lcnt[i0], 1);
    if (i1 >= 0) r1 = atomicAdd(&lcnt[i1], 1);
    if (i2 >= 0) r2 = atomicAdd(&lcnt[i2], 1);
  }
  __syncthreads();
  const int bh = b * 8 + h;
  if (tid < 32 && lcnt[tid] > 0) lcnt[32 + tid] = (int)atomicAdd(&p->mcnt[bh * 32 + tid], (unsigned)lcnt[tid]);
  __syncthreads();
  if (half == 0) {
    unsigned* lst = p->mlist + (long)bh * 126976;
    if (i0 >= 0) wt32u(lst + moba_off(i0) + lcnt[32 + i0] + r0, ((unsigned)tq << 2) | 0u);
    if (i1 >= 0) wt32u(lst + moba_off(i1) + lcnt[32 + i1] + r1, ((unsigned)tq << 2) | 1u);
    if (i2 >= 0) wt32u(lst + moba_off(i2) + lcnt[32 + i2] + r2, ((unsigned)tq << 2) | 2u);
  }
}

DI void moba_gather_phase(int ws, PP p, char* shm) {
  const int tid = mytid(ws), wid = tid >> 6, lane = tid & 63, rl = lane & 31, hh = lane >> 5;
  const u16* u = p->big;
  u16* kvb = (u16*)shm;
  int* pre = (int*)(shm + 120000);
  __syncthreads();
  {
    const int c0 = (int)((p->mcnt[2 * tid] + 255u) >> 8), c1 = (int)((p->mcnt[2 * tid + 1] + 255u) >> 8);
    int sc = c0 + c1;
#pragma unroll
    for (int d = 1; d < 64; d <<= 1) {
      const int o = __shfl_up(sc, d);
      if (lane >= d) sc += o;
    }
    int* wtot = pre + 1032;
    if (lane == 63) wtot[wid] = sc;
    __syncthreads();
    int base = 0;
    for (int w = 0; w < wid; ++w) base += wtot[w];
    const int excl = base + sc - (c0 + c1);
    if (tid == 0) pre[0] = 0;
    pre[2 * tid + 1] = excl + c0;
    pre[2 * tid + 2] = excl + c0 + c1;
  }
  __syncthreads();
  const int total = pre[1024];
  const int row = tid >> 3, seg = tid & 7;
  u32x4 kr[4], vr[4];
  auto locate = [&](int it, int& li, int& chunk) {
    int lo = 0, hi = 1024;
    while (hi - lo > 1) {
      const int mid = (lo + hi) >> 1;
      if (pre[mid] <= it) lo = mid; else hi = mid;
    }
    li = lo;
    chunk = it - pre[lo];
  };
  auto issue = [&](int li) {
    const int bh = li >> 5, n = li & 31, b = bh >> 3, h = bh & 7;
    const u16* kbase = u + ((long)b * SEQ + n * 256) * IN0 + 1536 + h * 64;
    const u16* vbase = p->vt + ((long)bh * 64) * SEQ + n * 256;
#pragma unroll
    for (int st = 0; st < 4; ++st) {
      kr[st] = *(const u32x4*)(kbase + (long)(st * 64 + row) * IN0 + seg * 8);
      vr[st] = *(const u32x4*)(vbase + (long)row * SEQ + st * 64 + seg * 8);
    }
  };
  int li = 0, chunk = 0;
  int* gslot = (int*)(shm + 150016);
  int it = grab(ws, p->ctr + 2, shm);
  if (it < total) { locate(it, li, chunk); issue(li); }
#pragma unroll 1
  while (it < total) {
    const int bh = li >> 5, n = li & 31, b = bh >> 3, h = bh & 7;
    const int cnt = (int)p->mcnt[li];
    __syncthreads();
#pragma unroll
    for (int st = 0; st < 4; ++st) {
      *(u32x4*)(kvb + st * 2 * KVT + row * KVS + seg * 8) = kr[st];
      *(u32x4*)(kvb + st * 2 * KVT + KVT + row * KVS + seg * 8) = vr[st];
    }
    const int e = chunk * 256 + wid * 32 + rl;
    const bool valid = e < cnt;
    const unsigned ent = p->mlist[(long)bh * 126976 + moba_off(n) + (valid ? e : 0)];
    const int tq = (int)(ent >> 2), slot = (int)(ent & 3u);
    bf16x8 qf[4];
    load_qf(qf, u + ((long)b * SEQ + tq) * IN0 + 1024 + h * 64, hh);
    qf[0] = rope_frag(qf[0], p->rope + tq * 16, hh);
    if (tid == 0) *gslot = (int)atomicAdd(p->ctr + 2, 1u);
    f32x16 o[2];
#pragma unroll
    for (int db = 0; db < 2; ++db)
#pragma unroll
      for (int i = 0; i < 16; ++i) o[db][i] = 0.f;
    float m = -1e30f, l = 0.f;
    __syncthreads();
    const int itn = *gslot;
    int lin = 0, chunkn = 0;
    if (itn < total) { locate(itn, lin, chunkn); issue(lin); }
#pragma unroll
    for (int st = 0; st < 4; ++st) {
      f32x16 s[2];
      qk_tile(kvb + st * 2 * KVT, qf, s, rl, hh);
      osm<0>(s, 0xffffffffu, m, l, o);
      pv_tile(kvb + st * 2 * KVT + KVT, s, o, rl, hh);
    }
    if (valid) {
      u16* pe = p->part + (((long)bh * SEQ + tq) * 3 + slot) * 72;
      store_o(pe + 8, o, 1.f / l, hh);
      if (hh == 0) { wt32f((float*)pe, m); wt32f((float*)pe + 1, l); }
    }
    li = lin; chunk = chunkn; it = itn;
  }
  __syncthreads();
}

DI void moba_own_item(int ws, PP p, char* shm, int item) {
  const int tid = mytid(ws), wid = tid >> 6, lane = tid & 63, rl = lane & 31, hh = lane >> 5;
  const int qb = 31 - (item >> 5), b = (item >> 3) & 3, h = item & 7;
  const int t0 = qb * 256;
  const u16* u = p->big;
  u16* kvb = (u16*)shm;
  const int tq = t0 + wid * 32 + rl;
  bf16x8 qf[4];
  load_qf(qf, u + ((long)b * SEQ + tq) * IN0 + 1024 + h * 64, hh);
  qf[0] = rope_frag(qf[0], p->rope + tq * 16, hh);
  f32x16 o[2];
#pragma unroll
  for (int db = 0; db < 2; ++db)
#pragma unroll
    for (int i = 0; i < 16; ++i) o[db][i] = 0.f;
  float m = -1e30f, l = 0.f;
  const u16* kbase = u + ((long)b * SEQ + t0) * IN0 + 1536 + h * 64;
  const u16* vbase = p->vt + ((long)(b * 8 + h) * 64) * SEQ + t0;
  auto tf = [&](int i, const u16*& kp, long& ldk, const u16*& vp, long& ldv) {
    kp = kbase + (long)i * 64 * IN0; ldk = IN0;
    vp = vbase + i * 64; ldv = SEQ;
  };
  auto body = [&](int i, const u16* Ks, const u16* Vs) {
    const uint32_t vm = range_mask(i * 64, 0, wid * 32 + rl, hh);
    if (__ballot(vm != 0) != 0ull) {
      f32x16 s[2];
      qk_tile(Ks, qf, s, rl, hh);
      online_softmax(s, vm, m, l, o);
      pv_tile(Vs, s, o, rl, hh);
    }
  };
  kv_loop(kvb, 4, tid, tf, body);
  const int nsl = qb < 3 ? qb : 3;
#pragma unroll 1
  for (int sl = 0; sl < nsl; ++sl) {
    const u16* pe = p->part + (((long)(b * 8 + h) * SEQ + tq) * 3 + sl) * 72;
    const float ms = ((const float*)pe)[0], ls = ((const float*)pe)[1];
    const float mn = fmaxf(m, ms);
    const float a = fexp2(m - mn), c = fexp2(ms - mn) * ls;
#pragma unroll
    for (int db = 0; db < 2; ++db)
#pragma unroll
      for (int q = 0; q < 4; ++q) {
        const u32x2 w = *(const u32x2*)(pe + 8 + db * 32 + 8 * q + 4 * hh);
        o[db][4 * q] = o[db][4 * q] * a + c * bflo(w[0]);
        o[db][4 * q + 1] = o[db][4 * q + 1] * a + c * bfhi(w[0]);
        o[db][4 * q + 2] = o[db][4 * q + 2] * a + c * bflo(w[1]);
        o[db][4 * q + 3] = o[db][4 * q + 3] * a + c * bfhi(w[1]);
      }
    l = l * a + c;
    m = mn;
  }
  store_o(p->h + ((long)b * SEQ + tq) * DM + 512 + h * 64, o, 1.f / l, hh);
}

DI void rope1_phase(int ws, PP p) {
  const int tid = mytid(ws);
  u16* u = p->big;
  for (int e = blockIdx.x * NTHR + tid; e < NT * 4; e += gridDim.x * NTHR) {
    const int trow = e >> 2, w = e & 3, pos = trow & (SEQ - 1);
    u16* ptr = u + (long)trow * IN1P + ((w & 2) ? 1536 : 1280) + (w & 1) * 64;
    u32x4 a = *(const u32x4*)ptr, bq = *(const u32x4*)(ptr + 8);
    const float* cs = p->rope + pos * 16;
    float x1[8], x2[8], r1[8], r2[8];
#pragma unroll
    for (int q = 0; q < 4; ++q) { x1[2 * q] = bflo(a[q]); x1[2 * q + 1] = bfhi(a[q]); x2[2 * q] = bflo(bq[q]); x2[2 * q + 1] = bfhi(bq[q]); }
#pragma unroll
    for (int i = 0; i < 8; ++i) { r1[i] = x1[i] * cs[i] - x2[i] * cs[8 + i]; r2[i] = x2[i] * cs[i] + x1[i] * cs[8 + i]; }
    u32x4 oa = {pack2(r1[0], r1[1]), pack2(r1[2], r1[3]), pack2(r1[4], r1[5]), pack2(r1[6], r1[7])};
    u32x4 ob = {pack2(r2[0], r2[1]), pack2(r2[2], r2[3]), pack2(r2[4], r2[5]), pack2(r2[6], r2[7])};
    wt128(ptr, oa);
    wt128(ptr + 8, ob);
  }
}
DI void cmpfin_phase(int ws, PP p, char* shm) {
  const int tid = mytid(ws);
  float* hid = (float*)shm;
  float* w2s = (float*)(shm + 4096);
  int kvl = -1;
  for (int it = blockIdx.x; it < 1024; it += gridDim.x) {
    const int kv = it >> 9, bg = (it >> 6) & 7, i0 = (it & 63) * 8;
    const int row = tid >> 6, n = tid & 63, i = i0 + row;
    const float* pq = p->pq + ((long)kv * 4096 + bg * 512) * 256;
    __syncthreads();
    if (kv != kvl) {
      const float* w2 = p->cmp_w2 + (long)kv * 128 * 64;
      for (int e = tid; e < 128 * 64; e += NTHR) w2s[e] = w2[e];
      kvl = kv;
    }
#pragma unroll
    for (int hf = 0; hf < 2; ++hf) {
      const int nn = n + hf * 64;
      float v = 0.f;
      if (i < 511) v = gelu_tanh(pq[(long)i * 256 + nn] + pq[(long)(i + 1) * 256 + 128 + nn] + p->cvec[kv * 128 + nn]);
      hid[row * 128 + nn] = v;
    }
    __syncthreads();
    float acc = 0.f;
#pragma unroll 8
    for (int k = 0; k < 128; ++k) acc += hid[row * 128 + k] * w2s[k * 64 + n];
    if (i < 511) {
      if (kv == 0) wt16(p->kcmp + ((long)bg * 512 + i) * 64 + n, f2bf(acc));
      else wt16(p->vcmpT + ((long)bg * 64 + n) * 512 + i, f2bf(acc));
    }
  }
  __syncthreads();
}

DI void nsa_item(int ws, PP p, char* shm, int item) {
  const int tid = mytid(ws), wid = tid >> 6, lane = tid & 63, rl = lane & 31, hh = lane >> 5;
  const int tt = 255 - (item >> 3), bg = item & 7, b = bg >> 1, g = bg & 1;
  const int t0 = tt * 32, tokl = wid * 4 + (rl >> 3), tok = t0 + tokl, r = rl & 7, hq = g * 8 + r;
  const u16* u = p->big;
  u16* kvb = (u16*)shm;
  float* impm = (float*)(shm + 36864);
  float* imps = (float*)(shm + 53760);
  float* vals = (float*)(shm + 70656);
  unsigned char* selb = (unsigned char*)(shm + 147456);
  uint32_t* un = (uint32_t*)(shm + 147968);
  int* tl = (int*)(shm + 148032);
  __syncthreads();
  for (int i = tid; i < 2 * 32 * 132; i += NTHR) impm[i] = 0.f;
  if (tid < 8) un[tid] = 0;
  const u16* qrow = u + ((long)b * SEQ + tok) * IN1P + hq * 64;
  bf16x8 qn[4], qr[4];
  load_qf(qn, qrow, hh);
  qr[0] = rope_frag(qn[0], p->rope + tok * 16, hh);
  qr[1] = qn[1]; qr[2] = qn[2]; qr[3] = qn[3];
  float gt[3];
#pragma unroll
  for (int br = 0; br < 3; ++br) gt[br] = sigmoidf_(bf2f(qrow[1792 - hq * 64 + hq * 3 + br]));
  f32x16 yacc[2], o[2];
#pragma unroll
  for (int db = 0; db < 2; ++db)
#pragma unroll
    for (int i = 0; i < 16; ++i) { yacc[db][i] = 0.f; o[db][i] = 0.f; }
  {
    const int nct = (t0 >> 10) + 1;
    const int cmax = (tok - 31) >> 4;
    const u16* kc = p->kcmp + (long)bg * 512 * 64;
    const u16* vc = p->vcmpT + (long)bg * 64 * 512;
    auto tf = [&](int i, const u16*& kp, long& ldk, const u16*& vp, long& ldv) {
      kp = kc + (long)i * 64 * 64; ldk = 64;
      vp = vc + i * 64; ldv = 512;
    };
    float m = -1e30f, l = 0.f;
    auto body1 = [&](int i, const u16* Ks, const u16* Vs) {
      const uint32_t vm = range_mask(i * 64, 0, cmax, hh);
      f32x16 s[2];
      qk_tile(Ks, qn, s, rl, hh);
      float mx = -1e30f;
#pragma unroll
      for (int kb = 0; kb < 2; ++kb)
#pragma unroll
        for (int ii = 0; ii < 16; ++ii) {
          float v = s[kb][ii] * SCL2;
          v = ((vm >> (kb * 16 + ii)) & 1u) ? v : -1e30f;
          s[kb][ii] = v;
          mx = fmaxf(mx, v);
        }
      mx = xmax32(mx);
      const float mn = fmaxf(m, mx);
      float rs = 0.f;
#pragma unroll
      for (int kb = 0; kb < 2; ++kb)
#pragma unroll
        for (int ii = 0; ii < 16; ++ii) rs += ((vm >> (kb * 16 + ii)) & 1u) ? fexp2(s[kb][ii] - mn) : 0.f;
      rs = xsum32(rs);
      l = l * fexp2(m - mn) + rs;
      m = mn;
    };
    kv_loop(kvb, nct, tid, tf, body1);
    const float invl = l > 0.f ? 1.f / l : 0.f;
    auto body2 = [&](int i, const u16* Ks, const u16* Vs) {
      const uint32_t vm = range_mask(i * 64, 0, cmax, hh);
      f32x16 s[2];
      qk_tile(Ks, qn, s, rl, hh);
#pragma unroll
      for (int kb = 0; kb < 2; ++kb)
#pragma unroll
        for (int ii = 0; ii < 16; ++ii) s[kb][ii] = ((vm >> (kb * 16 + ii)) & 1u) ? fexp2(__builtin_fmaf(s[kb][ii], SCL2, -m)) * invl : 0.f;
      pv_tile(Vs, s, o, rl, hh);
#pragma unroll
      for (int kb = 0; kb < 2; ++kb)
#pragma unroll
        for (int q4 = 0; q4 < 4; ++q4) {
          float mainv = s[kb][4 * q4] + s[kb][4 * q4 + 1] + s[kb][4 * q4 + 2] + 0.5f * s[kb][4 * q4 + 3];
          float sp = 0.5f * s[kb][4 * q4 + 3];
          mainv = sum8(mainv);
          sp = sum8(sp);
          if (r == 0) {
            const int j = 16 * i + 8 * kb + 2 * q4 + hh;
            impm[tokl * 132 + j] = mainv;
            imps[tokl * 132 + j + 1] = sp;
          }
        }
    };
    kv_loop(kvb, nct, tid, tf, body2);
#pragma unroll
    for (int db = 0; db < 2; ++db)
#pragma unroll
      for (int i = 0; i < 16; ++i) { yacc[db][i] = gt[0] * o[db][i]; o[db][i] = 0.f; }
  }
  __syncthreads();
  {
    const int tk = tid >> 4, jg = tid & 15, blk = (t0 + tk) >> 6;
    float v[8];
#pragma unroll
    for (int e = 0; e < 8; ++e) {
      const int j = jg * 8 + e;
      float x = impm[tk * 132 + j] + imps[tk * 132 + j];
      if (j == 0 || j == blk || j == blk - 1) x = 1e30f;
      if (j > blk) x = -INFINITY;
      v[e] = x;
      vals[tk * 132 + j] = x;
    }
    uint32_t key[8];
#pragma unroll
    for (int e = 0; e < 8; ++e) {
      const uint32_t uu = __float_as_uint(v[e]);
      key[e] = (uu & 0x80000000u) ? ~uu : (uu | 0x80000000u);
    }
    auto rowsum = [](int c) {
      c += __builtin_amdgcn_update_dpp(0, c, 0x128, 0xF, 0xF, true);
      c += __builtin_amdgcn_update_dpp(0, c, 0x124, 0xF, 0xF, true);
      c += __builtin_amdgcn_update_dpp(0, c, 0x122, 0xF, 0xF, true);
      c += __builtin_amdgcn_update_dpp(0, c, 0x121, 0xF, 0xF, true);
      return c;
    };
    uint32_t pfx = 0;
#pragma unroll 1
    for (int b = 31; b >= 0; --b) {
      const uint32_t cand = pfx | (1u << b);
      int c = 0;
#pragma unroll
      for (int e = 0; e < 8; ++e) c += (key[e] >= cand) ? 1 : 0;
      c = rowsum(c);
      if (c >= 16) pfx = cand;
    }
    int cgt = 0, teq = 0;
#pragma unroll
    for (int e = 0; e < 8; ++e) { cgt += (key[e] > pfx) ? 1 : 0; teq += (key[e] == pfx) ? 1 : 0; }
    cgt = rowsum(cgt);
    int tin = teq;
    tin += __builtin_amdgcn_update_dpp(0, tin, 0x111, 0xF, 0xF, true);
    tin += __builtin_amdgcn_update_dpp(0, tin, 0x112, 0xF, 0xF, true);
    tin += __builtin_amdgcn_update_dpp(0, tin, 0x114, 0xF, 0xF, true);
    tin += __builtin_amdgcn_update_dpp(0, tin, 0x118, 0xF, 0xF, true);
    int run = cgt + tin - teq;
    uint32_t bits = 0;
#pragma unroll
    for (int e = 0; e < 8; ++e) {
      const bool eq = key[e] == pfx;
      const bool sel = (key[e] > pfx) || (eq && run < 16);
      run += eq ? 1 : 0;
      bits |= (sel && (jg * 8 + e) <= blk) ? (1u << e) : 0u;
    }
    selb[tk * 16 + jg] = (unsigned char)bits;
    __syncthreads();
    if (tid < 32) {
      const uint32_t* w = (const uint32_t*)(selb + tid * 16);
      atomicOr(&un[0], w[0]); atomicOr(&un[1], w[1]); atomicOr(&un[2], w[2]); atomicOr(&un[3], w[3]);
    }
    __syncthreads();
    if (tid < 128) {
      const uint32_t u0 = un[0], u1 = un[1], u2 = un[2], u3 = un[3];
      const int w = tid >> 5, bpos = tid & 31;
      const uint32_t uw = w == 0 ? u0 : w == 1 ? u1 : w == 2 ? u2 : u3;
      const int below = (w > 0 ? __popc(u0) : 0) + (w > 1 ? __popc(u1) : 0) + (w > 2 ? __popc(u2) : 0);
      if ((uw >> bpos) & 1u) tl[below + __popc(uw & ((1u << bpos) - 1u))] = tid;
      if (tid == 0) un[4] = __popc(u0) + __popc(u1) + __popc(u2) + __popc(u3);
    }
    __syncthreads();
  }
  {
    const int ntl = (int)un[4];
    const u32x4 ms = *(const u32x4*)(selb + tokl * 16);
    const u16* kb_ = u + (long)b * SEQ * IN1P + 1280 + g * 64;
    const u16* vb_ = p->vt + (long)bg * 64 * SEQ;
    auto tf = [&](int i, const u16*& kp, long& ldk, const u16*& vp, long& ldv) {
      const int j = tl[i];
      kp = kb_ + (long)j * 64 * IN1P; ldk = IN1P;
      vp = vb_ + j * 64; ldv = SEQ;
    };
    float m = -1e30f, l = 0.f;
    auto body = [&](int i, const u16* Ks, const u16* Vs) {
      const int j = tl[i];
      const uint32_t w = j < 32 ? ms[0] : j < 64 ? ms[1] : j < 96 ? ms[2] : ms[3];
      uint32_t vm = ((w >> (j & 31)) & 1u) ? range_mask(j * 64, 0, tok, hh) : 0u;
      if (__ballot(vm != 0) != 0ull) {
        f32x16 s[2];
        qk_tile(Ks, qr, s, rl, hh);
        online_softmax(s, vm, m, l, o);
        pv_tile(Vs, s, o, rl, hh);
      }
    };
    {
      const int ng = (ntl + 3) >> 2;
      const int row = tid >> 3, seg = tid & 7;
      u32x4 kr[4], vr[4];
      auto issue = [&](int g4) {
#pragma unroll
        for (int t = 0; t < 4; ++t) {
          const int idx = g4 * 4 + t;
          if (idx < ntl) {
            const int j = tl[idx];
            kr[t] = *(const u32x4*)(kb_ + ((long)j * 64 + row) * IN1P + seg * 8);
            vr[t] = *(const u32x4*)(vb_ + (long)row * SEQ + j * 64 + seg * 8);
          }
        }
      };
      auto wr = [&](int g4, int buf) {
#pragma unroll
        for (int t = 0; t < 4; ++t) {
          if (g4 * 4 + t < ntl) {
            u16* kd = kvb + (buf * 4 + t) * 2 * KVT;
            *(u32x4*)(kd + row * KVS + seg * 8) = kr[t];
            *(u32x4*)(kd + KVT + row * KVS + seg * 8) = vr[t];
          }
        }
      };
      __syncthreads();
      issue(0);
      wr(0, 0);
      __syncthreads();
#pragma unroll 1
      for (int g4 = 0; g4 < ng; ++g4) {
        if (g4 + 1 < ng) issue(g4 + 1);
#pragma unroll 1
        for (int t = 0; t < 4; ++t) {
          const int idx = g4 * 4 + t;
          if (idx < ntl) {
            const u16* kd = kvb + ((g4 & 1) * 4 + t) * 2 * KVT;
            body(idx, kd, kd + KVT);
          }
        }
        if (g4 + 1 < ng) wr(g4 + 1, (g4 + 1) & 1);
        __syncthreads();
      }
    }
    const float sc = gt[1] / l;
#pragma unroll
    for (int db = 0; db < 2; ++db)
#pragma unroll
      for (int i = 0; i < 16; ++i) { yacc[db][i] += sc * o[db][i]; o[db][i] = 0.f; }
  }
  {
    const int jlo = (t0 > 511 ? t0 - 511 : 0) >> 6, jhi = (t0 + 31) >> 6;
    const u16* kb_ = u + (long)b * SEQ * IN1P + 1536 + g * 64;
    const u16* vb_ = p->vt + (long)(8 + bg) * 64 * SEQ;
    auto tf = [&](int i, const u16*& kp, long& ldk, const u16*& vp, long& ldv) {
      const int j = jlo + i;
      kp = kb_ + (long)j * 64 * IN1P; ldk = IN1P;
      vp = vb_ + j * 64; ldv = SEQ;
    };
    float m = -1e30f, l = 0.f;
    auto body = [&](int i, const u16* Ks, const u16* Vs) {
      const int j = jlo + i;
      const uint32_t vm = range_mask(j * 64, tok - 511, tok, hh);
      if (__ballot(vm != 0) != 0ull) {
        f32x16 s[2];
        qk_tile(Ks, qr, s, rl, hh);
        online_softmax(s, vm, m, l, o);
        pv_tile(Vs, s, o, rl, hh);
      }
    };
    kv_loop(kvb, jhi - jlo + 1, tid, tf, body);
    const float sc = gt[2] / l;
#pragma unroll
    for (int db = 0; db < 2; ++db)
#pragma unroll
      for (int i = 0; i < 16; ++i) yacc[db][i] += sc * o[db][i];
  }
  store_o(p->h + ((long)b * SEQ + tok) * DM + hq * 64, yacc, 1.f, hh);
}

__global__ void __launch_bounds__(NTHR) fwd_kernel(Params pk) {
  __shared__ __attribute__((aligned(1024))) char shm[151552];
  cg::grid_group grid = cg::this_grid();
  const PP p0 = (PP)__builtin_amdgcn_kernarg_segment_ptr();
  const int ws = __builtin_amdgcn_readfirstlane(threadIdx.x >> 6);
  prep_phase(ws, launder_p(p0), shm);
  grid.sync();
  auto half = [&](const int l, const int s) __attribute__((always_inline)) {
    {
      PP p = launder_p(p0);
      const float* modl = p->mod + (long)l * 4 * 9216;
      const float* xin = (l == 0 && s == 0) ? p->x : p->out;
      norm_phase(ws, xin, p->h, p->norm_g + (l * 3 + (s == 0 ? 0 : 2)) * DM, modl + (s == 0 ? 0 : 6) * DM, modl + (s == 0 ? 1 : 7) * DM);
      grid.sync();
      p = launder_p(p0);
      {
        const u16* W = p->wt1 + (long)(l * 2 + s) * 5632 * 1024;
        u16* act = p->big;
        auto desc = [&](int pm, int pn) { return TileDesc{p->h + (long)pm * 256 * DM, DM, 64, W + (long)pn * 256 * DM, DM, DM / 64}; };
        auto epi = [&](int pm, int pn, Acc8& acc, int wr, int wc, int fr, int fq) {
#pragma unroll
          for (int ai = 0; ai < 2; ++ai)
#pragma unroll
            for (int bj = 0; bj < 2; ++bj)
#pragma unroll
              for (int m = 0; m < 4; ++m)
#pragma unroll
                for (int j = 0; j < 4; ++j) {
                  float a = acc[ai][bj][m][0][j], b = acc[ai][bj][m][1][j];
                  float v = a * __builtin_amdgcn_rcpf(1.f + __expf(-a)) * b;
                  long row = (long)pm * 256 + ai * 128 + wr * 64 + m * 16 + fq * 4 + j;
                  int col = pn * 128 + (bj * 4 + wc) * 16 + fr;
                  wt16(act + row * DFF + col, f2bf(v));
                }
        };
        gemm_phase(ws, shm, NT / 256, 5632 / 256, desc, epi);
      }
      grid.sync();
      p = launder_p(p0);
      modl = p->mod + (long)l * 4 * 9216;
      xin = (l == 0 && s == 0) ? p->x : p->out;
      {
        const u16* W = p->wt2 + (long)(l * 2 + s) * 1024 * DFF;
        const float* gate = modl + (s == 0 ? 2 : 8) * DM;
        float* xo = p->out;
        auto desc = [&](int pm, int pn) { return TileDesc{p->big + (long)pm * 256 * DFF, DFF, 64, W + (long)pn * 256 * DFF, DFF, DFF / 64}; };
        auto epi = [&](int pm, int pn, Acc8& acc, int wr, int wc, int fr, int fq) {
          const int b = (pm * 256) >> 13;
#pragma unroll
          for (int bj = 0; bj < 2; ++bj)
#pragma unroll
            for (int n = 0; n < 2; ++n) {
              const int col = pn * 256 + bj * 128 + wc * 32 + n * 16 + fr;
              const float gv = 0.5f * gate[(long)b * 9216 + col];
#pragma unroll
              for (int ai = 0; ai < 2; ++ai)
#pragma unroll
                for (int m = 0; m < 4; ++m) {
#pragma unroll
                  for (int j = 0; j < 4; ++j) {
                    long row = (long)pm * 256 + ai * 128 + wr * 64 + m * 16 + fq * 4 + j;
                    wt32f(xo + row * DM + col, xin[row * DM + col] + gv * acc[ai][bj][m][n][j]);
                  }
                  asm volatile("" ::: "memory");
                }
            }
        };
        gemm_phase(ws, shm, NT / 256, DM / 256, desc, epi);
      }
      grid.sync();
      if (s == 0) {
        p = launder_p(p0);
        modl = p->mod + (long)l * 4 * 9216;
        norm_phase(ws, p->out, p->h, p->norm_g + (l * 3 + 1) * DM, modl + 3 * DM, modl + 4 * DM);
        grid.sync();
        if (l == 0) {
          p = launder_p(p0);
          {
            u16* uu = p->big;
            u16* vt = p->vt;
            auto desc = [&](int pm, int pn) { return TileDesc{p->h + (long)pm * 256 * DM, DM, 64, p->wtin0 + (long)pn * 256 * DM, DM, DM / 64}; };
            auto epi = [&](int pm, int pn, Acc8& acc, int wr, int wc, int fr, int fq) {
#pragma unroll
              for (int ai = 0; ai < 2; ++ai)
#pragma unroll
                for (int bj = 0; bj < 2; ++bj)
#pragma unroll
                  for (int m = 0; m < 4; ++m)
#pragma unroll
                    for (int n = 0; n < 2; ++n) {
                      const int col = pn * 256 + bj * 128 + wc * 32 + n * 16 + fr;
                      const long row0 = (long)pm * 256 + ai * 128 + wr * 64 + m * 16 + fq * 4;
                      const f32x4 v = acc[ai][bj][m][n];
                      if (col >= 2048) {
                        const int vc = col - 2048, bb = (int)(row0 >> 13), t = (int)(row0 & 8191);
                        u32x2 pk = {pack2(v[0], v[1]), pack2(v[2], v[3])};
                        wt64(vt + ((long)(bb * 8 + (vc >> 6)) * 64 + (vc & 63)) * SEQ + t, pk);
                      } else {
#pragma unroll
                        for (int j = 0; j < 4; ++j) wt16(uu + (row0 + j) * IN0 + col, f2bf(v[j]));
                      }
                    }
            };
            gemm_phase(ws, shm, NT / 256, IN0 / 256, desc, epi);
          }
          grid.sync();
          p = launder_p(p0);
          kprep0_phase(ws, p, shm);
          p = launder_p(p0);
#pragma unroll 1
          for (int it = grab(ws, p->ctr + 0, shm); it < 512;) {
            const int nx_ = grab_begin(ws, p->ctr + 0);
            lru_item<false>(ws, p, shm, it);
            it = grab_end(ws, nx_, shm);
          }
          grid.sync();
          p = launder_p(p0);
#pragma unroll 1
          for (int it = grab(ws, p->ctr + 1, shm); it < 1024;) {
            const int nx_ = grab_begin(ws, p->ctr + 1);
            moba_gate_item(ws, p, shm, it);
            it = grab_end(ws, nx_, shm);
          }
          grid.sync();
          p = launder_p(p0);
          moba_gather_phase(ws, p, shm);
          p = launder_p(p0);
#pragma unroll 1
          for (int it = grab(ws, p->ctr + 3, shm); it < 512;) {
            const int nx_ = grab_begin(ws, p->ctr + 3);
            lru_item<true>(ws, p, shm, it);
            it = grab_end(ws, nx_, shm);
          }
          grid.sync();
          p = launder_p(p0);
#pragma unroll 1
          for (int it = grab(ws, p->ctr + 4, shm); it < 1024;) {
            const int nx_ = grab_begin(ws, p->ctr + 4);
            moba_own_item(ws, p, shm, it);
            it = grab_end(ws, nx_, shm);
          }
          grid.sync();
        }
        if (l == 1) {
          p = launder_p(p0);
          {
            u16* uu = p->big;
            u16* vt = p->vt;
            auto desc = [&](int pm, int pn) { return TileDesc{p->h + (long)pm * 256 * DM, DM, 64, p->wtin1 + (long)pn * 256 * DM, DM, DM / 64}; };
            auto epi = [&](int pm, int pn, Acc8& acc, int wr, int wc, int fr, int fq) {
#pragma unroll
              for (int ai = 0; ai < 2; ++ai)
#pragma unroll
                for (int bj = 0; bj < 2; ++bj) {
                  const int c64 = (pn * 256 + bj * 128 + wc * 32) >> 6;
                  const bool isv = (c64 == 22 || c64 == 23 || c64 == 26 || c64 == 27);
#pragma unroll
                  for (int m = 0; m < 4; ++m)
#pragma unroll
                    for (int n = 0; n < 2; ++n) {
                      const int col = pn * 256 + bj * 128 + wc * 32 + n * 16 + fr;
                      const long row0 = (long)pm * 256 + ai * 128 + wr * 64 + m * 16 + fq * 4;
                      const f32x4 v = acc[ai][bj][m][n];
                      if (isv) {
                        const int bb = (int)(row0 >> 13), t = (int)(row0 & 8191);
                        const int which = c64 >= 26 ? 1 : 0, gg = c64 & 1;
                        u32x2 pk = {pack2(v[0], v[1]), pack2(v[2], v[3])};
                        wt64(vt + ((long)(which * 8 + bb * 2 + gg) * 64 + (col & 63)) * SEQ + t, pk);
                      } else if (col < IN1) {
#pragma unroll
                        for (int j = 0; j < 4; ++j) wt16(uu + (row0 + j) * IN1P + col, f2bf(v[j]));
                      }
                    }
                }
            };
            gemm_phase(ws, shm, NT / 256, IN1P / 256, desc, epi);
          }
          grid.sync();
          p = launder_p(p0);
          rope1_phase(ws, p);
          p = launder_p(p0);
          {
            float* pq = p->pq;
            auto desc = [&](int pm, int pn) {
              const int kv = pm >> 4, rr = pm & 15, bg = rr >> 1, j0 = (rr & 1) * 256;
              return TileDesc{p->big + ((long)(bg >> 1) * SEQ + 16 * j0) * IN1P + 1024 + kv * 128 + (bg & 1) * 64, 16 * IN1P, IN1P,
                              p->wtcmp + (long)kv * 256 * 1024, 1024, 16};
            };
            auto epi = [&](int pm, int pn, Acc8& acc, int wr, int wc, int fr, int fq) {
#pragma unroll
              for (int ai = 0; ai < 2; ++ai)
#pragma unroll
                for (int bj = 0; bj < 2; ++bj)
#pragma unroll
                  for (int m = 0; m < 4; ++m)
#pragma unroll
                    for (int n = 0; n < 2; ++n)
#pragma unroll
                      for (int j = 0; j < 4; ++j)
                        wt32f(pq + ((long)pm * 256 + ai * 128 + wr * 64 + m * 16 + fq * 4 + j) * 256 + bj * 128 + wc * 32 + n * 16 + fr, acc[ai][bj][m][n][j]);
            };
            gemm_phase(ws, shm, 32, 1, desc, epi);
          }
          grid.sync();
          p = launder_p(p0);
          cmpfin_phase(ws, p, shm);
          grid.sync();
          p = launder_p(p0);
#pragma unroll 1
          for (int it = grab(ws, p->ctr + 5, shm); it < 2048;) {
            const int nx_ = grab_begin(ws, p->ctr + 5);
            nsa_item(ws, p, shm, it);
            it = grab_end(ws, nx_, shm);
          }
          grid.sync();
        }
        {
          p = launder_p(p0);
          modl = p->mod + (long)l * 4 * 9216;
          const u16* W = l == 0 ? p->wtout0 : p->wtout1;
          const float* gate = modl + 5 * DM;
          float* xo = p->out;
          auto desc = [&](int pm, int pn) { return TileDesc{p->h + (long)pm * 256 * DM, DM, 64, W + (long)pn * 256 * DM, DM, DM / 64}; };
          auto epi = [&](int pm, int pn, Acc8& acc, int wr, int wc, int fr, int fq) {
            const int b = (pm * 256) >> 13;
#pragma unroll
            for (int bj = 0; bj < 2; ++bj)
#pragma unroll
              for (int n = 0; n < 2; ++n) {
                const int col = pn * 256 + bj * 128 + wc * 32 + n * 16 + fr;
                const float gv = gate[(long)b * 9216 + col];
#pragma unroll
                for (int ai = 0; ai < 2; ++ai)
#pragma unroll
                  for (int m = 0; m < 4; ++m) {
#pragma unroll
                    for (int j = 0; j < 4; ++j) {
                      long row = (long)pm * 256 + ai * 128 + wr * 64 + m * 16 + fq * 4 + j;
                      wt32f(xo + row * DM + col, xo[row * DM + col] + gv * acc[ai][bj][m][n][j]);
                    }
                    asm volatile("" ::: "memory");
                  }
              }
          };
          gemm_phase(ws, shm, NT / 256, DM / 256, desc, epi);
          grid.sync();
        }
      }
    }
  };
  half(0, 0);
  half(0, 1);
  half(1, 0);
  half(1, 1);
  { PP p = launder_p(p0); final_norm_phase(ws, p->out, p->fng); }
}

extern "C" void kernel_launch(void* const* d_in, const int* in_sizes, int n_in, void* d_out, int out_size, void* d_ws, size_t ws_size,
                              hipStream_t stream) {
  Params p;
  memset(&p, 0, sizeof(p));
  const float** fp = (const float**)&p.x;
  for (int i = 0; i < 22; ++i) fp[i] = (const float*)d_in[i];
  p.out = (float*)d_out;
  char* ws = (char*)d_ws;
  size_t off = 0;
  auto take = [&](size_t bytes) { char* r = ws + off; off += (bytes + 255) & ~(size_t)255; return r; };
  p.wt1 = (u16*)take((size_t)4 * 5632 * 1024 * 2);
  p.wt2 = (u16*)take((size_t)4 * 1024 * DFF * 2);
  p.wtin0 = (u16*)take((size_t)IN0 * 1024 * 2);
  p.wtout0 = (u16*)take((size_t)1024 * 1024 * 2);
  p.wtin1 = (u16*)take((size_t)IN1P * 1024 * 2);
  p.wtout1 = (u16*)take((size_t)1024 * 1024 * 2);
  p.wtcmp = (u16*)take((size_t)2 * 256 * 1024 * 2);
  p.wat = (u16*)take((size_t)2 * 8 * 64 * 64 * 2);
  p.mod = (float*)take((size_t)2 * 4 * 9216 * 4);
  p.rope = (float*)take((size_t)SEQ * 16 * 4);
  p.cvec = (float*)take(2 * 128 * 4);
  p.cent = (float*)take((size_t)4 * 8 * 32 * 64 * 4);
  p.lrusum = (float*)take((size_t)4 * 128 * 512 * 2 * 4);
  p.pq = (float*)take((size_t)2 * 4096 * 256 * 4);
  p.h = (u16*)take((size_t)NT * 1024 * 2);
  p.big = (u16*)take((size_t)NT * DFF * 2);
  p.vt = (u16*)take((size_t)NT * 512 * 2);
  p.kcmp = (u16*)take((size_t)8 * 512 * 64 * 2);
  p.vcmpT = (u16*)take((size_t)8 * 512 * 64 * 2);
  p.mcnt = (unsigned*)take(1024 * 4);
  p.ctr = (unsigned*)take(64 * 4);
  p.mlist = (unsigned*)take((size_t)32 * 126976 * 4);
  p.part = (u16*)take((size_t)NT * 8 * 3 * 144);
  int nj = 0, t0 = 0;
  auto add = [&](const float* src, u16* dst, int K, int N, int ldn, int perm, int npad) {
    TJob& j = p.jobs[nj++];
    j.src = src; j.dst = dst; j.K = K; j.N = N; j.ldn = ldn; j.perm = perm; j.tile0 = t0; j.ntn = npad / 64;
    t0 += (K / 64) * ((npad / 64 + 3) / 4);
  };
  for (int i = 0; i < 4; ++i) add(p.ffn_w1 + (size_t)i * 1024 * 5632, p.wt1 + (size_t)i * 5632 * 1024, 1024, 5632, 5632, 1, 5632);
  for (int i = 0; i < 4; ++i) add(p.ffn_w2 + (size_t)i * DFF * 1024, p.wt2 + (size_t)i * 1024 * DFF, DFF, 1024, 1024, 0, 1024);
  add(p.mix0_in_w, p.wtin0, 1024, IN0, IN0, 0, IN0);
  add(p.mix0_out_w, p.wtout0, 1024, 1024, 1024, 0, 1024);
  add(p.mix1_in_w, p.wtin1, 1024, IN1, IN1, 0, IN1P);
  add(p.mix1_out_w, p.wtout1, 1024, 1024, 1024, 0, 1024);
  for (int kv = 0; kv < 2; ++kv)
    for (int hf = 0; hf < 2; ++hf)
      add(p.cmp_w1 + ((size_t)kv * 2048 + hf * 1024) * 128, p.wtcmp + ((size_t)kv * 256 + hf * 128) * 1024, 1024, 128, 128, 0, 128);
  for (int n = 0; n < 8; ++n) add(p.wa + (size_t)n * 4096, p.wat + (size_t)n * 4096, 64, 64, 64, 0, 64);
  for (int n = 0; n < 8; ++n) add(p.wx + (size_t)n * 4096, p.wat + (size_t)(8 + n) * 4096, 64, 64, 64, 0, 64);
  p.njobs = nj;
  p.ntr_tiles = t0;

  static int grid_blocks = 0;
  if (!grid_blocks) {
    int dev = 0, cus = 0, per_cu = 0;
    (void)hipGetDevice(&dev);
    (void)hipDeviceGetAttribute(&cus, hipDeviceAttributeMultiprocessorCount, dev);
    (void)hipOccupancyMaxActiveBlocksPerMultiprocessor(&per_cu, fwd_kernel, NTHR, 0);
    if (per_cu < 1) per_cu = 1;
    grid_blocks = cus * 1;
  }
  void* args[] = {&p};
  hipError_t e = hipLaunchCooperativeKernel((void*)fwd_kernel, dim3(grid_blocks), dim3(NTHR), args, 0, stream);
  if (e != hipSuccess) fprintf(stderr, "cooperative launch failed: %s (grid %d)\n", hipGetErrorString(e), grid_blocks);
}
```

```cpp
#include <hip/hip_runtime.h>
#include <hip/hip_cooperative_groups.h>
#include <stdint.h>
#include <stdio.h>
#include <string.h>
namespace cg = cooperative_groups;

typedef unsigned short u16;
typedef __attribute__((ext_vector_type(8))) short bf16x8;
typedef __attribute__((ext_vector_type(4))) short s16x4;
typedef __attribute__((ext_vector_type(4))) float f32x4;
typedef __attribute__((ext_vector_type(16))) float f32x16;
typedef __attribute__((ext_vector_type(4))) int i32x4;
typedef __attribute__((ext_vector_type(4))) unsigned u32x4;
typedef __attribute__((ext_vector_type(2))) unsigned u32x2;

#define DI __device__ __forceinline__
#define MFMA32(a, b, c) __builtin_amdgcn_mfma_f32_32x32x16_bf16((a), (b), (c), 0, 0, 0)
#define MFMA16(a, b, c) __builtin_amdgcn_mfma_f32_16x16x32_bf16((a), (b), (c), 0, 0, 0)

constexpr int NB = 4, SEQ = 8192, DM = 1024, NT = NB * SEQ, DFF = 2816;
constexpr int IN0 = 2560, IN1 = 1840, IN1P = 2048;
constexpr int NTHR = 512;
constexpr int NJOBS = 32;

struct TJob { const float* src; u16* dst; int K, N, ldn, perm, tile0, ntn; };

struct Params {
  const float *x, *c, *mod_w, *mod_b, *norm_g, *ffn_w1, *ffn_w2, *mix0_in_w, *conv_w, *conv_b, *wa, *ba, *wx, *bx, *lam,
      *mix0_out_w, *mix1_in_w, *cmp_pos, *cmp_w1, *cmp_w2, *mix1_out_w, *fng;
  float* out;
  u16 *wt1, *wt2, *wtin0, *wtout0, *wtin1, *wtout1, *wtcmp, *wat;
  float *mod, *rope, *cvec, *cent, *lrusum, *pq;
  u16 *h, *big, *vt, *kcmp, *vcmpT;
  unsigned *mcnt, *mlist, *ctr, *xcnt, *lbar;
  u16* part;
  TJob jobs[NJOBS];
  int njobs, ntr_tiles;
};

typedef const __attribute__((address_space(4))) Params* PP;
DI PP launder_p(PP p) { asm volatile("" : "+s"(p)); return p; }

typedef __attribute__((ext_vector_type(2))) float f32x2_;
typedef __attribute__((ext_vector_type(2))) __bf16 bf16x2_;
DI uint32_t pack2(float a, float b) {
  f32x2_ v = {a, b};
  return __builtin_bit_cast(uint32_t, __builtin_convertvector(v, bf16x2_));
}
DI u16 f2bf(float f) { return (u16)(pack2(f, 0.f) & 0xffffu); }
DI float bf2f(u16 h) { return __uint_as_float(((uint32_t)h) << 16); }
DI float bflo(uint32_t w) { return __uint_as_float(w << 16); }
DI float bfhi(uint32_t w) { return __uint_as_float(w & 0xffff0000u); }

DI void wt16(u16* p, u16 v) { *p = v; }
DI void wt32u(unsigned* p, unsigned v) { *p = v; }
DI void wt32f(float* p, float v) { *p = v; }
DI void wt64(void* p, u32x2 v) { *(u32x2*)p = v; }
DI void wt128(void* p, u32x4 v) { *(u32x4*)p = v; }
DI bf16x8 pack8(float a0, float a1, float a2, float a3, float a4, float a5, float a6, float a7) {
  u32x4 p;
  asm volatile("v_cvt_pk_bf16_f32 %0, %4, %5\n\tv_cvt_pk_bf16_f32 %1, %6, %7\n\tv_cvt_pk_bf16_f32 %2, %8, %9\n\tv_cvt_pk_bf16_f32 %3, %10, %11\n\ts_nop 1"
               : "=&v"(p[0]), "=&v"(p[1]), "=&v"(p[2]), "=&v"(p[3])
               : "v"(a0), "v"(a1), "v"(a2), "v"(a3), "v"(a4), "v"(a5), "v"(a6), "v"(a7));
  return __builtin_bit_cast(bf16x8, p);
}
DI int launder(int v) { asm volatile("" : "+v"(v)); return v; }
DI int lane_id_() { int l = __builtin_amdgcn_mbcnt_hi(-1, __builtin_amdgcn_mbcnt_lo(-1, 0)); asm volatile("" : "+v"(l)); return l; }
DI int grab_begin(int ws, unsigned* ctr) {
  int v = 0;
  if (ws == 0 && lane_id_() == 0) v = (int)atomicAdd(ctr, 1u);
  return v;
}
DI int grab_end(int ws, int v, char* shm) {
  int* slot = (int*)(shm + 150016);
  __syncthreads();
  if (ws == 0 && lane_id_() == 0) *slot = v;
  __syncthreads();
  return *slot;
}
DI int grab(int ws, unsigned* ctr, char* shm) { return grab_end(ws, grab_begin(ws, ctr), shm); }
DI int mytid(int ws) { return launder(ws * 64 + lane_id_()); }
template <int M> DI int shxi(int v) {
  if (M < 32) return __builtin_amdgcn_ds_swizzle(v, (M << 10) | 0x1f);
  auto r = __builtin_amdgcn_permlane32_swap((unsigned)v, (unsigned)v, false, false);
  return (int)(r[0] ^ r[1] ^ (unsigned)v);
}
DI float sum8(float v) {
  v += __int_as_float(__builtin_amdgcn_update_dpp(0, __float_as_int(v), 0xB1, 0xF, 0xF, true));
  v += __int_as_float(__builtin_amdgcn_update_dpp(0, __float_as_int(v), 0x4E, 0xF, 0xF, true));
  v += __int_as_float(__builtin_amdgcn_update_dpp(0, __float_as_int(v), 0x141, 0xF, 0xF, true));
  return v;
}
DI float xmax32(float v) {
  auto r = __builtin_amdgcn_permlane32_swap(__float_as_uint(v), __float_as_uint(v), false, false);
  return fmaxf(__uint_as_float(r[0]), __uint_as_float(r[1]));
}
DI float xsum32(float v) {
  auto r = __builtin_amdgcn_permlane32_swap(__float_as_uint(v), __float_as_uint(v), false, false);
  return __uint_as_float(r[0]) + __uint_as_float(r[1]);
}
template <int M> DI float shxf(float v) { return __int_as_float(shxi<M>(__float_as_int(v))); }
DI float sigmoidf_(float x) { return __builtin_amdgcn_rcpf(1.f + __expf(-x)); }
DI float gelu_tanh(float x) {
  const float z = 0.7978845608028654f * (x + 0.044715f * x * x * x);
  const float th = 1.f - 2.f * __builtin_amdgcn_rcpf(1.f + __expf(2.f * z));
  return 0.5f * x * (1.f + th);
}

template <int KS> DI int lds_byte(int r, int c) {
  int st = (r >> 4) * KS + (c >> 5), ob = (r & 15) * 64 + (c & 31) * 2;
  return st * 1024 + (ob ^ (((ob >> 9) & 1) << 5));
}
template <int KS> DI void stage_rc(int b, int& R, int& C) {
  int st = b >> 10, sb = b & 1023, swz = sb ^ (((sb >> 9) & 1) << 5);
  R = (st / KS) * 16 + swz / 64;
  C = (st % KS) * 32 + (swz % 64) / 2;
}
#define WAIT_V(n) asm volatile("s_waitcnt vmcnt(%0)" ::"n"(n) : "memory")

struct TileDesc { const u16* a; long lda, kts; const u16* b; long ldb; int nt; };

typedef f32x4 Acc8[2][2][4][2];
template <class Epi>
DI void gemm_tile(int ws, char* shmc, const TileDesc& td, Epi& epi, int pm, int pn, bool first, bool has_next, const TileDesc& tdn) {
  constexpr int BK = 64, HALF = 128, HT = HALF * BK;
  u16* shm = (u16*)shmc;
  const int tid = mytid(ws), wid = tid >> 6, lane = tid & 63, wr = wid >> 2, wc = wid & 3, fr = lane & 15, fq = lane >> 4;
  const u16* ABASE = td.a;
  const u16* BBASE = td.b;
  const long lda = td.lda, kts = td.kts, ldb = td.ldb;
  const int nt = td.nt;
#define SA(b, h) (shm + ((b) * 2 + (h)) * HT)
#define SB(b, h) (shm + (4 + (b) * 2 + (h)) * HT)
  unsigned voffA, voffB;
  {
    int r0_, c0_;
    stage_rc<2>(tid * 16, r0_, c0_);
    voffA = (unsigned)(r0_ * (int)lda + c0_);
    voffB = (unsigned)(r0_ * (int)ldb + c0_);
  }
#define STAGE_A(P, hf, kt)                                                                                     \
  do {                                                                                                         \
    _Pragma("unroll") for (int _i = 0; _i < 2; ++_i)                                                           \
      __builtin_amdgcn_global_load_lds((const unsigned*)((ABASE + (long)((hf) * HALF + 64 * _i) * lda + (long)(kt) * kts) + voffA), \
                                       (__attribute__((address_space(3))) unsigned*)((char*)(P) + tid * 16 + _i * 8192), 16, 0, 0); \
  } while (0)
#define STAGE_B(P, hf, kt)                                                                                     \
  do {                                                                                                         \
    _Pragma("unroll") for (int _i = 0; _i < 2; ++_i)                                                           \
      __builtin_amdgcn_global_load_lds((const unsigned*)((BBASE + (long)((hf) * HALF + 64 * _i) * ldb + (long)(kt) * BK) + voffB), \
                                       (__attribute__((address_space(3))) unsigned*)((char*)(P) + tid * 16 + _i * 8192), 16, 0, 0); \
  } while (0)
#define LDA_(dst, b, h)                                    \
  _Pragma("unroll") for (int m = 0; m < 4; ++m)            \
  _Pragma("unroll") for (int k = 0; k < 2; ++k)            \
      dst[m][k] = *(const bf16x8*)((const char*)SA(b, h) + lds_byte<2>(wr * 64 + m * 16 + fr, k * 32 + fq * 8))
#define LDB_(dst, b, h)                                    \
  _Pragma("unroll") for (int n = 0; n < 2; ++n)            \
  _Pragma("unroll") for (int k = 0; k < 2; ++k)            \
      dst[n][k] = *(const bf16x8*)((const char*)SB(b, h) + lds_byte<2>(wc * 32 + n * 16 + fr, k * 32 + fq * 8))
#define MMA_(ai, bj, AT, BT)                                                           \
  do {                                                                                 \
    __builtin_amdgcn_s_setprio(1);                                                     \
    _Pragma("unroll") for (int m = 0; m < 4; ++m)                                      \
    _Pragma("unroll") for (int n = 0; n < 2; ++n)                                      \
    _Pragma("unroll") for (int k = 0; k < 2; ++k)                                      \
        acc[ai][bj][m][n] = MFMA16(AT[m][k], BT[n][k], acc[ai][bj][m][n]);             \
    __builtin_amdgcn_s_setprio(0);                                                     \
  } while (0)
#define WV(n) asm volatile("s_waitcnt vmcnt(" #n ")" ::: "memory")
#define WL(n) asm volatile("s_waitcnt lgkmcnt(" #n ")" ::: "memory")
#define BAR __builtin_amdgcn_s_barrier()
#define SCHED __builtin_amdgcn_sched_barrier(0)
  Acc8 acc;
#pragma unroll
  for (int a = 0; a < 2; ++a)
#pragma unroll
    for (int b = 0; b < 2; ++b)
#pragma unroll
      for (int m = 0; m < 4; ++m)
#pragma unroll
        for (int n = 0; n < 2; ++n) acc[a][b][m][n] = f32x4{0.f, 0.f, 0.f, 0.f};
  bf16x8 At[4][2], B0[2][2], B1[2][2];
  if (first) {
    STAGE_B(SB(0, 0), 0, 0); STAGE_A(SA(0, 0), 0, 0);
    STAGE_B(SB(0, 1), 1, 0); STAGE_A(SA(0, 1), 1, 0);
  }
  if (wr == 1) BAR;
  WV(4); BAR;
  STAGE_B(SB(1, 0), 0, 1); STAGE_A(SA(1, 0), 0, 1); STAGE_B(SB(1, 1), 1, 1);
  WV(6); BAR;
  for (int t = 0; t < nt - 2; t += 2) {
    LDB_(B0, 0, 0); SCHED; LDA_(At, 0, 0); STAGE_A(SA(1, 1), 1, t + 1);
    WL(8); BAR; WL(0); MMA_(0, 0, At, B0); BAR; SCHED;
    LDB_(B1, 0, 1); STAGE_B(SB(0, 0), 0, t + 2);
    BAR; WL(0); MMA_(0, 1, At, B1); BAR;
    LDA_(At, 0, 1); STAGE_A(SA(0, 0), 0, t + 2);
    BAR; WL(0); MMA_(1, 0, At, B0); BAR; SCHED;
    STAGE_B(SB(0, 1), 1, t + 2);
    WV(6); BAR; MMA_(1, 1, At, B1); BAR;
    LDB_(B0, 1, 0); SCHED; LDA_(At, 1, 0); STAGE_A(SA(0, 1), 1, t + 2);
    WL(8); BAR; WL(0); MMA_(0, 0, At, B0); BAR; SCHED;
    LDB_(B1, 1, 1); STAGE_B(SB(1, 0), 0, t + 3);
    BAR; WL(0); MMA_(0, 1, At, B1); BAR;
    LDA_(At, 1, 1); STAGE_A(SA(1, 0), 0, t + 3);
    BAR; WL(0); MMA_(1, 0, At, B0); BAR; SCHED;
    STAGE_B(SB(1, 1), 1, t + 3);
    WV(6); BAR; MMA_(1, 1, At, B1); BAR;
  }
  { LDB_(B0, 0, 0); LDA_(At, 0, 0); STAGE_A(SA(1, 1), 1, nt - 1);
    BAR; WL(0); MMA_(0, 0, At, B0); BAR;
    LDB_(B1, 0, 1); BAR; WL(0); MMA_(0, 1, At, B1); BAR;
    LDA_(At, 0, 1); WV(4); BAR; WL(0); MMA_(1, 0, At, B0); MMA_(1, 1, At, B1); BAR; }
  { LDB_(B0, 1, 0); LDA_(At, 1, 0); WV(2); BAR; WL(0); MMA_(0, 0, At, B0); BAR;
    LDB_(B1, 1, 1); WV(0); BAR; WL(0); MMA_(0, 1, At, B1); BAR;
    LDA_(At, 1, 1); BAR; WL(0); MMA_(1, 0, At, B0); MMA_(1, 1, At, B1); BAR; }
  if (wr == 0) BAR;
  if (has_next) {
    ABASE = tdn.a;
    BBASE = tdn.b;
    STAGE_B(SB(0, 0), 0, 0); STAGE_A(SA(0, 0), 0, 0);
    STAGE_B(SB(0, 1), 1, 0); STAGE_A(SA(0, 1), 1, 0);
  }
  epi(pm, pn, acc, wr, wc, fr, fq);
  asm volatile("s_waitcnt vmcnt(0)" ::: "memory");
  __syncthreads();
#undef SA
#undef SB
#undef STAGE_A
#undef STAGE_B
#undef LDA_
#undef LDB_
#undef MMA_
#undef WV
#undef WL
#undef BAR
#undef SCHED
}

template <class Desc, class Epi>
DI void gemm_phase(int ws, int gx, int gslot, char* shm, int nM, int nN, Desc desc, Epi epi) {
  const int ntiles = nM * nN;
  const int G = gridDim.x, bid = blockIdx.x;
  const bool xcdmap = (G % 8 == 0) && (ntiles % 8 == 0);
  const int per = ntiles / 8, slots = G / 8;
  auto tile_at = [&](int i, int& pm, int& pn) -> bool {
    int t;
    if (xcdmap) {
      int lt = gslot + slots * i;
      if (lt >= per) return false;
      t = gx * per + lt;
    } else {
      t = bid + G * i;
      if (t >= ntiles) return false;
    }
    const int WGM = 8;
    int nig = WGM * nN, gid = t / nig, fm = gid * WGM, gsz = min(nM - fm, WGM);
    pm = fm + ((t % nig) % gsz);
    pn = (t % nig) / gsz;
    return true;
  };
  __syncthreads();
  int pm, pn;
  if (!tile_at(0, pm, pn)) return;
  TileDesc td = desc(pm, pn);
  bool first = true;
  for (int i = 0;; ++i) {
    int pmn = 0, pnn = 0;
    const bool more = tile_at(i + 1, pmn, pnn);
    TileDesc tdn = td;
    if (more) tdn = desc(pmn, pnn);
    gemm_tile(ws, shm, td, epi, pm, pn, first, more, tdn);
    if (!more) break;
    td = tdn; pm = pmn; pn = pnn; first = false;
  }
}

DI float wave_sum(float v) {
  v += shxf<32>(v); v += shxf<16>(v); v += shxf<8>(v); v += shxf<4>(v); v += shxf<2>(v); v += shxf<1>(v);
  return v;
}

DI void norm_phase(int ws, int gx, int gslot, const float* __restrict__ x, u16* __restrict__ h, const float* __restrict__ g, const float* __restrict__ shift,
                   const float* __restrict__ scale  ) {
  const int tid_ = mytid(ws), wid = tid_ >> 6, lane = tid_ & 63;
  const int rbase = gx * (NT / 8) + gslot * (NT / 8 / (gridDim.x / 8)) + wid * (NT / 8 / (gridDim.x / 8) / 8);
  const int rcnt = NT / 8 / (gridDim.x / 8) / 8;
  for (int row = rbase; row < rbase + rcnt; ++row) {
    const float4* xr = (const float4*)(x + (long)row * DM);
    float4 v[4];
    float ss = 0.f;
#pragma unroll
    for (int i = 0; i < 4; ++i) {
      v[i] = xr[lane + 64 * i];
      ss += v[i].x * v[i].x + v[i].y * v[i].y + v[i].z * v[i].z + v[i].w * v[i].w;
    }
    ss = wave_sum(ss);
    const float rs = rsqrtf(ss * (1.f / DM) + 1e-6f);
    const int b = row >> 13;
#pragma unroll
    for (int i = 0; i < 4; ++i) {
      const int c4 = lane + 64 * i;
      const float4 gg = ((const float4*)g)[c4];
      const float4 sc = ((const float4*)(scale + (long)b * 9216))[c4];
      const float4 sh = ((const float4*)(shift + (long)b * 9216))[c4];
      float y0 = v[i].x * rs * gg.x * (1.f + sc.x) + sh.x;
      float y1 = v[i].y * rs * gg.y * (1.f + sc.y) + sh.y;
      float y2 = v[i].z * rs * gg.z * (1.f + sc.z) + sh.z;
      float y3 = v[i].w * rs * gg.w * (1.f + sc.w) + sh.w;
      u32x2 pk = {pack2(y0, y1), pack2(y2, y3)};
      wt64(h + (long)row * DM + c4 * 4, pk);
    }
  }
}

DI void final_norm_phase(int ws, int gx, int gslot, float* __restrict__ x, const float* __restrict__ g) {
  const int tid_ = mytid(ws), wid = tid_ >> 6, lane = tid_ & 63;
  const int rbase = gx * (NT / 8) + gslot * (NT / 8 / (gridDim.x / 8)) + wid * (NT / 8 / (gridDim.x / 8) / 8);
  const int rcnt = NT / 8 / (gridDim.x / 8) / 8;
  for (int row = rbase; row < rbase + rcnt; ++row) {
    float4* xr = (float4*)(x + (long)row * DM);
    float4 v[4];
    float ss = 0.f;
#pragma unroll
    for (int i = 0; i < 4; ++i) {
      v[i] = xr[lane + 64 * i];
      ss += v[i].x * v[i].x + v[i].y * v[i].y + v[i].z * v[i].z + v[i].w * v[i].w;
    }
    ss = wave_sum(ss);
    const float rs = rsqrtf(ss * (1.f / DM) + 1e-6f);
#pragma unroll
    for (int i = 0; i < 4; ++i) {
      const int c4 = lane + 64 * i;
      const float4 gg = ((const float4*)g)[c4];
      float4 o = {v[i].x * rs * gg.x, v[i].y * rs * gg.y, v[i].z * rs * gg.z, v[i].w * rs * gg.w};
      xr[c4] = o;
    }
  }
}

DI void prep_phase(int ws, PP p, char* shm) {
  const int tid = mytid(ws);
  float* fs = (float*)shm;
  const int n_tr = p->ntr_tiles;
  const int n_mod = 2 * 144;
  const int n_cv = 8;
  const int n_rope = 128;
  const int n_misc = 1;
  const int total = n_tr + n_mod + n_cv + n_rope + n_misc;
  for (int it = blockIdx.x; it < total; it += gridDim.x) {
    if (it < n_tr) {
      int j = 0;
      for (int q = 1; q < p->njobs; ++q)
        if (it >= p->jobs[q].tile0) j = q;
      TJob jb;
      jb.src = p->jobs[j].src; jb.dst = p->jobs[j].dst; jb.K = p->jobs[j].K; jb.N = p->jobs[j].N; jb.ldn = p->jobs[j].ldn; jb.perm = p->jobs[j].perm; jb.tile0 = p->jobs[j].tile0; jb.ntn = p->jobs[j].ntn;
      const int lt = it - jb.tile0;
      const int ngn = (jb.ntn + 3) >> 2;
      const int tk = lt / ngn, tg4 = lt % ngn;
      const int k0 = tk * 64;
      float4 v[4][2];
#pragma unroll
      for (int u = 0; u < 4; ++u)
#pragma unroll
        for (int rep = 0; rep < 2; ++rep) {
          const int idx = tid + rep * 512, r = idx >> 4, c4 = idx & 15;
          const int n = (tg4 * 4 + u) * 64 + c4 * 4;
          v[u][rep] = float4{0.f, 0.f, 0.f, 0.f};
          if (tg4 * 4 + u < jb.ntn && n < jb.N) v[u][rep] = *(const float4*)(jb.src + (long)(k0 + r) * jb.ldn + n);
        }
#pragma unroll
      for (int u = 0; u < 4; ++u)
#pragma unroll
        for (int rep = 0; rep < 2; ++rep) {
          const int idx = tid + rep * 512, r = idx >> 4, c4 = idx & 15;
          float* f = fs + u * (64 * 65) + r * 65 + c4 * 4;
          f[0] = v[u][rep].x; f[1] = v[u][rep].y; f[2] = v[u][rep].z; f[3] = v[u][rep].w;
        }
      __syncthreads();
#pragma unroll
      for (int u = 0; u < 4; ++u) {
        if (tg4 * 4 + u < jb.ntn) {
          const int n = tid >> 3, ks = tid & 7;
          float e[8];
#pragma unroll
          for (int q = 0; q < 8; ++q) e[q] = fs[u * (64 * 65) + (ks * 8 + q) * 65 + n];
          int ng = (tg4 * 4 + u) * 64 + n, drow = ng;
          if (jb.perm == 1) {
            int isb = ng >= DFF ? 1 : 0, jj = ng - isb * DFF;
            drow = (jj >> 4) * 32 + isb * 16 + (jj & 15);
          }
          u32x4 pk = {pack2(e[0], e[1]), pack2(e[2], e[3]), pack2(e[4], e[5]), pack2(e[6], e[7])};
          wt128(jb.dst + (long)drow * jb.K + k0 + ks * 8, pk);
        }
      }
      __syncthreads();
    } else if (it < n_tr + n_mod) {
      const int q = it - n_tr, l = q / 144, cg0 = (q % 144) * 64;
      for (int i = tid; i < 4096; i += NTHR) {
        float cv = p->c[i];
        fs[i] = cv / (1.f + __expf(-cv));
      }
      __syncthreads();
      const int col = tid & 63, kg = tid >> 6;
      const float* w = p->mod_w + (long)l * DM * 9216 + cg0 + col;
      float a0 = 0.f, a1 = 0.f, a2 = 0.f, a3 = 0.f;
#pragma unroll 16
      for (int k = kg * 128; k < kg * 128 + 128; ++k) {
        float wv = w[(long)k * 9216];
        a0 += fs[k] * wv;
        a1 += fs[1024 + k] * wv;
        a2 += fs[2048 + k] * wv;
        a3 += fs[3072 + k] * wv;
      }
      __syncthreads();
      float* red = fs;
      red[(kg * 4 + 0) * 64 + col] = a0;
      red[(kg * 4 + 1) * 64 + col] = a1;
      red[(kg * 4 + 2) * 64 + col] = a2;
      red[(kg * 4 + 3) * 64 + col] = a3;
      __syncthreads();
      if (tid < 256) {
        int b = tid >> 6;
        float s = 0.f;
#pragma unroll
        for (int g = 0; g < 8; ++g) s += red[(g * 4 + b) * 64 + col];
        wt32f(p->mod + ((long)l * 4 + b) * 9216 + cg0 + col, s + p->mod_b[(long)l * 9216 + cg0 + col]);
      }
      __syncthreads();
    } else if (it < n_tr + n_mod + n_cv) {
      const int q = it - n_tr - n_mod, kv = q >> 2, n = (q & 3) * 32 + (tid & 31), kg = tid >> 5;
      const float* w1 = p->cmp_w1 + (long)kv * 2048 * 128;
      const float* pe = p->cmp_pos + (long)kv * 2048;
      float a = 0.f;
      for (int k = kg * 128; k < kg * 128 + 128; ++k) a += pe[k] * w1[(long)k * 128 + n];
      fs[kg * 32 + (tid & 31)] = a;
      __syncthreads();
      if (tid < 32) {
        float s = 0.f;
        for (int g = 0; g < 16; ++g) s += fs[g * 32 + tid];
        p->cvec[kv * 128 + (q & 3) * 32 + tid] = s;
      }
      __syncthreads();
    } else if (it < n_tr + n_mod + n_cv + n_rope) {
      const int q = it - n_tr - n_mod - n_cv;
      const int e = q * 512 + tid, pos = e >> 3, i = e & 7;
      const float freq = powf(500000.f, -(float)i * 0.125f);
      const float angf = (float)pos * freq;
      const double ang = (double)angf;
      const double n = rint(ang * 0.15915494309189535);
      double r = fma(-n, 6.283185307179586, ang);
      r = fma(-n, 2.4492935982947064e-16, r);
      const float rf = (float)r;
      p->rope[pos * 16 + i] = cosf(rf);
      p->rope[pos * 16 + 8 + i] = sinf(rf);
    } else {
      if (tid < 512) {
        int bg = tid >> 6, d = tid & 63;
        p->kcmp[((long)bg * 512 + 511) * 64 + d] = 0;
        p->vcmpT[((long)bg * 64 + d) * 512 + 511] = 0;
        p->mcnt[tid] = 0u;
        p->mcnt[512 + tid] = 0u;
        if (tid < 64) { p->ctr[tid] = 0u; p->xcnt[tid] = 0u; }
        p->lbar[tid] = 0u;
      }
    }
  }
}

constexpr int KVS = 72;
constexpr int KVT = 64 * KVS;
constexpr float SCL2 = 0.125f * 1.4426950408889634f;

DI void qk_tile(const u16* Ks, const bf16x8* qf, f32x16* s, int rl, int hh) {
#pragma unroll
  for (int kb = 0; kb < 2; ++kb) {
#pragma unroll
    for (int i = 0; i < 16; ++i) s[kb][i] = 0.f;
#pragma unroll
    for (int ks = 0; ks < 4; ++ks) {
      bf16x8 a = *(const bf16x8*)(Ks + (kb * 32 + rl) * KVS + ks * 16 + hh * 8);
      s[kb] = MFMA32(a, qf[ks], s[kb]);
    }
  }
}
DI void pv_tile(const u16* Vs, const f32x16* s, f32x16* o, int rl, int hh) {
#pragma unroll
  for (int kk = 0; kk < 4; ++kk) {
    const int kb = kk >> 1, i0 = 8 * (kk & 1);
    bf16x8 pf = pack8(s[kb][i0], s[kb][i0 + 1], s[kb][i0 + 2], s[kb][i0 + 3], s[kb][i0 + 4], s[kb][i0 + 5], s[kb][i0 + 6], s[kb][i0 + 7]);
#pragma unroll
    for (int db = 0; db < 2; ++db) {
      const u16* vp = Vs + (db * 32 + rl) * KVS + kk * 16 + hh * 4;
      s16x4 lo = *(const s16x4*)vp, hi = *(const s16x4*)(vp + 8);
      bf16x8 a = __builtin_shufflevector(lo, hi, 0, 1, 2, 3, 4, 5, 6, 7);
      o[db] = MFMA32(a, pf, o[db]);
    }
  }
}
DI float fexp2(float x) { return __builtin_amdgcn_exp2f(x); }
template <int MODE>
DI void osm(f32x16* s, uint32_t vm, float& m, float& l, f32x16* o) {
  float mx = -1e30f;
#pragma unroll
  for (int kb = 0; kb < 2; ++kb)
#pragma unroll
    for (int i = 0; i < 16; ++i) {
      if (MODE == 2) s[kb][i] = ((vm >> (kb * 16 + i)) & 1u) ? s[kb][i] : -1e30f;
      mx = fmaxf(mx, s[kb][i]);
    }
  mx *= SCL2;
  if (MODE == 1) mx = vm ? mx : -1e30f;
  mx = xmax32(mx);
  const float mn = fmaxf(m, mx);
  const float alpha = fexp2(m - mn);
  const bool rowok = (MODE == 1) ? (vm != 0u) : true;
  const float mu = (rowok && mn > -1e29f) ? mn : 1e30f;
  float rs = 0.f;
#pragma unroll
  for (int kb = 0; kb < 2; ++kb)
#pragma unroll
    for (int i = 0; i < 16; ++i) {
      const float pv = fexp2(__builtin_fmaf(s[kb][i], SCL2, -mu));
      s[kb][i] = pv;
      rs += pv;
    }
  rs = xsum32(rs);
  l = l * alpha + rs;
  if (__ballot(mn > m) != 0ull) {
#pragma unroll
    for (int db = 0; db < 2; ++db)
#pragma unroll
      for (int i = 0; i < 16; ++i) o[db][i] *= alpha;
  }
  m = mn;
}
DI void online_softmax(f32x16* s, uint32_t vm, float& m, float& l, f32x16* o) {
  const unsigned long long ball = __ballot(vm == 0xffffffffu), bnone = __ballot(vm == 0u);
  if (ball == ~0ull) osm<0>(s, vm, m, l, o);
  else if ((ball | bnone) == ~0ull) osm<1>(s, vm, m, l, o);
  else osm<2>(s, vm, m, l, o);
}
DI uint32_t range_mask(int kpos0, int lo, int hi, int hh) {
  if (kpos0 >= lo && kpos0 + 63 <= hi) return 0xffffffffu;
  if (kpos0 > hi || kpos0 + 63 < lo) return 0u;
  uint32_t vm = 0;
#pragma unroll
  for (int kb = 0; kb < 2; ++kb)
#pragma unroll
    for (int i = 0; i < 16; ++i) {
      int kp = kpos0 + kb * 32 + hh * 4 + (i & 3) + 8 * (i >> 2);
      vm |= (kp >= lo && kp <= hi) ? (1u << (kb * 16 + i)) : 0u;
    }
  return vm;
}

struct KVRegs { u32x4 k, v; };
DI void kv_issue(KVRegs& r, const u16* kptr, long ldk, const u16* vptr, long ldv, int tid) {
  const int row = tid >> 3, seg = tid & 7;
  r.k = *(const u32x4*)(kptr + (long)row * ldk + seg * 8);
  r.v = *(const u32x4*)(vptr + (long)row * ldv + seg * 8);
}
DI void kv_write(const KVRegs& r, u16* Ks, u16* Vs, int tid) {
  const int row = tid >> 3, seg = tid & 7;
  *(u32x4*)(Ks + row * KVS + seg * 8) = r.k;
  *(u32x4*)(Vs + row * KVS + seg * 8) = r.v;
}
template <class TF, class BODY>
DI void kv_loop(u16* kvb, int ntiles, int tid, TF tf, BODY body) {
  KVRegs r;
  const u16 *kp, *vp;
  long ldk, ldv;
  __syncthreads();
  if (ntiles > 0) {
    tf(0, kp, ldk, vp, ldv);
    kv_issue(r, kp, ldk, vp, ldv, tid);
    kv_write(r, kvb, kvb + KVT, tid);
  }
  __syncthreads();
  for (int i = 0; i < ntiles; ++i) {
    const int cur = i & 1;
    if (i + 1 < ntiles) {
      tf(i + 1, kp, ldk, vp, ldv);
      kv_issue(r, kp, ldk, vp, ldv, tid);
    }
    body(i, kvb + cur * 2 * KVT, kvb + cur * 2 * KVT + KVT);
    if (i + 1 < ntiles) kv_write(r, kvb + (cur ^ 1) * 2 * KVT, kvb + (cur ^ 1) * 2 * KVT + KVT, tid);
    __syncthreads();
  }
}
DI void load_qf(bf16x8* qf, const u16* qrow, int hh) {
#pragma unroll
  for (int ks = 0; ks < 4; ++ks) qf[ks] = *(const bf16x8*)(qrow + ks * 16 + hh * 8);
}
DI bf16x8 rope_frag(bf16x8 f, const float* cs  , int hh) {
  u32x4 w = __builtin_bit_cast(u32x4, f), ow;
#pragma unroll
  for (int q = 0; q < 4; ++q) ow[q] = shxi<32>((int)w[q]);
  float mine[8], oth[8], res[8];
#pragma unroll
  for (int q = 0; q < 4; ++q) {
    mine[2 * q] = bflo(w[q]); mine[2 * q + 1] = bfhi(w[q]);
    oth[2 * q] = bflo(ow[q]); oth[2 * q + 1] = bfhi(ow[q]);
  }
  const float sg = hh ? 1.f : -1.f;
#pragma unroll
  for (int i = 0; i < 8; ++i) res[i] = mine[i] * cs[i] + sg * oth[i] * cs[8 + i];
  u32x4 r = {pack2(res[0], res[1]), pack2(res[2], res[3]), pack2(res[4], res[5]), pack2(res[6], res[7])};
  return __builtin_bit_cast(bf16x8, r);
}
DI void store_o(u16* yrow, const f32x16* o, float scale, int hh) {
#pragma unroll
  for (int db = 0; db < 2; ++db)
#pragma unroll
    for (int q = 0; q < 4; ++q) {
      u32x2 pk = {pack2(o[db][4 * q] * scale, o[db][4 * q + 1] * scale), pack2(o[db][4 * q + 2] * scale, o[db][4 * q + 3] * scale)};
      wt64(yrow + db * 32 + 8 * q + 4 * hh, pk);
    }
}

DI void kprep0_phase(int ws, PP p, char* shm) {
  const int tid = mytid(ws);
  float* fs = (float*)shm;
  u16* u = p->big;
  for (int item = blockIdx.x; item < 256; item += gridDim.x) {
    const int b = item >> 6, n = (item >> 1) & 31, hg = item & 1;
    const int cc = tid & 31, tg = tid >> 5, head = hg * 4 + (cc >> 3), dch = cc & 7;
    float sum[8];
#pragma unroll
    for (int e = 0; e < 8; ++e) sum[e] = 0.f;
#pragma unroll 1
    for (int tb = 0; tb < 16; tb += 8) {
    u32x4 wv[8];
#pragma unroll
    for (int t8 = 0; t8 < 8; ++t8) wv[t8] = *(const u32x4*)(u + ((long)b * SEQ + n * 256 + tg * 16 + tb + t8) * IN0 + 1536 + head * 64 + dch * 8);
#pragma unroll
    for (int t8 = 0; t8 < 8; ++t8) {
      const int tt = tb + t8;
      const int tok = n * 256 + tg * 16 + tt;
      u16* ptr = u + ((long)b * SEQ + tok) * IN0 + 1536 + head * 64 + dch * 8;
      u32x4 w = wv[t8], ow;
#pragma unroll
      for (int q = 0; q < 4; ++q) ow[q] = shxi<1>((int)w[q]);
      float mine[8], oth[8];
#pragma unroll
      for (int q = 0; q < 4; ++q) {
        mine[2 * q] = bflo(w[q]); mine[2 * q + 1] = bfhi(w[q]);
        oth[2 * q] = bflo(ow[q]); oth[2 * q + 1] = bfhi(ow[q]);
      }
      if (dch < 2) {
        const float* cs = p->rope + tok * 16;
        const float sg = dch ? 1.f : -1.f;
        float res[8];
#pragma unroll
        for (int i = 0; i < 8; ++i) res[i] = mine[i] * cs[i] + sg * oth[i] * cs[8 + i];
        u32x4 r = {pack2(res[0], res[1]), pack2(res[2], res[3]), pack2(res[4], res[5]), pack2(res[6], res[7])};
        wt128(ptr, r);
#pragma unroll
        for (int q = 0; q < 4; ++q) { mine[2 * q] = bflo(r[q]); mine[2 * q + 1] = bfhi(r[q]); }
      }
#pragma unroll
      for (int e = 0; e < 8; ++e) sum[e] += mine[e];
    }
    }
    __syncthreads();
#pragma unroll
    for (int e = 0; e < 8; ++e) fs[tg * 256 + cc * 8 + e] = sum[e];
    __syncthreads();
    if (tid < 256) {
      float t = 0.f;
#pragma unroll
      for (int g = 0; g < 16; ++g) t += fs[g * 256 + tid];
      wt32f(p->cent + (((long)b * 8 + hg * 4 + (tid >> 6)) * 32 + n) * 64 + (tid & 63), t * (1.f / 256.f));
    }
    __syncthreads();
  }
}

template <bool FINAL>
DI void lru_item(int ws, PP p, char* shm, int item) {
  const int tid = mytid(ws), wid = tid >> 6, lane = tid & 63, rl = lane & 31, hh = lane >> 5;
  const int b = item & 3, c = 127 - (item >> 2), t0 = c * 64;
  const u16* u = p->big;
  u16* XC = (u16*)shm + wid * KVT;
  {
    const int ch = wid * 64 + lane;
    const float w0 = p->conv_w[ch], w1 = p->conv_w[512 + ch], w2 = p->conv_w[1024 + ch], w3 = p->conv_w[1536 + ch], cb = p->conv_b[ch];
    const u16* up = u + ((long)b * SEQ + t0) * IN0 + ch;
    float xm3 = 0.f, xm2 = 0.f, xm1 = 0.f;
    if (t0 > 0) { xm3 = bf2f(up[-3 * IN0]); xm2 = bf2f(up[-2 * IN0]); xm1 = bf2f(up[-1 * IN0]); }
    for (int t = 0; t < 64; ++t) {
      float xv = bf2f(up[(long)t * IN0]);
      float xc = w0 * xm3 + w1 * xm2 + w2 * xm1 + w3 * xv + cb;
      XC[t * KVS + lane] = f2bf(xc);
      xm3 = xm2; xm2 = xm1; xm1 = xv;
    }
  }
  __syncthreads();
  const u16* wat = p->wat + (long)wid * 4096;
  const u16* wxt = p->wat + (long)(8 + wid) * 4096;
#pragma unroll 1
  for (int nb = 0; nb < 2; ++nb) {
    f32x16 ar[2], ai[2];
#pragma unroll
    for (int mb = 0; mb < 2; ++mb)
#pragma unroll
      for (int i = 0; i < 16; ++i) { ar[mb][i] = 0.f; ai[mb][i] = 0.f; }
#pragma unroll
    for (int ks = 0; ks < 4; ++ks) {
      bf16x8 ba_ = *(const bf16x8*)(wat + (nb * 32 + rl) * 64 + ks * 16 + hh * 8);
      bf16x8 bx_ = *(const bf16x8*)(wxt + (nb * 32 + rl) * 64 + ks * 16 + hh * 8);
#pragma unroll
      for (int mb = 0; mb < 2; ++mb) {
        bf16x8 a = *(const bf16x8*)(XC + (mb * 32 + rl) * KVS + ks * 16 + hh * 8);
        ar[mb] = MFMA32(a, ba_, ar[mb]);
        ai[mb] = MFMA32(a, bx_, ai[mb]);
      }
    }
    const int j = nb * 32 + rl, chj = wid * 64 + j;
    const float baj = p->ba[chj], bxj = p->bx[chj];
    const float la = -8.f * log1pf(__expf(-p->lam[chj]));
#pragma unroll
    for (int mb = 0; mb < 2; ++mb)
#pragma unroll
      for (int i = 0; i < 16; ++i) {
        const int tok = mb * 32 + hh * 4 + (i & 3) + 8 * (i >> 2);
        const float xc = bf2f(XC[tok * KVS + j]);
        const float r = sigmoidf_(ar[mb][i] + baj), ig = sigmoidf_(ai[mb][i] + bxj);
        const float aa = __expf(r * la);
        ar[mb][i] = aa;
        ai[mb][i] = __builtin_amdgcn_sqrtf(__builtin_fmaf(-aa, aa, 1.f)) * ig * xc;
      }
    float carry = 0.f, atot = 1.f;
    if (FINAL) {
      const float* sm = p->lrusum + ((long)b * 128 * 512 + chj) * 2;
#pragma unroll 8
      for (int cp = 0; cp < c; ++cp) {
        float2 ab = *(const float2*)(sm + (long)cp * 1024);
        carry = ab.y + ab.x * carry;
      }
    }
#pragma unroll
    for (int mb = 0; mb < 2; ++mb)
#pragma unroll
      for (int q = 0; q < 4; ++q) {
        float P = 1.f, H = 0.f;
#pragma unroll
        for (int e = 0; e < 4; ++e) {
          const int idx = 4 * q + e;
          H = ar[mb][idx] * H + ai[mb][idx];
          P *= ar[mb][idx];
          ar[mb][idx] = P;
          ai[mb][idx] = H;
        }
        const float Po = shxf<32>(P), Ho = shxf<32>(H);
        const float A0 = hh ? Po : P, B0 = hh ? Ho : H, A1 = hh ? P : Po, B1 = hh ? H : Ho;
        const float mid = B0 + A0 * carry;
        const float cin = hh ? mid : carry;
        carry = B1 + A1 * mid;
        atot *= A0 * A1;
        if (FINAL) {
          const int tl0 = launder(hh * 4);
#pragma unroll
          for (int e = 0; e < 4; ++e) {
            const int idx = 4 * q + e;
            const int tok = mb * 32 + tl0 + e + 8 * q;
            const float hv = ai[mb][idx] + ar[mb][idx] * cin;
            const long trow = (long)b * SEQ + t0 + tok;
            const float g = bf2f(u[trow * IN0 + 512 + chj]);
            wt16(p->h + trow * DM + chj, f2bf(hv * gelu_tanh(g)));
          }
        }
      }
    if (!FINAL && hh == 0) {
      float2 ab = {atot, carry};
      wt64(p->lrusum + (((long)b * 128 + c) * 512 + chj) * 2, __builtin_bit_cast(u32x2, ab));
    }
  }
  __syncthreads();
}

DI int moba_off(int n) { return 256 * (31 * n - (n * (n - 1)) / 2); }

DI void moba_gate_item(int ws, PP p, char* shm, int item) {
  const int tid = mytid(ws);
  const int qb = 31 - (item >> 5), b = (item >> 3) & 3, h = item & 7;
  if (qb == 0) return;
  const int t0 = qb * 256;
  const u16* u = p->big;
  float* cs = (float*)shm;
  float* tv = (float*)(shm + 8192);
  int* ti = (int*)(shm + 11264);
  __syncthreads();
  for (int i = tid; i < qb * 64; i += NTHR) cs[i] = p->cent[((long)(b * 8 + h) * 32) * 64 + i];
  __syncthreads();
  const int ql = tid & 255, half = tid >> 8, tq = t0 + ql;
  const u16* qp = u + ((long)b * SEQ + tq) * IN0 + 1024 + h * 64;
  float q[64];
#pragma unroll
  for (int s8 = 0; s8 < 8; ++s8) {
    u32x4 w = *(const u32x4*)(qp + s8 * 8);
#pragma unroll
    for (int e = 0; e < 4; ++e) { q[s8 * 8 + 2 * e] = bflo(w[e]); q[s8 * 8 + 2 * e + 1] = bfhi(w[e]); }
  }
  {
    const float* rc = p->rope + tq * 16;
#pragma unroll
    for (int i = 0; i < 8; ++i) {
      float x1 = q[i], x2 = q[8 + i], cc = rc[i], sn = rc[8 + i];
      q[i] = bf2f(f2bf(x1 * cc - x2 * sn));
      q[8 + i] = bf2f(f2bf(x2 * cc + x1 * sn));
    }
  }
  float v0 = -INFINITY, v1 = -INFINITY, v2 = -INFINITY;
  int i0 = -1, i1 = -1, i2 = -1;
  for (int n = half; n < qb; n += 2) {
    const float4* cr = (const float4*)(cs + n * 64);
    float d = 0.f;
#pragma unroll
    for (int e = 0; e < 16; ++e) {
      float4 cv = cr[e];
      d += q[4 * e] * cv.x + q[4 * e + 1] * cv.y + q[4 * e + 2] * cv.z + q[4 * e + 3] * cv.w;
    }
    if (d > v0) { v2 = v1; i2 = i1; v1 = v0; i1 = i0; v0 = d; i0 = n; }
    else if (d > v1) { v2 = v1; i2 = i1; v1 = d; i1 = n; }
    else if (d > v2) { v2 = d; i2 = n; }
  }
  if (half == 1) {
    tv[ql * 3] = v0; tv[ql * 3 + 1] = v1; tv[ql * 3 + 2] = v2;
    ti[ql * 3] = i0; ti[ql * 3 + 1] = i1; ti[ql * 3 + 2] = i2;
  }
  __syncthreads();
  if (half == 0) {
#pragma unroll
    for (int e = 0; e < 3; ++e) {
      const float d = tv[ql * 3 + e];
      const int n = ti[ql * 3 + e];
      if (n >= 0) {
        if (d > v0 || (d == v0 && n < i0)) { v2 = v1; i2 = i1; v1 = v0; i1 = i0; v0 = d; i0 = n; }
        else if (d > v1 || (d == v1 && n < i1)) { v2 = v1; i2 = i1; v1 = d; i1 = n; }
        else if (d > v2 || (d == v2 && n < i2)) { v2 = d; i2 = n; }
      }
    }
  }
  int* lcnt = (int*)(shm + 14336);
  if (tid < 64) lcnt[tid] = 0;
  __syncthreads();
  int r0 = 0, r1 = 0, r2 = 0;
  if (half == 0) {
    if (i0 >= 0) r0 = atomicAdd(&lcnt[i0], 1);
    if (i1 >= 0) r1 = atomicAdd(&lcnt[i1], 1);
    if (i2 >= 0) r2 = atomicAdd(&lcnt[i2], 1);
  }
  __syncthreads();
  const int bh = b * 8 + h;
  if (tid < 32 && lcnt[tid] > 0) lcnt[32 + tid] = (int)atomicAdd(&p->mcnt[bh * 32 + tid], (unsigned)lcnt[tid]);
  __syncthreads();
  if (half == 0) {
    unsigned* lst = p->mlist + (long)bh * 126976;
    if (i0 >= 0) wt32u(lst + moba_off(i0) + lcnt[32 + i0] + r0, ((unsigned)tq << 2) | 0u);
    if (i1 >= 0) wt32u(lst + moba_off(i1) + lcnt[32 + i1] + r1, ((unsigned)tq << 2) | 1u);
    if (i2 >= 0) wt32u(lst + moba_off(i2) + lcnt[32 + i2] + r2, ((unsigned)tq << 2) | 2u);
  }
}

DI void moba_gather_phase(int ws, PP p, char* shm) {
  const int tid = mytid(ws), wid = tid >> 6, lane = tid & 63, rl = lane & 31, hh = lane >> 5;
  const u16* u = p->big;
  u16* kvb = (u16*)shm;
  int* pre = (int*)(shm + 120000);
  __syncthreads();
  {
    const int c0 = (int)((p->mcnt[2 * tid] + 255u) >> 8), c1 = (int)((p->mcnt[2 * tid + 1] + 255u) >> 8);
    int sc = c0 + c1;
#pragma unroll
    for (int d = 1; d < 64; d <<= 1) {
      const int o = __shfl_up(sc, d);
      if (lane >= d) sc += o;
    }
    int* wtot = pre + 1032;
    if (lane == 63) wtot[wid] = sc;
    __syncthreads();
    int base = 0;
    for (int w = 0; w < wid; ++w) base += wtot[w];
    const int excl = base + sc - (c0 + c1);
    if (tid == 0) pre[0] = 0;
    pre[2 * tid + 1] = excl + c0;
    pre[2 * tid + 2] = excl + c0 + c1;
  }
  __syncthreads();
  const int total = pre[1024];
  const int row = tid >> 3, seg = tid & 7;
  u32x4 kr[4], vr[4];
  auto locate = [&](int it, int& li, int& chunk) {
    int lo = 0, hi = 1024;
    while (hi - lo > 1) {
      const int mid = (lo + hi) >> 1;
      if (pre[mid] <= it) lo = mid; else hi = mid;
    }
    li = lo;
    chunk = it - pre[lo];
  };
  auto issue = [&](int li) {
    const int bh = li >> 5, n = li & 31, b = bh >> 3, h = bh & 7;
    const u16* kbase = u + ((long)b * SEQ + n * 256) * IN0 + 1536 + h * 64;
    const u16* vbase = p->vt + ((long)bh * 64) * SEQ + n * 256;
#pragma unroll
    for (int st = 0; st < 4; ++st) {
      kr[st] = *(const u32x4*)(kbase + (long)(st * 64 + row) * IN0 + seg * 8);
      vr[st] = *(const u32x4*)(vbase + (long)row * SEQ + st * 64 + seg * 8);
    }
  };
  int li = 0, chunk = 0;
  int* gslot = (int*)(shm + 150016);
  int it = grab(ws, p->ctr + 2, shm);
  if (it < total) { locate(it, li, chunk); issue(li); }
#pragma unroll 1
  while (it < total) {
    const int bh = li >> 5, n = li & 31, b = bh >> 3, h = bh & 7;
    const int cnt = (int)p->mcnt[li];
    __syncthreads();
#pragma unroll
    for (int st = 0; st < 4; ++st) {
      *(u32x4*)(kvb + st * 2 * KVT + row * KVS + seg * 8) = kr[st];
      *(u32x4*)(kvb + st * 2 * KVT + KVT + row * KVS + seg * 8) = vr[st];
    }
    const int e = chunk * 256 + wid * 32 + rl;
    const bool valid = e < cnt;
    const unsigned ent = p->mlist[(long)bh * 126976 + moba_off(n) + (valid ? e : 0)];
    const int tq = (int)(ent >> 2), slot = (int)(ent & 3u);
    bf16x8 qf[4];
    load_qf(qf, u + ((long)b * SEQ + tq) * IN0 + 1024 + h * 64, hh);
    qf[0] = rope_frag(qf[0], p->rope + tq * 16, hh);
    if (tid == 0) *gslot = (int)atomicAdd(p->ctr + 2, 1u);
    f32x16 o[2];
#pragma unroll
    for (int db = 0; db < 2; ++db)
#pragma unroll
      for (int i = 0; i < 16; ++i) o[db][i] = 0.f;
    float m = -1e30f, l = 0.f;
    __syncthreads();
    const int itn = *gslot;
    int lin = 0, chunkn = 0;
    if (itn < total) { locate(itn, lin, chunkn); issue(lin); }
#pragma unroll
    for (int st = 0; st < 4; ++st) {
      f32x16 s[2];
      qk_tile(kvb + st * 2 * KVT, qf, s, rl, hh);
      osm<0>(s, 0xffffffffu, m, l, o);
      pv_tile(kvb + st * 2 * KVT + KVT, s, o, rl, hh);
    }
    if (valid) {
      u16* pe = p->part + (((long)bh * SEQ + tq) * 3 + slot) * 72;
      store_o(pe + 8, o, 1.f / l, hh);
      if (hh == 0) { wt32f((float*)pe, m); wt32f((float*)pe + 1, l); }
    }
    li = lin; chunk = chunkn; it = itn;
  }
  __syncthreads();
}

DI void moba_own_item(int ws, PP p, char* shm, int item) {
  const int tid = mytid(ws), wid = tid >> 6, lane = tid & 63, rl = lane & 31, hh = lane >> 5;
  const int qb = 31 - (item >> 5), b = (item >> 3) & 3, h = item & 7;
  const int t0 = qb * 256;
  const u16* u = p->big;
  u16* kvb = (u16*)shm;
  const int tq = t0 + wid * 32 + rl;
  bf16x8 qf[4];
  load_qf(qf, u + ((long)b * SEQ + tq) * IN0 + 1024 + h * 64, hh);
  qf[0] = rope_frag(qf[0], p->rope + tq * 16, hh);
  f32x16 o[2];
#pragma unroll
  for (int db = 0; db < 2; ++db)
#pragma unroll
    for (int i = 0; i < 16; ++i) o[db][i] = 0.f;
  float m = -1e30f, l = 0.f;
  const u16* kbase = u + ((long)b * SEQ + t0) * IN0 + 1536 + h * 64;
  const u16* vbase = p->vt + ((long)(b * 8 + h) * 64) * SEQ + t0;
  auto tf = [&](int i, const u16*& kp, long& ldk, const u16*& vp, long& ldv) {
    kp = kbase + (long)i * 64 * IN0; ldk = IN0;
    vp = vbase + i * 64; ldv = SEQ;
  };
  auto body = [&](int i, const u16* Ks, const u16* Vs) {
    const uint32_t vm = range_mask(i * 64, 0, wid * 32 + rl, hh);
    if (__ballot(vm != 0) != 0ull) {
      f32x16 s[2];
      qk_tile(Ks, qf, s, rl, hh);
      online_softmax(s, vm, m, l, o);
      pv_tile(Vs, s, o, rl, hh);
    }
  };
  kv_loop(kvb, 4, tid, tf, body);
  const int nsl = qb < 3 ? qb : 3;
#pragma unroll 1
  for (int sl = 0; sl < nsl; ++sl) {
    const u16* pe = p->part + (((long)(b * 8 + h) * SEQ + tq) * 3 + sl) * 72;
    const float ms = ((const float*)pe)[0], ls = ((const float*)pe)[1];
    const float mn = fmaxf(m, ms);
    const float a = fexp2(m - mn), c = fexp2(ms - mn) * ls;
#pragma unroll
    for (int db = 0; db < 2; ++db)
#pragma unroll
      for (int q = 0; q < 4; ++q) {
        const u32x2 w = *(const u32x2*)(pe + 8 + db * 32 + 8 * q + 4 * hh);
        o[db][4 * q] = o[db][4 * q] * a + c * bflo(w[0]);
        o[db][4 * q + 1] = o[db][4 * q + 1] * a + c * bfhi(w[0]);
        o[db][4 * q + 2] = o[db][4 * q + 2] * a + c * bflo(w[1]);
        o[db][4 * q + 3] = o[db][4 * q + 3] * a + c * bfhi(w[1]);
      }
    l = l * a + c;
    m = mn;
  }
  store_o(p->h + ((long)b * SEQ + tq) * DM + 512 + h * 64, o, 1.f / l, hh);
}

DI void rope1_phase(int ws, PP p) {
  const int tid = mytid(ws);
  u16* u = p->big;
  for (int e = blockIdx.x * NTHR + tid; e < NT * 4; e += gridDim.x * NTHR) {
    const int trow = e >> 2, w = e & 3, pos = trow & (SEQ - 1);
    u16* ptr = u + (long)trow * IN1P + ((w & 2) ? 1536 : 1280) + (w & 1) * 64;
    u32x4 a = *(const u32x4*)ptr, bq = *(const u32x4*)(ptr + 8);
    const float* cs = p->rope + pos * 16;
    float x1[8], x2[8], r1[8], r2[8];
#pragma unroll
    for (int q = 0; q < 4; ++q) { x1[2 * q] = bflo(a[q]); x1[2 * q + 1] = bfhi(a[q]); x2[2 * q] = bflo(bq[q]); x2[2 * q + 1] = bfhi(bq[q]); }
#pragma unroll
    for (int i = 0; i < 8; ++i) { r1[i] = x1[i] * cs[i] - x2[i] * cs[8 + i]; r2[i] = x2[i] * cs[i] + x1[i] * cs[8 + i]; }
    u32x4 oa = {pack2(r1[0], r1[1]), pack2(r1[2], r1[3]), pack2(r1[4], r1[5]), pack2(r1[6], r1[7])};
    u32x4 ob = {pack2(r2[0], r2[1]), pack2(r2[2], r2[3]), pack2(r2[4], r2[5]), pack2(r2[6], r2[7])};
    wt128(ptr, oa);
    wt128(ptr + 8, ob);
  }
}
DI void cmpfin_phase(int ws, PP p, char* shm) {
  const int tid = mytid(ws);
  float* hid = (float*)shm;
  float* w2s = (float*)(shm + 4096);
  int kvl = -1;
  for (int it = blockIdx.x; it < 1024; it += gridDim.x) {
    const int kv = it >> 9, bg = (it >> 6) & 7, i0 = (it & 63) * 8;
    const int row = tid >> 6, n = tid & 63, i = i0 + row;
    const float* pq = p->pq + ((long)kv * 4096 + bg * 512) * 256;
    __syncthreads();
    if (kv != kvl) {
      const float* w2 = p->cmp_w2 + (long)kv * 128 * 64;
      for (int e = tid; e < 128 * 64; e += NTHR) w2s[e] = w2[e];
      kvl = kv;
    }
#pragma unroll
    for (int hf = 0; hf < 2; ++hf) {
      const int nn = n + hf * 64;
      float v = 0.f;
      if (i < 511) v = gelu_tanh(pq[(long)i * 256 + nn] + pq[(long)(i + 1) * 256 + 128 + nn] + p->cvec[kv * 128 + nn]);
      hid[row * 128 + nn] = v;
    }
    __syncthreads();
    float acc = 0.f;
#pragma unroll 8
    for (int k = 0; k < 128; ++k) acc += hid[row * 128 + k] * w2s[k * 64 + n];
    if (i < 511) {
      if (kv == 0) wt16(p->kcmp + ((long)bg * 512 + i) * 64 + n, f2bf(acc));
      else wt16(p->vcmpT + ((long)bg * 64 + n) * 512 + i, f2bf(acc));
    }
  }
  __syncthreads();
}

DI void nsa_item(int ws, PP p, char* shm, int item) {
  const int tid = mytid(ws), wid = tid >> 6, lane = tid & 63, rl = lane & 31, hh = lane >> 5;
  const int tt = 255 - (item >> 3), bg = item & 7, b = bg >> 1, g = bg & 1;
  const int t0 = tt * 32, tokl = wid * 4 + (rl >> 3), tok = t0 + tokl, r = rl & 7, hq = g * 8 + r;
  const u16* u = p->big;
  u16* kvb = (u16*)shm;
  float* impm = (float*)(shm + 36864);
  float* imps = (float*)(shm + 53760);
  float* vals = (float*)(shm + 70656);
  unsigned char* selb = (unsigned char*)(shm + 147456);
  uint32_t* un = (uint32_t*)(shm + 147968);
  int* tl = (int*)(shm + 148032);
  __syncthreads();
  for (int i = tid; i < 2 * 32 * 132; i += NTHR) impm[i] = 0.f;
  if (tid < 8) un[tid] = 0;
  const u16* qrow = u + ((long)b * SEQ + tok) * IN1P + hq * 64;
  bf16x8 qn[4], qr[4];
  load_qf(qn, qrow, hh);
  qr[0] = rope_frag(qn[0], p->rope + tok * 16, hh);
  qr[1] = qn[1]; qr[2] = qn[2]; qr[3] = qn[3];
  float gt[3];
#pragma unroll
  for (int br = 0; br < 3; ++br) gt[br] = sigmoidf_(bf2f(qrow[1792 - hq * 64 + hq * 3 + br]));
  f32x16 yacc[2], o[2];
#pragma unroll
  for (int db = 0; db < 2; ++db)
#pragma unroll
    for (int i = 0; i < 16; ++i) { yacc[db][i] = 0.f; o[db][i] = 0.f; }
  {
    const int nct = (t0 >> 10) + 1;
    const int cmax = (tok - 31) >> 4;
    const u16* kc = p->kcmp + (long)bg * 512 * 64;
    const u16* vc = p->vcmpT + (long)bg * 64 * 512;
    auto tf = [&](int i, const u16*& kp, long& ldk, const u16*& vp, long& ldv) {
      kp = kc + (long)i * 64 * 64; ldk = 64;
      vp = vc + i * 64; ldv = 512;
    };
    float m = -1e30f, l = 0.f;
    auto body1 = [&](int i, const u16* Ks, const u16* Vs) {
      const uint32_t vm = range_mask(i * 64, 0, cmax, hh);
      f32x16 s[2];
      qk_tile(Ks, qn, s, rl, hh);
      float mx = -1e30f;
#pragma unroll
      for (int kb = 0; kb < 2; ++kb)
#pragma unroll
        for (int ii = 0; ii < 16; ++ii) {
          float v = s[kb][ii] * SCL2;
          v = ((vm >> (kb * 16 + ii)) & 1u) ? v : -1e30f;
          s[kb][ii] = v;
          mx = fmaxf(mx, v);
        }
      mx = xmax32(mx);
      const float mn = fmaxf(m, mx);
      float rs = 0.f;
#pragma unroll
      for (int kb = 0; kb < 2; ++kb)
#pragma unroll
        for (int ii = 0; ii < 16; ++ii) rs += ((vm >> (kb * 16 + ii)) & 1u) ? fexp2(s[kb][ii] - mn) : 0.f;
      rs = xsum32(rs);
      l = l * fexp2(m - mn) + rs;
      m = mn;
    };
    kv_loop(kvb, nct, tid, tf, body1);
    const float invl = l > 0.f ? 1.f / l : 0.f;
    auto body2 = [&](int i, const u16* Ks, const u16* Vs) {
      const uint32_t vm = range_mask(i * 64, 0, cmax, hh);
      f32x16 s[2];
      qk_tile(Ks, qn, s, rl, hh);
#pragma unroll
      for (int kb = 0; kb < 2; ++kb)
#pragma unroll
        for (int ii = 0; ii < 16; ++ii) s[kb][ii] = ((vm >> (kb * 16 + ii)) & 1u) ? fexp2(__builtin_fmaf(s[kb][ii], SCL2, -m)) * invl : 0.f;
      pv_tile(Vs, s, o, rl, hh);
#pragma unroll
      for (int kb = 0; kb < 2; ++kb)
#pragma unroll
        for (int q4 = 0; q4 < 4; ++q4) {
          float mainv = s[kb][4 * q4] + s[kb][4 * q4 + 1] + s[kb][4 * q4 + 2] + 0.5f * s[kb][4 * q4 + 3];
          float sp = 0.5f * s[kb][4 * q4 + 3];
          mainv = sum8(mainv);
          sp = sum8(sp);
          if (r == 0) {
            const int j = 16 * i + 8 * kb + 2 * q4 + hh;
            impm[tokl * 132 + j] = mainv;
            imps[tokl * 132 + j + 1] = sp;
          }
        }
    };
    kv_loop(kvb, nct, tid, tf, body2);
#pragma unroll
    for (int db = 0; db < 2; ++db)
#pragma unroll
      for (int i = 0; i < 16; ++i) { yacc[db][i] = gt[0] * o[db][i]; o[db][i] = 0.f; }
  }
  __syncthreads();
  {
    const int tk = tid >> 4, jg = tid & 15, blk = (t0 + tk) >> 6;
    float v[8];
#pragma unroll
    for (int e = 0; e < 8; ++e) {
      const int j = jg * 8 + e;
      float x = impm[tk * 132 + j] + imps[tk * 132 + j];
      if (j == 0 || j == blk || j == blk - 1) x = 1e30f;
      if (j > blk) x = -INFINITY;
      v[e] = x;
      vals[tk * 132 + j] = x;
    }
    uint32_t key[8];
#pragma unroll
    for (int e = 0; e < 8; ++e) {
      const uint32_t uu = __float_as_uint(v[e]);
      key[e] = (uu & 0x80000000u) ? ~uu : (uu | 0x80000000u);
    }
    auto rowsum = [](int c) {
      c += __builtin_amdgcn_update_dpp(0, c, 0x128, 0xF, 0xF, true);
      c += __builtin_amdgcn_update_dpp(0, c, 0x124, 0xF, 0xF, true);
      c += __builtin_amdgcn_update_dpp(0, c, 0x122, 0xF, 0xF, true);
      c += __builtin_amdgcn_update_dpp(0, c, 0x121, 0xF, 0xF, true);
      return c;
    };
    uint32_t pfx = 0;
#pragma unroll 1
    for (int b = 31; b >= 0; --b) {
      const uint32_t cand = pfx | (1u << b);
      int c = 0;
#pragma unroll
      for (int e = 0; e < 8; ++e) c += (key[e] >= cand) ? 1 : 0;
      c = rowsum(c);
      if (c >= 16) pfx = cand;
    }
    int cgt = 0, teq = 0;
#pragma unroll
    for (int e = 0; e < 8; ++e) { cgt += (key[e] > pfx) ? 1 : 0; teq += (key[e] == pfx) ? 1 : 0; }
    cgt = rowsum(cgt);
    int tin = teq;
    tin += __builtin_amdgcn_update_dpp(0, tin, 0x111, 0xF, 0xF, true);
    tin += __builtin_amdgcn_update_dpp(0, tin, 0x112, 0xF, 0xF, true);
    tin += __builtin_amdgcn_update_dpp(0, tin, 0x114, 0xF, 0xF, true);
    tin += __builtin_amdgcn_update_dpp(0, tin, 0x118, 0xF, 0xF, true);
    int run = cgt + tin - teq;
    uint32_t bits = 0;
#pragma unroll
    for (int e = 0; e < 8; ++e) {
      const bool eq = key[e] == pfx;
      const bool sel = (key[e] > pfx) || (eq && run < 16);
      run += eq ? 1 : 0;
      bits |= (sel && (jg * 8 + e) <= blk) ? (1u << e) : 0u;
    }
    selb[tk * 16 + jg] = (unsigned char)bits;
    __syncthreads();
    if (tid < 32) {
      const uint32_t* w = (const uint32_t*)(selb + tid * 16);
      atomicOr(&un[0], w[0]); atomicOr(&un[1], w[1]); atomicOr(&un[2], w[2]); atomicOr(&un[3], w[3]);
    }
    __syncthreads();
    if (tid < 128) {
      const uint32_t u0 = un[0], u1 = un[1], u2 = un[2], u3 = un[3];
      const int w = tid >> 5, bpos = tid & 31;
      const uint32_t uw = w == 0 ? u0 : w == 1 ? u1 : w == 2 ? u2 : u3;
      const int below = (w > 0 ? __popc(u0) : 0) + (w > 1 ? __popc(u1) : 0) + (w > 2 ? __popc(u2) : 0);
      if ((uw >> bpos) & 1u) tl[below + __popc(uw & ((1u << bpos) - 1u))] = tid;
      if (tid == 0) un[4] = __popc(u0) + __popc(u1) + __popc(u2) + __popc(u3);
    }
    __syncthreads();
  }
  {
    const int ntl = (int)un[4];
    const u32x4 ms = *(const u32x4*)(selb + tokl * 16);
    const u16* kb_ = u + (long)b * SEQ * IN1P + 1280 + g * 64;
    const u16* vb_ = p->vt + (long)bg * 64 * SEQ;
    auto tf = [&](int i, const u16*& kp, long& ldk, const u16*& vp, long& ldv) {
      const int j = tl[i];
      kp = kb_ + (long)j * 64 * IN1P; ldk = IN1P;
      vp = vb_ + j * 64; ldv = SEQ;
    };
    float m = -1e30f, l = 0.f;
    auto body = [&](int i, const u16* Ks, const u16* Vs) {
      const int j = tl[i];
      const uint32_t w = j < 32 ? ms[0] : j < 64 ? ms[1] : j < 96 ? ms[2] : ms[3];
      uint32_t vm = ((w >> (j & 31)) & 1u) ? range_mask(j * 64, 0, tok, hh) : 0u;
      if (__ballot(vm != 0) != 0ull) {
        f32x16 s[2];
        qk_tile(Ks, qr, s, rl, hh);
        online_softmax(s, vm, m, l, o);
        pv_tile(Vs, s, o, rl, hh);
      }
    };
    {
      const int ng = (ntl + 3) >> 2;
      const int row = tid >> 3, seg = tid & 7;
      u32x4 kr[4], vr[4];
      auto issue = [&](int g4) {
#pragma unroll
        for (int t = 0; t < 4; ++t) {
          const int idx = g4 * 4 + t;
          if (idx < ntl) {
            const int j = tl[idx];
            kr[t] = *(const u32x4*)(kb_ + ((long)j * 64 + row) * IN1P + seg * 8);
            vr[t] = *(const u32x4*)(vb_ + (long)row * SEQ + j * 64 + seg * 8);
          }
        }
      };
      auto wr = [&](int g4, int buf) {
#pragma unroll
        for (int t = 0; t < 4; ++t) {
          if (g4 * 4 + t < ntl) {
            u16* kd = kvb + (buf * 4 + t) * 2 * KVT;
            *(u32x4*)(kd + row * KVS + seg * 8) = kr[t];
            *(u32x4*)(kd + KVT + row * KVS + seg * 8) = vr[t];
          }
        }
      };
      __syncthreads();
      issue(0);
      wr(0, 0);
      __syncthreads();
#pragma unroll 1
      for (int g4 = 0; g4 < ng; ++g4) {
        if (g4 + 1 < ng) issue(g4 + 1);
#pragma unroll 1
        for (int t = 0; t < 4; ++t) {
          const int idx = g4 * 4 + t;
          if (idx < ntl) {
            const u16* kd = kvb + ((g4 & 1) * 4 + t) * 2 * KVT;
            body(idx, kd, kd + KVT);
          }
        }
        if (g4 + 1 < ng) wr(g4 + 1, (g4 + 1) & 1);
        __syncthreads();
      }
    }
    const float sc = gt[1] / l;
#pragma unroll
    for (int db = 0; db < 2; ++db)
#pragma unroll
      for (int i = 0; i < 16; ++i) { yacc[db][i] += sc * o[db][i]; o[db][i] = 0.f; }
  }
  {
    const int jlo = (t0 > 511 ? t0 - 511 : 0) >> 6, jhi = (t0 + 31) >> 6;
    const u16* kb_ = u + (long)b * SEQ * IN1P + 1536 + g * 64;
    const u16* vb_ = p->vt + (long)(8 + bg) * 64 * SEQ;
    auto tf = [&](int i, const u16*& kp, long& ldk, const u16*& vp, long& ldv) {
      const int j = jlo + i;
      kp = kb_ + (long)j * 64 * IN1P; ldk = IN1P;
      vp = vb_ + j * 64; ldv = SEQ;
    };
    float m = -1e30f, l = 0.f;
    auto body = [&](int i, const u16* Ks, const u16* Vs) {
      const int j = jlo + i;
      const uint32_t vm = range_mask(j * 64, tok - 511, tok, hh);
      if (__ballot(vm != 0) != 0ull) {
        f32x16 s[2];
        qk_tile(Ks, qr, s, rl, hh);
        online_softmax(s, vm, m, l, o);
        pv_tile(Vs, s, o, rl, hh);
      }
    };
    kv_loop(kvb, jhi - jlo + 1, tid, tf, body);
    const float sc = gt[2] / l;
#pragma unroll
    for (int db = 0; db < 2; ++db)
#pragma unroll
      for (int i = 0; i < 16; ++i) yacc[db][i] += sc * o[db][i];
  }
  store_o(p->h + ((long)b * SEQ + tok) * DM + hq * 64, yacc, 1.f, hh);
}

DI void local_barrier(unsigned* ctr, unsigned target, int ws) {
  asm volatile("s_waitcnt vmcnt(0)" ::: "memory");
  __syncthreads();
  if (ws == 0 && lane_id_() == 0) {
    __hip_atomic_fetch_add(ctr, 1u, __ATOMIC_RELAXED, __HIP_MEMORY_SCOPE_AGENT);
    unsigned sp = 0;
    while (__hip_atomic_load(ctr, __ATOMIC_RELAXED, __HIP_MEMORY_SCOPE_AGENT) < target) {
      __builtin_amdgcn_s_sleep(1);
      if (++sp > (1u << 22)) break;
    }
    __builtin_amdgcn_fence(__ATOMIC_ACQUIRE, "agent");
    asm volatile("s_waitcnt vmcnt(0)" ::: "memory");
  }
  __syncthreads();
}

__global__ void __launch_bounds__(NTHR) fwd_kernel(Params pk) {
  __shared__ __attribute__((aligned(1024))) char shm[151552];
  cg::grid_group grid = cg::this_grid();
  const PP p0 = (PP)__builtin_amdgcn_kernarg_segment_ptr();
  const int ws = __builtin_amdgcn_readfirstlane(threadIdx.x >> 6);
  prep_phase(ws, launder_p(p0), shm);
  grid.sync();
  int gx = blockIdx.x & 7, gslot = blockIdx.x >> 3;
  bool loc = false;
  unsigned lep = 0;
  {
    int* cs_ = (int*)(shm + 150024);
    if (ws == 0 && lane_id_() == 0) {
      const unsigned xcc = (unsigned)__builtin_amdgcn_s_getreg((3 << 11) | 20) & 0xFu;
      cs_[0] = (int)xcc;
      cs_[1] = (int)__hip_atomic_fetch_add(p0->xcnt + xcc, 1u, __ATOMIC_RELAXED, __HIP_MEMORY_SCOPE_AGENT);
    }
  }
  auto seam = [&]() {
    if (loc) { ++lep; local_barrier(p0->lbar + gx * 64, lep * (gridDim.x >> 3), ws); }
    else grid.sync();
  };
  auto half = [&](const int l, const int s) __attribute__((always_inline)) {
    {
      PP p = launder_p(p0);
      const float* modl = p->mod + (long)l * 4 * 9216;
      const float* xin = (l == 0 && s == 0) ? p->x : p->out;
      norm_phase(ws, gx, gslot, xin, p->h, p->norm_g + (l * 3 + (s == 0 ? 0 : 2)) * DM, modl + (s == 0 ? 0 : 6) * DM, modl + (s == 0 ? 1 : 7) * DM);
      if (l == 0 && s == 0) {
        grid.sync();
        bool ok = (gridDim.x == 256);
        for (int j = 0; j < 8; ++j) ok = ok && (__hip_atomic_load(p0->xcnt + j, __ATOMIC_RELAXED, __HIP_MEMORY_SCOPE_AGENT) == 32u);
        const int* cs_ = (const int*)(shm + 150024);
        __syncthreads();
        if (ok) { gx = cs_[0]; gslot = cs_[1]; loc = true; }
      } else {
        seam();
      }
      p = launder_p(p0);
      {
        const u16* W = p->wt1 + (long)(l * 2 + s) * 5632 * 1024;
        u16* act = p->big;
        auto desc = [&](int pm, int pn) { return TileDesc{p->h + (long)pm * 256 * DM, DM, 64, W + (long)pn * 256 * DM, DM, DM / 64}; };
        auto epi = [&](int pm, int pn, Acc8& acc, int wr, int wc, int fr, int fq) {
#pragma unroll
          for (int ai = 0; ai < 2; ++ai)
#pragma unroll
            for (int bj = 0; bj < 2; ++bj)
#pragma unroll
              for (int m = 0; m < 4; ++m)
#pragma unroll
                for (int j = 0; j < 4; ++j) {
                  float a = acc[ai][bj][m][0][j], b = acc[ai][bj][m][1][j];
                  float v = a * __builtin_amdgcn_rcpf(1.f + __expf(-a)) * b;
                  long row = (long)pm * 256 + ai * 128 + wr * 64 + m * 16 + fq * 4 + j;
                  int col = pn * 128 + (bj * 4 + wc) * 16 + fr;
                  wt16(act + row * DFF + col, f2bf(v));
                }
        };
        gemm_phase(ws, gx, gslot, shm, NT / 256, 5632 / 256, desc, epi);
      }
      seam();
      p = launder_p(p0);
      modl = p->mod + (long)l * 4 * 9216;
      xin = (l == 0 && s == 0) ? p->x : p->out;
      {
        const u16* W = p->wt2 + (long)(l * 2 + s) * 1024 * DFF;
        const float* gate = modl + (s == 0 ? 2 : 8) * DM;
        float* xo = p->out;
        auto desc = [&](int pm, int pn) { return TileDesc{p->big + (long)pm * 256 * DFF, DFF, 64, W + (long)pn * 256 * DFF, DFF, DFF / 64}; };
        auto epi = [&](int pm, int pn, Acc8& acc, int wr, int wc, int fr, int fq) {
          const int b = (pm * 256) >> 13;
#pragma unroll
          for (int bj = 0; bj < 2; ++bj)
#pragma unroll
            for (int n = 0; n < 2; ++n) {
              const int col = pn * 256 + bj * 128 + wc * 32 + n * 16 + fr;
              const float gv = 0.5f * gate[(long)b * 9216 + col];
#pragma unroll
              for (int ai = 0; ai < 2; ++ai)
#pragma unroll
                for (int m = 0; m < 4; ++m) {
#pragma unroll
                  for (int j = 0; j < 4; ++j) {
                    long row = (long)pm * 256 + ai * 128 + wr * 64 + m * 16 + fq * 4 + j;
                    wt32f(xo + row * DM + col, xin[row * DM + col] + gv * acc[ai][bj][m][n][j]);
                  }
                  asm volatile("" ::: "memory");
                }
            }
        };
        gemm_phase(ws, gx, gslot, shm, NT / 256, DM / 256, desc, epi);
      }
      seam();
      if (s == 0) {
        p = launder_p(p0);
        modl = p->mod + (long)l * 4 * 9216;
        norm_phase(ws, gx, gslot, p->out, p->h, p->norm_g + (l * 3 + 1) * DM, modl + 3 * DM, modl + 4 * DM);
        seam();
        if (l == 0) {
          p = launder_p(p0);
          {
            u16* uu = p->big;
            u16* vt = p->vt;
            auto desc = [&](int pm, int pn) { return TileDesc{p->h + (long)pm * 256 * DM, DM, 64, p->wtin0 + (long)pn * 256 * DM, DM, DM / 64}; };
            auto epi = [&](int pm, int pn, Acc8& acc, int wr, int wc, int fr, int fq) {
#pragma unroll
              for (int ai = 0; ai < 2; ++ai)
#pragma unroll
                for (int bj = 0; bj < 2; ++bj)
#pragma unroll
                  for (int m = 0; m < 4; ++m)
#pragma unroll
                    for (int n = 0; n < 2; ++n) {
                      const int col = pn * 256 + bj * 128 + wc * 32 + n * 16 + fr;
                      const long row0 = (long)pm * 256 + ai * 128 + wr * 64 + m * 16 + fq * 4;
                      const f32x4 v = acc[ai][bj][m][n];
                      if (col >= 2048) {
                        const int vc = col - 2048, bb = (int)(row0 >> 13), t = (int)(row0 & 8191);
                        u32x2 pk = {pack2(v[0], v[1]), pack2(v[2], v[3])};
                        wt64(vt + ((long)(bb * 8 + (vc >> 6)) * 64 + (vc & 63)) * SEQ + t, pk);
                      } else {
#pragma unroll
                        for (int j = 0; j < 4; ++j) wt16(uu + (row0 + j) * IN0 + col, f2bf(v[j]));
                      }
                    }
            };
            gemm_phase(ws, gx, gslot, shm, NT / 256, IN0 / 256, desc, epi);
          }
          grid.sync();
          p = launder_p(p0);
          kprep0_phase(ws, p, shm);
          p = launder_p(p0);
#pragma unroll 1
          for (int it = grab(ws, p->ctr + 0, shm); it < 512;) {
            const int nx_ = grab_begin(ws, p->ctr + 0);
            lru_item<false>(ws, p, shm, it);
            it = grab_end(ws, nx_, shm);
          }
          grid.sync();
          p = launder_p(p0);
#pragma unroll 1
          for (int it = grab(ws, p->ctr + 1, shm); it < 1024;) {
            const int nx_ = grab_begin(ws, p->ctr + 1);
            moba_gate_item(ws, p, shm, it);
            it = grab_end(ws, nx_, shm);
          }
          grid.sync();
          p = launder_p(p0);
          moba_gather_phase(ws, p, shm);
          p = launder_p(p0);
#pragma unroll 1
          for (int it = grab(ws, p->ctr + 3, shm); it < 512;) {
            const int nx_ = grab_begin(ws, p->ctr + 3);
            lru_item<true>(ws, p, shm, it);
            it = grab_end(ws, nx_, shm);
          }
          grid.sync();
          p = launder_p(p0);
#pragma unroll 1
          for (int it = grab(ws, p->ctr + 4, shm); it < 1024;) {
            const int nx_ = grab_begin(ws, p->ctr + 4);
            moba_own_item(ws, p, shm, it);
            it = grab_end(ws, nx_, shm);
          }
          grid.sync();
        }
        if (l == 1) {
          p = launder_p(p0);
          {
            u16* uu = p->big;
            u16* vt = p->vt;
            auto desc = [&](int pm, int pn) { return TileDesc{p->h + (long)pm * 256 * DM, DM, 64, p->wtin1 + (long)pn * 256 * DM, DM, DM / 64}; };
            auto epi = [&](int pm, int pn, Acc8& acc, int wr, int wc, int fr, int fq) {
#pragma unroll
              for (int ai = 0; ai < 2; ++ai)
#pragma unroll
                for (int bj = 0; bj < 2; ++bj) {
                  const int c64 = (pn * 256 + bj * 128 + wc * 32) >> 6;
                  const bool isv = (c64 == 22 || c64 == 23 || c64 == 26 || c64 == 27);
#pragma unroll
                  for (int m = 0; m < 4; ++m)
#pragma unroll
                    for (int n = 0; n < 2; ++n) {
                      const int col = pn * 256 + bj * 128 + wc * 32 + n * 16 + fr;
                      const long row0 = (long)pm * 256 + ai * 128 + wr * 64 + m * 16 + fq * 4;
                      const f32x4 v = acc[ai][bj][m][n];
                      if (isv) {
                        const int bb = (int)(row0 >> 13), t = (int)(row0 & 8191);
                        const int which = c64 >= 26 ? 1 : 0, gg = c64 & 1;
                        u32x2 pk = {pack2(v[0], v[1]), pack2(v[2], v[3])};
                        wt64(vt + ((long)(which * 8 + bb * 2 + gg) * 64 + (col & 63)) * SEQ + t, pk);
                      } else if (col < IN1) {
#pragma unroll
                        for (int j = 0; j < 4; ++j) wt16(uu + (row0 + j) * IN1P + col, f2bf(v[j]));
                      }
                    }
                }
            };
            gemm_phase(ws, gx, gslot, shm, NT / 256, IN1P / 256, desc, epi);
          }
          grid.sync();
          p = launder_p(p0);
          rope1_phase(ws, p);
          p = launder_p(p0);
          {
            float* pq = p->pq;
            auto desc = [&](int pm, int pn) {
              const int kv = pm >> 4, rr = pm & 15, bg = rr >> 1, j0 = (rr & 1) * 256;
              return TileDesc{p->big + ((long)(bg >> 1) * SEQ + 16 * j0) * IN1P + 1024 + kv * 128 + (bg & 1) * 64, 16 * IN1P, IN1P,
                              p->wtcmp + (long)kv * 256 * 1024, 1024, 16};
            };
            auto epi = [&](int pm, int pn, Acc8& acc, int wr, int wc, int fr, int fq) {
#pragma unroll
              for (int ai = 0; ai < 2; ++ai)
#pragma unroll
                for (int bj = 0; bj < 2; ++bj)
#pragma unroll
                  for (int m = 0; m < 4; ++m)
#pragma unroll
                    for (int n = 0; n < 2; ++n)
#pragma unroll
                      for (int j = 0; j < 4; ++j)
                        wt32f(pq + ((long)pm * 256 + ai * 128 + wr * 64 + m * 16 + fq * 4 + j) * 256 + bj * 128 + wc * 32 + n * 16 + fr, acc[ai][bj][m][n][j]);
            };
            gemm_phase(ws, gx, gslot, shm, 32, 1, desc, epi);
          }
          grid.sync();
          p = launder_p(p0);
          cmpfin_phase(ws, p, shm);
          grid.sync();
          p = launder_p(p0);
#pragma unroll 1
          for (int it = grab(ws, p->ctr + 5, shm); it < 2048;) {
            const int nx_ = grab_begin(ws, p->ctr + 5);
            nsa_item(ws, p, shm, it);
            it = grab_end(ws, nx_, shm);
          }
          grid.sync();
        }
        {
          p = launder_p(p0);
          modl = p->mod + (long)l * 4 * 9216;
          const u16* W = l == 0 ? p->wtout0 : p->wtout1;
          const float* gate = modl + 5 * DM;
          float* xo = p->out;
          auto desc = [&](int pm, int pn) { return TileDesc{p->h + (long)pm * 256 * DM, DM, 64, W + (long)pn * 256 * DM, DM, DM / 64}; };
          auto epi = [&](int pm, int pn, Acc8& acc, int wr, int wc, int fr, int fq) {
            const int b = (pm * 256) >> 13;
#pragma unroll
            for (int bj = 0; bj < 2; ++bj)
#pragma unroll
              for (int n = 0; n < 2; ++n) {
                const int col = pn * 256 + bj * 128 + wc * 32 + n * 16 + fr;
                const float gv = gate[(long)b * 9216 + col];
#pragma unroll
                for (int ai = 0; ai < 2; ++ai)
#pragma unroll
                  for (int m = 0; m < 4; ++m) {
#pragma unroll
                    for (int j = 0; j < 4; ++j) {
                      long row = (long)pm * 256 + ai * 128 + wr * 64 + m * 16 + fq * 4 + j;
                      wt32f(xo + row * DM + col, xo[row * DM + col] + gv * acc[ai][bj][m][n][j]);
                    }
                    asm volatile("" ::: "memory");
                  }
              }
          };
          gemm_phase(ws, gx, gslot, shm, NT / 256, DM / 256, desc, epi);
          seam();
        }
      }
    }
  };
  half(0, 0);
  half(0, 1);
  half(1, 0);
  half(1, 1);
  { PP p = launder_p(p0); final_norm_phase(ws, gx, gslot, p->out, p->fng); }
}

extern "C" void kernel_launch(void* const* d_in, const int* in_sizes, int n_in, void* d_out, int out_size, void* d_ws, size_t ws_size,
                              hipStream_t stream) {
  Params p;
  memset(&p, 0, sizeof(p));
  const float** fp = (const float**)&p.x;
  for (int i = 0; i < 22; ++i) fp[i] = (const float*)d_in[i];
  p.out = (float*)d_out;
  char* ws = (char*)d_ws;
  size_t off = 0;
  auto take = [&](size_t bytes) { char* r = ws + off; off += (bytes + 255) & ~(size_t)255; return r; };
  p.wt1 = (u16*)take((size_t)4 * 5632 * 1024 * 2);
  p.wt2 = (u16*)take((size_t)4 * 1024 * DFF * 2);
  p.wtin0 = (u16*)take((size_t)IN0 * 1024 * 2);
  p.wtout0 = (u16*)take((size_t)1024 * 1024 * 2);
  p.wtin1 = (u16*)take((size_t)IN1P * 1024 * 2);
  p.wtout1 = (u16*)take((size_t)1024 * 1024 * 2);
  p.wtcmp = (u16*)take((size_t)2 * 256 * 1024 * 2);
  p.wat = (u16*)take((size_t)2 * 8 * 64 * 64 * 2);
  p.mod = (float*)take((size_t)2 * 4 * 9216 * 4);
  p.rope = (float*)take((size_t)SEQ * 16 * 4);
  p.cvec = (float*)take(2 * 128 * 4);
  p.cent = (float*)take((size_t)4 * 8 * 32 * 64 * 4);
  p.lrusum = (float*)take((size_t)4 * 128 * 512 * 2 * 4);
  p.pq = (float*)take((size_t)2 * 4096 * 256 * 4);
  p.h = (u16*)take((size_t)NT * 1024 * 2);
  p.big = (u16*)take((size_t)NT * DFF * 2);
  p.vt = (u16*)take((size_t)NT * 512 * 2);
  p.kcmp = (u16*)take((size_t)8 * 512 * 64 * 2);
  p.vcmpT = (u16*)take((size_t)8 * 512 * 64 * 2);
  p.mcnt = (unsigned*)take(1024 * 4);
  p.ctr = (unsigned*)take(64 * 4);
  p.xcnt = (unsigned*)take(64 * 4);
  p.lbar = (unsigned*)take(8 * 64 * 4);
  p.mlist = (unsigned*)take((size_t)32 * 126976 * 4);
  p.part = (u16*)take((size_t)NT * 8 * 3 * 144);
  int nj = 0, t0 = 0;
  auto add = [&](const float* src, u16* dst, int K, int N, int ldn, int perm, int npad) {
    TJob& j = p.jobs[nj++];
    j.src = src; j.dst = dst; j.K = K; j.N = N; j.ldn = ldn; j.perm = perm; j.tile0 = t0; j.ntn = npad / 64;
    t0 += (K / 64) * ((npad / 64 + 3) / 4);
  };
  for (int i = 0; i < 4; ++i) add(p.ffn_w1 + (size_t)i * 1024 * 5632, p.wt1 + (size_t)i * 5632 * 1024, 1024, 5632, 5632, 1, 5632);
  for (int i = 0; i < 4; ++i) add(p.ffn_w2 + (size_t)i * DFF * 1024, p.wt2 + (size_t)i * 1024 * DFF, DFF, 1024, 1024, 0, 1024);
  add(p.mix0_in_w, p.wtin0, 1024, IN0, IN0, 0, IN0);
  add(p.mix0_out_w, p.wtout0, 1024, 1024, 1024, 0, 1024);
  add(p.mix1_in_w, p.wtin1, 1024, IN1, IN1, 0, IN1P);
  add(p.mix1_out_w, p.wtout1, 1024, 1024, 1024, 0, 1024);
  for (int kv = 0; kv < 2; ++kv)
    for (int hf = 0; hf < 2; ++hf)
      add(p.cmp_w1 + ((size_t)kv * 2048 + hf * 1024) * 128, p.wtcmp + ((size_t)kv * 256 + hf * 128) * 1024, 1024, 128, 128, 0, 128);
  for (int n = 0; n < 8; ++n) add(p.wa + (size_t)n * 4096, p.wat + (size_t)n * 4096, 64, 64, 64, 0, 64);
  for (int n = 0; n < 8; ++n) add(p.wx + (size_t)n * 4096, p.wat + (size_t)(8 + n) * 4096, 64, 64, 64, 0, 64);
  p.njobs = nj;
  p.ntr_tiles = t0;

  static int grid_blocks = 0;
  if (!grid_blocks) {
    int dev = 0, cus = 0, per_cu = 0;
    (void)hipGetDevice(&dev);
    (void)hipDeviceGetAttribute(&cus, hipDeviceAttributeMultiprocessorCount, dev);
    (void)hipOccupancyMaxActiveBlocksPerMultiprocessor(&per_cu, fwd_kernel, NTHR, 0);
    if (per_cu < 1) per_cu = 1;
    grid_blocks = cus * 1;
  }
  void* args[] = {&p};
  hipError_t e = hipLaunchCooperativeKernel((void*)fwd_kernel, dim3(grid_blocks), dim3(NTHR), args, 0, stream);
  if (e != hipSuccess) fprintf(stderr, "cooperative launch failed: %s (grid %d)\n", hipGetErrorString(e), grid_blocks);
}
```

```cpp
#include <hip/hip_runtime.h>
#include <hip/hip_cooperative_groups.h>
#include <stdint.h>
#include <stdio.h>
#include <string.h>
namespace cg = cooperative_groups;

typedef unsigned short u16;
typedef __attribute__((ext_vector_type(8))) short bf16x8;
typedef __attribute__((ext_vector_type(4))) short s16x4;
typedef __attribute__((ext_vector_type(4))) float f32x4;
typedef __attribute__((ext_vector_type(16))) float f32x16;
typedef __attribute__((ext_vector_type(4))) int i32x4;
typedef __attribute__((ext_vector_type(4))) unsigned u32x4;
typedef __attribute__((ext_vector_type(2))) unsigned u32x2;

#define DI __device__ __forceinline__
#define MFMA32(a, b, c) __builtin_amdgcn_mfma_f32_32x32x16_bf16((a), (b), (c), 0, 0, 0)
#define MFMA16(a, b, c) __builtin_amdgcn_mfma_f32_16x16x32_bf16((a), (b), (c), 0, 0, 0)

constexpr int NB = 4, SEQ = 8192, DM = 1024, NT = NB * SEQ, DFF = 2816;
constexpr int IN0 = 2560, IN1 = 1840, IN1P = 2048;
constexpr int NTHR = 512;
constexpr int NJOBS = 32;

struct TJob { const float* src; u16* dst; int K, N, ldn, perm, tile0, ntn; };

struct Params {
  const float *x, *c, *mod_w, *mod_b, *norm_g, *ffn_w1, *ffn_w2, *mix0_in_w, *conv_w, *conv_b, *wa, *ba, *wx, *bx, *lam,
      *mix0_out_w, *mix1_in_w, *cmp_pos, *cmp_w1, *cmp_w2, *mix1_out_w, *fng;
  float* out;
  u16 *wt1, *wt2, *wtin0, *wtout0, *wtin1, *wtout1, *wtcmp, *wat;
  float *mod, *rope, *cvec, *cent, *lrusum, *pq;
  u16 *h, *big, *vt, *kcmp, *vcmpT;
  unsigned *mcnt, *mlist, *ctr, *xcnt, *lbar;
  u16* part;
  TJob jobs[NJOBS];
  int njobs, ntr_tiles;
};

typedef const __attribute__((address_space(4))) Params* PP;
DI PP launder_p(PP p) { asm volatile("" : "+s"(p)); return p; }

typedef __attribute__((ext_vector_type(2))) float f32x2_;
typedef __attribute__((ext_vector_type(2))) __bf16 bf16x2_;
DI uint32_t pack2(float a, float b) {
  f32x2_ v = {a, b};
  return __builtin_bit_cast(uint32_t, __builtin_convertvector(v, bf16x2_));
}
DI u16 f2bf(float f) { return (u16)(pack2(f, 0.f) & 0xffffu); }
DI float bf2f(u16 h) { return __uint_as_float(((uint32_t)h) << 16); }
DI float bflo(uint32_t w) { return __uint_as_float(w << 16); }
DI float bfhi(uint32_t w) { return __uint_as_float(w & 0xffff0000u); }

DI void wt16(u16* p, u16 v) { *p = v; }
DI void wt32u(unsigned* p, unsigned v) { *p = v; }
DI void wt32f(float* p, float v) { *p = v; }
DI void wt64(void* p, u32x2 v) { *(u32x2*)p = v; }
DI void wt128(void* p, u32x4 v) { *(u32x4*)p = v; }
DI bf16x8 pack8(float a0, float a1, float a2, float a3, float a4, float a5, float a6, float a7) {
  u32x4 p;
  asm volatile("v_cvt_pk_bf16_f32 %0, %4, %5\n\tv_cvt_pk_bf16_f32 %1, %6, %7\n\tv_cvt_pk_bf16_f32 %2, %8, %9\n\tv_cvt_pk_bf16_f32 %3, %10, %11\n\ts_nop 1"
               : "=&v"(p[0]), "=&v"(p[1]), "=&v"(p[2]), "=&v"(p[3])
               : "v"(a0), "v"(a1), "v"(a2), "v"(a3), "v"(a4), "v"(a5), "v"(a6), "v"(a7));
  return __builtin_bit_cast(bf16x8, p);
}
DI int launder(int v) { asm volatile("" : "+v"(v)); return v; }
DI int lane_id_() { int l = __builtin_amdgcn_mbcnt_hi(-1, __builtin_amdgcn_mbcnt_lo(-1, 0)); asm volatile("" : "+v"(l)); return l; }
DI int grab_begin(int ws, unsigned* ctr) {
  int v = 0;
  if (ws == 0 && lane_id_() == 0) v = (int)atomicAdd(ctr, 1u);
  return v;
}
DI int grab_end(int ws, int v, char* shm) {
  int* slot = (int*)(shm + 150016);
  __syncthreads();
  if (ws == 0 && lane_id_() == 0) *slot = v;
  __syncthreads();
  return *slot;
}
DI int grab(int ws, unsigned* ctr, char* shm) { return grab_end(ws, grab_begin(ws, ctr), shm); }
DI int mytid(int ws) { return launder(ws * 64 + lane_id_()); }
template <int M> DI int shxi(int v) {
  if (M < 32) return __builtin_amdgcn_ds_swizzle(v, (M << 10) | 0x1f);
  auto r = __builtin_amdgcn_permlane32_swap((unsigned)v, (unsigned)v, false, false);
  return (int)(r[0] ^ r[1] ^ (unsigned)v);
}
DI float sum8(float v) {
  v += __int_as_float(__builtin_amdgcn_update_dpp(0, __float_as_int(v), 0xB1, 0xF, 0xF, true));
  v += __int_as_float(__builtin_amdgcn_update_dpp(0, __float_as_int(v), 0x4E, 0xF, 0xF, true));
  v += __int_as_float(__builtin_amdgcn_update_dpp(0, __float_as_int(v), 0x141, 0xF, 0xF, true));
  return v;
}
DI float xmax32(float v) {
  auto r = __builtin_amdgcn_permlane32_swap(__float_as_uint(v), __float_as_uint(v), false, false);
  return fmaxf(__uint_as_float(r[0]), __uint_as_float(r[1]));
}
DI float xsum32(float v) {
  auto r = __builtin_amdgcn_permlane32_swap(__float_as_uint(v), __float_as_uint(v), false, false);
  return __uint_as_float(r[0]) + __uint_as_float(r[1]);
}
template <int M> DI float shxf(float v) { return __int_as_float(shxi<M>(__float_as_int(v))); }
DI float sigmoidf_(float x) { return __builtin_amdgcn_rcpf(1.f + __expf(-x)); }
DI float gelu_tanh(float x) {
  const float z = 0.7978845608028654f * (x + 0.044715f * x * x * x);
  const float th = 1.f - 2.f * __builtin_amdgcn_rcpf(1.f + __expf(2.f * z));
  return 0.5f * x * (1.f + th);
}

template <int KS> DI int lds_byte(int r, int c) {
  int st = (r >> 4) * KS + (c >> 5), ob = (r & 15) * 64 + (c & 31) * 2;
  return st * 1024 + (ob ^ (((ob >> 9) & 1) << 5));
}
template <int KS> DI void stage_rc(int b, int& R, int& C) {
  int st = b >> 10, sb = b & 1023, swz = sb ^ (((sb >> 9) & 1) << 5);
  R = (st / KS) * 16 + swz / 64;
  C = (st % KS) * 32 + (swz % 64) / 2;
}
#define WAIT_V(n) asm volatile("s_waitcnt vmcnt(%0)" ::"n"(n) : "memory")

struct TileDesc { const u16* a; long lda, kts; const u16* b; long ldb; int nt; };

typedef f32x4 Acc8[2][2][4][2];
template <class Epi>
DI void gemm_tile(int ws, char* shmc, const TileDesc& td, Epi& epi, int pm, int pn, bool first, bool has_next, const TileDesc& tdn) {
  constexpr int BK = 64, HALF = 128, HT = HALF * BK;
  u16* shm = (u16*)shmc;
  const int tid = mytid(ws), wid = tid >> 6, lane = tid & 63, wr = wid >> 2, wc = wid & 3, fr = lane & 15, fq = lane >> 4;
  const u16* ABASE = td.a;
  const u16* BBASE = td.b;
  const long lda = td.lda, kts = td.kts, ldb = td.ldb;
  const int nt = td.nt;
#define SA(b, h) (shm + ((b) * 2 + (h)) * HT)
#define SB(b, h) (shm + (4 + (b) * 2 + (h)) * HT)
  unsigned voffA, voffB;
  {
    int r0_, c0_;
    stage_rc<2>(tid * 16, r0_, c0_);
    voffA = (unsigned)(r0_ * (int)lda + c0_);
    voffB = (unsigned)(r0_ * (int)ldb + c0_);
  }
#define STAGE_A(P, hf, kt)                                                                                     \
  do {                                                                                                         \
    _Pragma("unroll") for (int _i = 0; _i < 2; ++_i)                                                           \
      __builtin_amdgcn_global_load_lds((const unsigned*)((ABASE + (long)((hf) * HALF + 64 * _i) * lda + (long)(kt) * kts) + voffA), \
                                       (__attribute__((address_space(3))) unsigned*)((char*)(P) + tid * 16 + _i * 8192), 16, 0, 0); \
  } while (0)
#define STAGE_B(P, hf, kt)                                                                                     \
  do {                                                                                                         \
    _Pragma("unroll") for (int _i = 0; _i < 2; ++_i)                                                           \
      __builtin_amdgcn_global_load_lds((const unsigned*)((BBASE + (long)((hf) * HALF + 64 * _i) * ldb + (long)(kt) * BK) + voffB), \
                                       (__attribute__((address_space(3))) unsigned*)((char*)(P) + tid * 16 + _i * 8192), 16, 0, 0); \
  } while (0)
#define LDA_(dst, b, h)                                    \
  _Pragma("unroll") for (int m = 0; m < 4; ++m)            \
  _Pragma("unroll") for (int k = 0; k < 2; ++k)            \
      dst[m][k] = *(const bf16x8*)((const char*)SA(b, h) + lds_byte<2>(wr * 64 + m * 16 + fr, k * 32 + fq * 8))
#define LDB_(dst, b, h)                                    \
  _Pragma("unroll") for (int n = 0; n < 2; ++n)            \
  _Pragma("unroll") for (int k = 0; k < 2; ++k)            \
      dst[n][k] = *(const bf16x8*)((const char*)SB(b, h) + lds_byte<2>(wc * 32 + n * 16 + fr, k * 32 + fq * 8))
#define MMA_(ai, bj, AT, BT)                                                           \
  do {                                                                                 \
    __builtin_amdgcn_s_setprio(1);                                                     \
    _Pragma("unroll") for (int m = 0; m < 4; ++m)                                      \
    _Pragma("unroll") for (int n = 0; n < 2; ++n)                                      \
    _Pragma("unroll") for (int k = 0; k < 2; ++k)                                      \
        acc[ai][bj][m][n] = MFMA16(AT[m][k], BT[n][k], acc[ai][bj][m][n]);             \
    __builtin_amdgcn_s_setprio(0);                                                     \
  } while (0)
#define WV(n) asm volatile("s_waitcnt vmcnt(" #n ")" ::: "memory")
#define WL(n) asm volatile("s_waitcnt lgkmcnt(" #n ")" ::: "memory")
#define BAR __builtin_amdgcn_s_barrier()
#define SCHED __builtin_amdgcn_sched_barrier(0)
  Acc8 acc;
#pragma unroll
  for (int a = 0; a < 2; ++a)
#pragma unroll
    for (int b = 0; b < 2; ++b)
#pragma unroll
      for (int m = 0; m < 4; ++m)
#pragma unroll
        for (int n = 0; n < 2; ++n) acc[a][b][m][n] = f32x4{0.f, 0.f, 0.f, 0.f};
  bf16x8 At[4][2], B0[2][2], B1[2][2];
  if (first) {
    STAGE_B(SB(0, 0), 0, 0); STAGE_A(SA(0, 0), 0, 0);
    STAGE_B(SB(0, 1), 1, 0); STAGE_A(SA(0, 1), 1, 0);
  }
  if (wr == 1) BAR;
  WV(4); BAR;
  STAGE_B(SB(1, 0), 0, 1); STAGE_A(SA(1, 0), 0, 1); STAGE_B(SB(1, 1), 1, 1);
  WV(6); BAR;
  for (int t = 0; t < nt - 2; t += 2) {
    LDB_(B0, 0, 0); SCHED; LDA_(At, 0, 0); STAGE_A(SA(1, 1), 1, t + 1);
    WL(8); BAR; WL(0); MMA_(0, 0, At, B0); BAR; SCHED;
    LDB_(B1, 0, 1); STAGE_B(SB(0, 0), 0, t + 2);
    BAR; WL(0); MMA_(0, 1, At, B1); BAR;
    LDA_(At, 0, 1); STAGE_A(SA(0, 0), 0, t + 2);
    BAR; WL(0); MMA_(1, 0, At, B0); BAR; SCHED;
    STAGE_B(SB(0, 1), 1, t + 2);
    WV(6); BAR; MMA_(1, 1, At, B1); BAR;
    LDB_(B0, 1, 0); SCHED; LDA_(At, 1, 0); STAGE_A(SA(0, 1), 1, t + 2);
    WL(8); BAR; WL(0); MMA_(0, 0, At, B0); BAR; SCHED;
    LDB_(B1, 1, 1); STAGE_B(SB(1, 0), 0, t + 3);
    BAR; WL(0); MMA_(0, 1, At, B1); BAR;
    LDA_(At, 1, 1); STAGE_A(SA(1, 0), 0, t + 3);
    BAR; WL(0); MMA_(1, 0, At, B0); BAR; SCHED;
    STAGE_B(SB(1, 1), 1, t + 3);
    WV(6); BAR; MMA_(1, 1, At, B1); BAR;
  }
  { LDB_(B0, 0, 0); LDA_(At, 0, 0); STAGE_A(SA(1, 1), 1, nt - 1);
    BAR; WL(0); MMA_(0, 0, At, B0); BAR;
    LDB_(B1, 0, 1); BAR; WL(0); MMA_(0, 1, At, B1); BAR;
    LDA_(At, 0, 1); WV(4); BAR; WL(0); MMA_(1, 0, At, B0); MMA_(1, 1, At, B1); BAR; }
  { LDB_(B0, 1, 0); LDA_(At, 1, 0); WV(2); BAR; WL(0); MMA_(0, 0, At, B0); BAR;
    LDB_(B1, 1, 1); WV(0); BAR; WL(0); MMA_(0, 1, At, B1); BAR;
    LDA_(At, 1, 1); BAR; WL(0); MMA_(1, 0, At, B0); MMA_(1, 1, At, B1); BAR; }
  if (wr == 0) BAR;
  if (has_next) {
    ABASE = tdn.a;
    BBASE = tdn.b;
    STAGE_B(SB(0, 0), 0, 0); STAGE_A(SA(0, 0), 0, 0);
    STAGE_B(SB(0, 1), 1, 0); STAGE_A(SA(0, 1), 1, 0);
  }
  epi(pm, pn, acc, wr, wc, fr, fq);
  asm volatile("s_waitcnt vmcnt(0)" ::: "memory");
  __syncthreads();
#undef SA
#undef SB
#undef STAGE_A
#undef STAGE_B
#undef LDA_
#undef LDB_
#undef MMA_
#undef WV
#undef WL
#undef BAR
#undef SCHED
}

template <class Desc, class Epi>
DI void gemm_phase(int ws, int gx, int gslot, char* shm, int nM, int nN, Desc desc, Epi epi) {
  const int ntiles = nM * nN;
  const int G = gridDim.x, bid = blockIdx.x;
  const bool xcdmap = (G % 8 == 0) && (ntiles % 8 == 0);
  const int per = ntiles / 8, slots = G / 8;
  auto tile_at = [&](int i, int& pm, int& pn) -> bool {
    int t;
    if (xcdmap) {
      int lt = gslot + slots * i;
      if (lt >= per) return false;
      t = gx * per + lt;
    } else {
      t = bid + G * i;
      if (t >= ntiles) return false;
    }
    const int WGM = 8;
    int nig = WGM * nN, gid = t / nig, fm = gid * WGM, gsz = min(nM - fm, WGM);
    pm = fm + ((t % nig) % gsz);
    pn = (t % nig) / gsz;
    return true;
  };
  __syncthreads();
  int pm, pn;
  if (!tile_at(0, pm, pn)) return;
  TileDesc td = desc(pm, pn);
  bool first = true;
  for (int i = 0;; ++i) {
    int pmn = 0, pnn = 0;
    const bool more = tile_at(i + 1, pmn, pnn);
    TileDesc tdn = td;
    if (more) tdn = desc(pmn, pnn);
    gemm_tile(ws, shm, td, epi, pm, pn, first, more, tdn);
    if (!more) break;
    td = tdn; pm = pmn; pn = pnn; first = false;
  }
}

DI float wave_sum(float v) {
  v += shxf<32>(v); v += shxf<16>(v); v += shxf<8>(v); v += shxf<4>(v); v += shxf<2>(v); v += shxf<1>(v);
  return v;
}

DI void norm_phase(int ws, int gx, int gslot, const float* __restrict__ x, u16* __restrict__ h, const float* __restrict__ g, const float* __restrict__ shift,
                   const float* __restrict__ scale  ) {
  const int tid_ = mytid(ws), wid = tid_ >> 6, lane = tid_ & 63;
  const int rbase = gx * (NT / 8) + gslot * (NT / 8 / (gridDim.x / 8)) + wid * (NT / 8 / (gridDim.x / 8) / 8);
  const int rcnt = NT / 8 / (gridDim.x / 8) / 8;
  for (int row = rbase; row < rbase + rcnt; ++row) {
    const float4* xr = (const float4*)(x + (long)row * DM);
    float4 v[4];
    float ss = 0.f;
#pragma unroll
    for (int i = 0; i < 4; ++i) {
      v[i] = xr[lane + 64 * i];
      ss += v[i].x * v[i].x + v[i].y * v[i].y + v[i].z * v[i].z + v[i].w * v[i].w;
    }
    ss = wave_sum(ss);
    const float rs = rsqrtf(ss * (1.f / DM) + 1e-6f);
    const int b = row >> 13;
#pragma unroll
    for (int i = 0; i < 4; ++i) {
      const int c4 = lane + 64 * i;
      const float4 gg = ((const float4*)g)[c4];
      const float4 sc = ((const float4*)(scale + (long)b * 9216))[c4];
      const float4 sh = ((const float4*)(shift + (long)b * 9216))[c4];
      float y0 = v[i].x * rs * gg.x * (1.f + sc.x) + sh.x;
      float y1 = v[i].y * rs * gg.y * (1.f + sc.y) + sh.y;
      float y2 = v[i].z * rs * gg.z * (1.f + sc.z) + sh.z;
      float y3 = v[i].w * rs * gg.w * (1.f + sc.w) + sh.w;
      u32x2 pk = {pack2(y0, y1), pack2(y2, y3)};
      wt64(h + (long)row * DM + c4 * 4, pk);
    }
  }
}

DI void final_norm_phase(int ws, int gx, int gslot, float* __restrict__ x, const float* __restrict__ g) {
  const int tid_ = mytid(ws), wid = tid_ >> 6, lane = tid_ & 63;
  const int rbase = gx * (NT / 8) + gslot * (NT / 8 / (gridDim.x / 8)) + wid * (NT / 8 / (gridDim.x / 8) / 8);
  const int rcnt = NT / 8 / (gridDim.x / 8) / 8;
  for (int row = rbase; row < rbase + rcnt; ++row) {
    float4* xr = (float4*)(x + (long)row * DM);
    float4 v[4];
    float ss = 0.f;
#pragma unroll
    for (int i = 0; i < 4; ++i) {
      v[i] = xr[lane + 64 * i];
      ss += v[i].x * v[i].x + v[i].y * v[i].y + v[i].z * v[i].z + v[i].w * v[i].w;
    }
    ss = wave_sum(ss);
    const float rs = rsqrtf(ss * (1.f / DM) + 1e-6f);
#pragma unroll
    for (int i = 0; i < 4; ++i) {
      const int c4 = lane + 64 * i;
      const float4 gg = ((const float4*)g)[c4];
      float4 o = {v[i].x * rs * gg.x, v[i].y * rs * gg.y, v[i].z * rs * gg.z, v[i].w * rs * gg.w};
      xr[c4] = o;
    }
  }
}

DI void prep_phase(int ws, PP p, char* shm) {
  const int tid = mytid(ws);
  float* fs = (float*)shm;
  const int n_tr = p->ntr_tiles;
  const int n_mod = 2 * 144;
  const int n_cv = 8;
  const int n_rope = 128;
  const int n_misc = 1;
  const int total = n_tr + n_mod + n_cv + n_rope + n_misc;
  for (int it = blockIdx.x; it < total; it += gridDim.x) {
    if (it < n_tr) {
      int j = 0;
      for (int q = 1; q < p->njobs; ++q)
        if (it >= p->jobs[q].tile0) j = q;
      TJob jb;
      jb.src = p->jobs[j].src; jb.dst = p->jobs[j].dst; jb.K = p->jobs[j].K; jb.N = p->jobs[j].N; jb.ldn = p->jobs[j].ldn; jb.perm = p->jobs[j].perm; jb.tile0 = p->jobs[j].tile0; jb.ntn = p->jobs[j].ntn;
      const int lt = it - jb.tile0;
      const int ngn = (jb.ntn + 3) >> 2;
      const int tk = lt / ngn, tg4 = lt % ngn;
      const int k0 = tk * 64;
      float4 v[4][2];
#pragma unroll
      for (int u = 0; u < 4; ++u)
#pragma unroll
        for (int rep = 0; rep < 2; ++rep) {
          const int idx = tid + rep * 512, r = idx >> 4, c4 = idx & 15;
          const int n = (tg4 * 4 + u) * 64 + c4 * 4;
          v[u][rep] = float4{0.f, 0.f, 0.f, 0.f};
          if (tg4 * 4 + u < jb.ntn && n < jb.N) v[u][rep] = *(const float4*)(jb.src + (long)(k0 + r) * jb.ldn + n);
        }
#pragma unroll
      for (int u = 0; u < 4; ++u)
#pragma unroll
        for (int rep = 0; rep < 2; ++rep) {
          const int idx = tid + rep * 512, r = idx >> 4, c4 = idx & 15;
          float* f = fs + u * (64 * 65) + r * 65 + c4 * 4;
          f[0] = v[u][rep].x; f[1] = v[u][rep].y; f[2] = v[u][rep].z; f[3] = v[u][rep].w;
        }
      __syncthreads();
#pragma unroll
      for (int u = 0; u < 4; ++u) {
        if (tg4 * 4 + u < jb.ntn) {
          const int n = tid >> 3, ks = tid & 7;
          float e[8];
#pragma unroll
          for (int q = 0; q < 8; ++q) e[q] = fs[u * (64 * 65) + (ks * 8 + q) * 65 + n];
          int ng = (tg4 * 4 + u) * 64 + n, drow = ng;
          if (jb.perm == 1) {
            int isb = ng >= DFF ? 1 : 0, jj = ng - isb * DFF;
            drow = (jj >> 4) * 32 + isb * 16 + (jj & 15);
          }
          u32x4 pk = {pack2(e[0], e[1]), pack2(e[2], e[3]), pack2(e[4], e[5]), pack2(e[6], e[7])};
          wt128(jb.dst + (long)drow * jb.K + k0 + ks * 8, pk);
        }
      }
      __syncthreads();
    } else if (it < n_tr + n_mod) {
      const int q = it - n_tr, l = q / 144, cg0 = (q % 144) * 64;
      for (int i = tid; i < 4096; i += NTHR) {
        float cv = p->c[i];
        fs[i] = cv / (1.f + __expf(-cv));
      }
      __syncthreads();
      const int col = tid & 63, kg = tid >> 6;
      const float* w = p->mod_w + (long)l * DM * 9216 + cg0 + col;
      float a0 = 0.f, a1 = 0.f, a2 = 0.f, a3 = 0.f;
#pragma unroll 16
      for (int k = kg * 128; k < kg * 128 + 128; ++k) {
        float wv = w[(long)k * 9216];
        a0 += fs[k] * wv;
        a1 += fs[1024 + k] * wv;
        a2 += fs[2048 + k] * wv;
        a3 += fs[3072 + k] * wv;
      }
      __syncthreads();
      float* red = fs;
      red[(kg * 4 + 0) * 64 + col] = a0;
      red[(kg * 4 + 1) * 64 + col] = a1;
      red[(kg * 4 + 2) * 64 + col] = a2;
      red[(kg * 4 + 3) * 64 + col] = a3;
      __syncthreads();
      if (tid < 256) {
        int b = tid >> 6;
        float s = 0.f;
#pragma unroll
        for (int g = 0; g < 8; ++g) s += red[(g * 4 + b) * 64 + col];
        wt32f(p->mod + ((long)l * 4 + b) * 9216 + cg0 + col, s + p->mod_b[(long)l * 9216 + cg0 + col]);
      }
      __syncthreads();
    } else if (it < n_tr + n_mod + n_cv) {
      const int q = it - n_tr - n_mod, kv = q >> 2, n = (q & 3) * 32 + (tid & 31), kg = tid >> 5;
      const float* w1 = p->cmp_w1 + (long)kv * 2048 * 128;
      const float* pe = p->cmp_pos + (long)kv * 2048;
      float a = 0.f;
      for (int k = kg * 128; k < kg * 128 + 128; ++k) a += pe[k] * w1[(long)k * 128 + n];
      fs[kg * 32 + (tid & 31)] = a;
      __syncthreads();
      if (tid < 32) {
        float s = 0.f;
        for (int g = 0; g < 16; ++g) s += fs[g * 32 + tid];
        p->cvec[kv * 128 + (q & 3) * 32 + tid] = s;
      }
      __syncthreads();
    } else if (it < n_tr + n_mod + n_cv + n_rope) {
      const int q = it - n_tr - n_mod - n_cv;
      const int e = q * 512 + tid, pos = e >> 3, i = e & 7;
      const float freq = powf(500000.f, -(float)i * 0.125f);
      const float angf = (float)pos * freq;
      const double ang = (double)angf;
      const double n = rint(ang * 0.15915494309189535);
      double r = fma(-n, 6.283185307179586, ang);
      r = fma(-n, 2.4492935982947064e-16, r);
      const float rf = (float)r;
      p->rope[pos * 16 + i] = cosf(rf);
      p->rope[pos * 16 + 8 + i] = sinf(rf);
    } else {
      if (tid < 512) {
        int bg = tid >> 6, d = tid & 63;
        p->kcmp[((long)bg * 512 + 511) * 64 + d] = 0;
        p->vcmpT[((long)bg * 64 + d) * 512 + 511] = 0;
        p->mcnt[tid] = 0u;
        p->mcnt[512 + tid] = 0u;
        if (tid < 64) { p->ctr[tid] = 0u; p->xcnt[tid] = 0u; }
        p->lbar[tid] = 0u;
      }
    }
  }
}

constexpr int KVS = 72;
constexpr int KVT = 64 * KVS;
constexpr float SCL2 = 0.125f * 1.4426950408889634f;

DI void qk_tile(const u16* Ks, const bf16x8* qf, f32x16* s, int rl, int hh) {
#pragma unroll
  for (int kb = 0; kb < 2; ++kb) {
#pragma unroll
    for (int i = 0; i < 16; ++i) s[kb][i] = 0.f;
#pragma unroll
    for (int ks = 0; ks < 4; ++ks) {
      bf16x8 a = *(const bf16x8*)(Ks + (kb * 32 + rl) * KVS + ks * 16 + hh * 8);
      s[kb] = MFMA32(a, qf[ks], s[kb]);
    }
  }
}
DI void pv_tile(const u16* Vs, const f32x16* s, f32x16* o, int rl, int hh) {
#pragma unroll
  for (int kk = 0; kk < 4; ++kk) {
    const int kb = kk >> 1, i0 = 8 * (kk & 1);
    bf16x8 pf = pack8(s[kb][i0], s[kb][i0 + 1], s[kb][i0 + 2], s[kb][i0 + 3], s[kb][i0 + 4], s[kb][i0 + 5], s[kb][i0 + 6], s[kb][i0 + 7]);
#pragma unroll
    for (int db = 0; db < 2; ++db) {
      const u16* vp = Vs + (db * 32 + rl) * KVS + kk * 16 + hh * 4;
      s16x4 lo = *(const s16x4*)vp, hi = *(const s16x4*)(vp + 8);
      bf16x8 a = __builtin_shufflevector(lo, hi, 0, 1, 2, 3, 4, 5, 6, 7);
      o[db] = MFMA32(a, pf, o[db]);
    }
  }
}
DI float fexp2(float x) { return __builtin_amdgcn_exp2f(x); }
template <int MODE>
DI void osm(f32x16* s, uint32_t vm, float& m, float& l, f32x16* o) {
  float mx = -1e30f;
#pragma unroll
  for (int kb = 0; kb < 2; ++kb)
#pragma unroll
    for (int i = 0; i < 16; ++i) {
      if (MODE == 2) s[kb][i] = ((vm >> (kb * 16 + i)) & 1u) ? s[kb][i] : -1e30f;
      mx = fmaxf(mx, s[kb][i]);
    }
  mx *= SCL2;
  if (MODE == 1) mx = vm ? mx : -1e30f;
  mx = xmax32(mx);
  const float mn = fmaxf(m, mx);
  const float alpha = fexp2(m - mn);
  const bool rowok = (MODE == 1) ? (vm != 0u) : true;
  const float mu = (rowok && mn > -1e29f) ? mn : 1e30f;
  float rs = 0.f;
#pragma unroll
  for (int kb = 0; kb < 2; ++kb)
#pragma unroll
    for (int i = 0; i < 16; ++i) {
      const float pv = fexp2(__builtin_fmaf(s[kb][i], SCL2, -mu));
      s[kb][i] = pv;
      rs += pv;
    }
  rs = xsum32(rs);
  l = l * alpha + rs;
  if (__ballot(mn > m) != 0ull) {
#pragma unroll
    for (int db = 0; db < 2; ++db)
#pragma unroll
      for (int i = 0; i < 16; ++i) o[db][i] *= alpha;
  }
  m = mn;
}
DI void online_softmax(f32x16* s, uint32_t vm, float& m, float& l, f32x16* o) {
  const unsigned long long ball = __ballot(vm == 0xffffffffu), bnone = __ballot(vm == 0u);
  if (ball == ~0ull) osm<0>(s, vm, m, l, o);
  else if ((ball | bnone) == ~0ull) osm<1>(s, vm, m, l, o);
  else osm<2>(s, vm, m, l, o);
}
DI uint32_t range_mask(int kpos0, int lo, int hi, int hh) {
  if (kpos0 >= lo && kpos0 + 63 <= hi) return 0xffffffffu;
  if (kpos0 > hi || kpos0 + 63 < lo) return 0u;
  uint32_t vm = 0;
#pragma unroll
  for (int kb = 0; kb < 2; ++kb)
#pragma unroll
    for (int i = 0; i < 16; ++i) {
      int kp = kpos0 + kb * 32 + hh * 4 + (i & 3) + 8 * (i >> 2);
      vm |= (kp >= lo && kp <= hi) ? (1u << (kb * 16 + i)) : 0u;
    }
  return vm;
}

struct KVRegs { u32x4 k, v; };
DI void kv_issue(KVRegs& r, const u16* kptr, long ldk, const u16* vptr, long ldv, int tid) {
  const int row = tid >> 3, seg = tid & 7;
  r.k = *(const u32x4*)(kptr + (long)row * ldk + seg * 8);
  r.v = *(const u32x4*)(vptr + (long)row * ldv + seg * 8);
}
DI void kv_write(const KVRegs& r, u16* Ks, u16* Vs, int tid) {
  const int row = tid >> 3, seg = tid & 7;
  *(u32x4*)(Ks + row * KVS + seg * 8) = r.k;
  *(u32x4*)(Vs + row * KVS + seg * 8) = r.v;
}
template <class TF, class BODY>
DI void kv_loop(u16* kvb, int ntiles, int tid, TF tf, BODY body) {
  KVRegs r;
  const u16 *kp, *vp;
  long ldk, ldv;
  __syncthreads();
  if (ntiles > 0) {
    tf(0, kp, ldk, vp, ldv);
    kv_issue(r, kp, ldk, vp, ldv, tid);
    kv_write(r, kvb, kvb + KVT, tid);
  }
  __syncthreads();
  for (int i = 0; i < ntiles; ++i) {
    const int cur = i & 1;
    if (i + 1 < ntiles) {
      tf(i + 1, kp, ldk, vp, ldv);
      kv_issue(r, kp, ldk, vp, ldv, tid);
    }
    body(i, kvb + cur * 2 * KVT, kvb + cur * 2 * KVT + KVT);
    if (i + 1 < ntiles) kv_write(r, kvb + (cur ^ 1) * 2 * KVT, kvb + (cur ^ 1) * 2 * KVT + KVT, tid);
    __syncthreads();
  }
}
DI void load_qf(bf16x8* qf, const u16* qrow, int hh) {
#pragma unroll
  for (int ks = 0; ks < 4; ++ks) qf[ks] = *(const bf16x8*)(qrow + ks * 16 + hh * 8);
}
DI bf16x8 rope_frag(bf16x8 f, const float* cs  , int hh) {
  u32x4 w = __builtin_bit_cast(u32x4, f), ow;
#pragma unroll
  for (int q = 0; q < 4; ++q) ow[q] = shxi<32>((int)w[q]);
  float mine[8], oth[8], res[8];
#pragma unroll
  for (int q = 0; q < 4; ++q) {
    mine[2 * q] = bflo(w[q]); mine[2 * q + 1] = bfhi(w[q]);
    oth[2 * q] = bflo(ow[q]); oth[2 * q + 1] = bfhi(ow[q]);
  }
  const float sg = hh ? 1.f : -1.f;
#pragma unroll
  for (int i = 0; i < 8; ++i) res[i] = mine[i] * cs[i] + sg * oth[i] * cs[8 + i];
  u32x4 r = {pack2(res[0], res[1]), pack2(res[2], res[3]), pack2(res[4], res[5]), pack2(res[6], res[7])};
  return __builtin_bit_cast(bf16x8, r);
}
DI void store_o(u16* yrow, const f32x16* o, float scale, int hh) {
#pragma unroll
  for (int db = 0; db < 2; ++db)
#pragma unroll
    for (int q = 0; q < 4; ++q) {
      u32x2 pk = {pack2(o[db][4 * q] * scale, o[db][4 * q + 1] * scale), pack2(o[db][4 * q + 2] * scale, o[db][4 * q + 3] * scale)};
      wt64(yrow + db * 32 + 8 * q + 4 * hh, pk);
    }
}

DI void kprep0_phase(int ws, PP p, char* shm) {
  const int tid = mytid(ws);
  float* fs = (float*)shm;
  u16* u = p->big;
  for (int item = blockIdx.x; item < 256; item += gridDim.x) {
    const int b = item >> 6, n = (item >> 1) & 31, hg = item & 1;
    const int cc = tid & 31, tg = tid >> 5, head = hg * 4 + (cc >> 3), dch = cc & 7;
    float sum[8];
#pragma unroll
    for (int e = 0; e < 8; ++e) sum[e] = 0.f;
#pragma unroll 1
    for (int tb = 0; tb < 16; tb += 8) {
    u32x4 wv[8];
#pragma unroll
    for (int t8 = 0; t8 < 8; ++t8) wv[t8] = *(const u32x4*)(u + ((long)b * SEQ + n * 256 + tg * 16 + tb + t8) * IN0 + 1536 + head * 64 + dch * 8);
#pragma unroll
    for (int t8 = 0; t8 < 8; ++t8) {
      const int tt = tb + t8;
      const int tok = n * 256 + tg * 16 + tt;
      u16* ptr = u + ((long)b * SEQ + tok) * IN0 + 1536 + head * 64 + dch * 8;
      u32x4 w = wv[t8], ow;
#pragma unroll
      for (int q = 0; q < 4; ++q) ow[q] = shxi<1>((int)w[q]);
      float mine[8], oth[8];
#pragma unroll
      for (int q = 0; q < 4; ++q) {
        mine[2 * q] = bflo(w[q]); mine[2 * q + 1] = bfhi(w[q]);
        oth[2 * q] = bflo(ow[q]); oth[2 * q + 1] = bfhi(ow[q]);
      }
      if (dch < 2) {
        const float* cs = p->rope + tok * 16;
        const float sg = dch ? 1.f : -1.f;
        float res[8];
#pragma unroll
        for (int i = 0; i < 8; ++i) res[i] = mine[i] * cs[i] + sg * oth[i] * cs[8 + i];
        u32x4 r = {pack2(res[0], res[1]), pack2(res[2], res[3]), pack2(res[4], res[5]), pack2(res[6], res[7])};
        wt128(ptr, r);
#pragma unroll
        for (int q = 0; q < 4; ++q) { mine[2 * q] = bflo(r[q]); mine[2 * q + 1] = bfhi(r[q]); }
      }
#pragma unroll
      for (int e = 0; e < 8; ++e) sum[e] += mine[e];
    }
    }
    __syncthreads();
#pragma unroll
    for (int e = 0; e < 8; ++e) fs[tg * 256 + cc * 8 + e] = sum[e];
    __syncthreads();
    if (tid < 256) {
      float t = 0.f;
#pragma unroll
      for (int g = 0; g < 16; ++g) t += fs[g * 256 + tid];
      wt32f(p->cent + (((long)b * 8 + hg * 4 + (tid >> 6)) * 32 + n) * 64 + (tid & 63), t * (1.f / 256.f));
    }
    __syncthreads();
  }
}

template <bool FINAL>
DI void lru_item(int ws, PP p, char* shm, int item) {
  const int tid = mytid(ws), wid = tid >> 6, lane = tid & 63, rl = lane & 31, hh = lane >> 5;
  const int b = item & 3, c = 127 - (item >> 2), t0 = c * 64;
  const u16* u = p->big;
  u16* XC = (u16*)shm + wid * KVT;
  {
    const int ch = wid * 64 + lane;
    const float w0 = p->conv_w[ch], w1 = p->conv_w[512 + ch], w2 = p->conv_w[1024 + ch], w3 = p->conv_w[1536 + ch], cb = p->conv_b[ch];
    const u16* up = u + ((long)b * SEQ + t0) * IN0 + ch;
    float xm3 = 0.f, xm2 = 0.f, xm1 = 0.f;
    if (t0 > 0) { xm3 = bf2f(up[-3 * IN0]); xm2 = bf2f(up[-2 * IN0]); xm1 = bf2f(up[-1 * IN0]); }
    for (int t = 0; t < 64; ++t) {
      float xv = bf2f(up[(long)t * IN0]);
      float xc = w0 * xm3 + w1 * xm2 + w2 * xm1 + w3 * xv + cb;
      XC[t * KVS + lane] = f2bf(xc);
      xm3 = xm2; xm2 = xm1; xm1 = xv;
    }
  }
  __syncthreads();
  const u16* wat = p->wat + (long)wid * 4096;
  const u16* wxt = p->wat + (long)(8 + wid) * 4096;
#pragma unroll 1
  for (int nb = 0; nb < 2; ++nb) {
    f32x16 ar[2], ai[2];
#pragma unroll
    for (int mb = 0; mb < 2; ++mb)
#pragma unroll
      for (int i = 0; i < 16; ++i) { ar[mb][i] = 0.f; ai[mb][i] = 0.f; }
#pragma unroll
    for (int ks = 0; ks < 4; ++ks) {
      bf16x8 ba_ = *(const bf16x8*)(wat + (nb * 32 + rl) * 64 + ks * 16 + hh * 8);
      bf16x8 bx_ = *(const bf16x8*)(wxt + (nb * 32 + rl) * 64 + ks * 16 + hh * 8);
#pragma unroll
      for (int mb = 0; mb < 2; ++mb) {
        bf16x8 a = *(const bf16x8*)(XC + (mb * 32 + rl) * KVS + ks * 16 + hh * 8);
        ar[mb] = MFMA32(a, ba_, ar[mb]);
        ai[mb] = MFMA32(a, bx_, ai[mb]);
      }
    }
    const int j = nb * 32 + rl, chj = wid * 64 + j;
    const float baj = p->ba[chj], bxj = p->bx[chj];
    const float la = -8.f * log1pf(__expf(-p->lam[chj]));
#pragma unroll
    for (int mb = 0; mb < 2; ++mb)
#pragma unroll
      for (int i = 0; i < 16; ++i) {
        const int tok = mb * 32 + hh * 4 + (i & 3) + 8 * (i >> 2);
        const float xc = bf2f(XC[tok * KVS + j]);
        const float r = sigmoidf_(ar[mb][i] + baj), ig = sigmoidf_(ai[mb][i] + bxj);
        const float aa = __expf(r * la);
        ar[mb][i] = aa;
        ai[mb][i] = __builtin_amdgcn_sqrtf(__builtin_fmaf(-aa, aa, 1.f)) * ig * xc;
      }
    float carry = 0.f, atot = 1.f;
    if (FINAL) {
      const float* sm = p->lrusum + ((long)b * 128 * 512 + chj) * 2;
#pragma unroll 8
      for (int cp = 0; cp < c; ++cp) {
        float2 ab = *(const float2*)(sm + (long)cp * 1024);
        carry = ab.y + ab.x * carry;
      }
    }
#pragma unroll
    for (int mb = 0; mb < 2; ++mb)
#pragma unroll
      for (int q = 0; q < 4; ++q) {
        float P = 1.f, H = 0.f;
#pragma unroll
        for (int e = 0; e < 4; ++e) {
          const int idx = 4 * q + e;
          H = ar[mb][idx] * H + ai[mb][idx];
          P *= ar[mb][idx];
          ar[mb][idx] = P;
          ai[mb][idx] = H;
        }
        const float Po = shxf<32>(P), Ho = shxf<32>(H);
        const float A0 = hh ? Po : P, B0 = hh ? Ho : H, A1 = hh ? P : Po, B1 = hh ? H : Ho;
        const float mid = B0 + A0 * carry;
        const float cin = hh ? mid : carry;
        carry = B1 + A1 * mid;
        atot *= A0 * A1;
        if (FINAL) {
          const int tl0 = launder(hh * 4);
#pragma unroll
          for (int e = 0; e < 4; ++e) {
            const int idx = 4 * q + e;
            const int tok = mb * 32 + tl0 + e + 8 * q;
            const float hv = ai[mb][idx] + ar[mb][idx] * cin;
            const long trow = (long)b * SEQ + t0 + tok;
            const float g = bf2f(u[trow * IN0 + 512 + chj]);
            wt16(p->h + trow * DM + chj, f2bf(hv * gelu_tanh(g)));
          }
        }
      }
    if (!FINAL && hh == 0) {
      float2 ab = {atot, carry};
      wt64(p->lrusum + (((long)b * 128 + c) * 512 + chj) * 2, __builtin_bit_cast(u32x2, ab));
    }
  }
  __syncthreads();
}

DI int moba_off(int n) { return 256 * (31 * n - (n * (n - 1)) / 2); }

DI void moba_gate_item(int ws, PP p, char* shm, int item) {
  const int tid = mytid(ws);
  const int qb = 31 - (item >> 5), b = (item >> 3) & 3, h = item & 7;
  if (qb == 0) return;
  const int t0 = qb * 256;
  const u16* u = p->big;
  float* cs = (float*)shm;
  float* tv = (float*)(shm + 8192);
  int* ti = (int*)(shm + 11264);
  __syncthreads();
  for (int i = tid; i < qb * 64; i += NTHR) cs[i] = p->cent[((long)(b * 8 + h) * 32) * 64 + i];
  __syncthreads();
  const int ql = tid & 255, half = tid >> 8, tq = t0 + ql;
  const u16* qp = u + ((long)b * SEQ + tq) * IN0 + 1024 + h * 64;
  float q[64];
#pragma unroll
  for (int s8 = 0; s8 < 8; ++s8) {
    u32x4 w = *(const u32x4*)(qp + s8 * 8);
#pragma unroll
    for (int e = 0; e < 4; ++e) { q[s8 * 8 + 2 * e] = bflo(w[e]); q[s8 * 8 + 2 * e + 1] = bfhi(w[e]); }
  }
  {
    const float* rc = p->rope + tq * 16;
#pragma unroll
    for (int i = 0; i < 8; ++i) {
      float x1 = q[i], x2 = q[8 + i], cc = rc[i], sn = rc[8 + i];
      q[i] = bf2f(f2bf(x1 * cc - x2 * sn));
      q[8 + i] = bf2f(f2bf(x2 * cc + x1 * sn));
    }
  }
  float v0 = -INFINITY, v1 = -INFINITY, v2 = -INFINITY;
  int i0 = -1, i1 = -1, i2 = -1;
  for (int n = half; n < qb; n += 2) {
    const float4* cr = (const float4*)(cs + n * 64);
    float d = 0.f;
#pragma unroll
    for (int e = 0; e < 16; ++e) {
      float4 cv = cr[e];
      d += q[4 * e] * cv.x + q[4 * e + 1] * cv.y + q[4 * e + 2] * cv.z + q[4 * e + 3] * cv.w;
    }
    if (d > v0) { v2 = v1; i2 = i1; v1 = v0; i1 = i0; v0 = d; i0 = n; }
    else if (d > v1) { v2 = v1; i2 = i1; v1 = d; i1 = n; }
    else if (d > v2) { v2 = d; i2 = n; }
  }
  if (half == 1) {
    tv[ql * 3] = v0; tv[ql * 3 + 1] = v1; tv[ql * 3 + 2] = v2;
    ti[ql * 3] = i0; ti[ql * 3 + 1] = i1; ti[ql * 3 + 2] = i2;
  }
  __syncthreads();
  if (half == 0) {
#pragma unroll
    for (int e = 0; e < 3; ++e) {
      const float d = tv[ql * 3 + e];
      const int n = ti[ql * 3 + e];
      if (n >= 0) {
        if (d > v0 || (d == v0 && n < i0)) { v2 = v1; i2 = i1; v1 = v0; i1 = i0; v0 = d; i0 = n; }
        else if (d > v1 || (d == v1 && n < i1)) { v2 = v1; i2 = i1; v1 = d; i1 = n; }
        else if (d > v2 || (d == v2 && n < i2)) { v2 = d; i2 = n; }
      }
    }
  }
  int* lcnt = (int*)(shm + 14336);
  if (tid < 64) lcnt[tid] = 0;
  __syncthreads();
  int r0 = 0, r1 = 0, r2 = 0;
  if (half == 0) {
    if (i0 >= 0) r0 = atomicAdd(&lcnt[i0], 1);
    if (i1 >= 0) r1 = atomicAdd(&lcnt[i1], 1);
    if (i2 >= 0) r2 = atomicAdd(&lcnt[i2], 1);
  }
  __syncthreads();
  const int bh = b * 8 + h;
  if (tid < 32 && lcnt[tid] > 0) lcnt[32 + tid] = (int)atomicAdd(&p->mcnt[bh * 32 + tid], (unsigned)lcnt[tid]);
  __syncthreads();
  if (half == 0) {
    unsigned* lst = p->mlist + (long)bh * 126976;
    if (i0 >= 0) wt32u(lst + moba_off(i0) + lcnt[32 + i0] + r0, ((unsigned)tq << 2) | 0u);
    if (i1 >= 0) wt32u(lst + moba_off(i1) + lcnt[32 + i1] + r1, ((unsigned)tq << 2) | 1u);
    if (i2 >= 0) wt32u(lst + moba_off(i2) + lcnt[32 + i2] + r2, ((unsigned)tq << 2) | 2u);
  }
}

DI void moba_gather_phase(int ws, PP p, char* shm) {
  const int tid = mytid(ws), wid = tid >> 6, lane = tid & 63, rl = lane & 31, hh = lane >> 5;
  const u16* u = p->big;
  u16* kvb = (u16*)shm;
  int* pre = (int*)(shm + 120000);
  __syncthreads();
  {
    const int c0 = (int)((p->mcnt[2 * tid] + 255u) >> 8), c1 = (int)((p->mcnt[2 * tid + 1] + 255u) >> 8);
    int sc = c0 + c1;
#pragma unroll
    for (int d = 1; d < 64; d <<= 1) {
      const int o = __shfl_up(sc, d);
      if (lane >= d) sc += o;
    }
    int* wtot = pre + 1032;
    if (lane == 63) wtot[wid] = sc;
    __syncthreads();
    int base = 0;
    for (int w = 0; w < wid; ++w) base += wtot[w];
    const int excl = base + sc - (c0 + c1);
    if (tid == 0) pre[0] = 0;
    pre[2 * tid + 1] = excl + c0;
    pre[2 * tid + 2] = excl + c0 + c1;
  }
  __syncthreads();
  const int total = pre[1024];
  const int row = tid >> 3, seg = tid & 7;
  u32x4 kr[4], vr[4];
  auto locate = [&](int it, int& li, int& chunk) {
    int lo = 0, hi = 1024;
    while (hi - lo > 1) {
      const int mid = (lo + hi) >> 1;
      if (pre[mid] <= it) lo = mid; else hi = mid;
    }
    li = lo;
    chunk = it - pre[lo];
  };
  auto issue = [&](int li) {
    const int bh = li >> 5, n = li & 31, b = bh >> 3, h = bh & 7;
    const u16* kbase = u + ((long)b * SEQ + n * 256) * IN0 + 1536 + h * 64;
    const u16* vbase = p->vt + ((long)bh * 64) * SEQ + n * 256;
#pragma unroll
    for (int st = 0; st < 4; ++st) {
      kr[st] = *(const u32x4*)(kbase + (long)(st * 64 + row) * IN0 + seg * 8);
      vr[st] = *(const u32x4*)(vbase + (long)row * SEQ + st * 64 + seg * 8);
    }
  };
  int li = 0, chunk = 0;
  int* gslot = (int*)(shm + 150016);
  int it = grab(ws, p->ctr + 2, shm);
  if (it < total) { locate(it, li, chunk); issue(li); }
#pragma unroll 1
  while (it < total) {
    const int bh = li >> 5, n = li & 31, b = bh >> 3, h = bh & 7;
    const int cnt = (int)p->mcnt[li];
    __syncthreads();
#pragma unroll
    for (int st = 0; st < 4; ++st) {
      *(u32x4*)(kvb + st * 2 * KVT + row * KVS + seg * 8) = kr[st];
      *(u32x4*)(kvb + st * 2 * KVT + KVT + row * KVS + seg * 8) = vr[st];
    }
    const int e = chunk * 256 + wid * 32 + rl;
    const bool valid = e < cnt;
    const unsigned ent = p->mlist[(long)bh * 126976 + moba_off(n) + (valid ? e : 0)];
    const int tq = (int)(ent >> 2), slot = (int)(ent & 3u);
    bf16x8 qf[4];
    load_qf(qf, u + ((long)b * SEQ + tq) * IN0 + 1024 + h * 64, hh);
    qf[0] = rope_frag(qf[0], p->rope + tq * 16, hh);
    if (tid == 0) *gslot = (int)atomicAdd(p->ctr + 2, 1u);
    f32x16 o[2];
#pragma unroll
    for (int db = 0; db < 2; ++db)
#pragma unroll
      for (int i = 0; i < 16; ++i) o[db][i] = 0.f;
    float m = -1e30f, l = 0.f;
    __syncthreads();
    const int itn = *gslot;
    int lin = 0, chunkn = 0;
    if (itn < total) { locate(itn, lin, chunkn); issue(lin); }
#pragma unroll
    for (int st = 0; st < 4; ++st) {
      f32x16 s[2];
      qk_tile(kvb + st * 2 * KVT, qf, s, rl, hh);
      osm<0>(s, 0xffffffffu, m, l, o);
      pv_tile(kvb + st * 2 * KVT + KVT, s, o, rl, hh);
    }
    if (valid) {
      u16* pe = p->part + (((long)bh * SEQ + tq) * 3 + slot) * 72;
      store_o(pe + 8, o, 1.f / l, hh);
      if (hh == 0) { wt32f((float*)pe, m); wt32f((float*)pe + 1, l); }
    }
    li = lin; chunk = chunkn; it = itn;
  }
  __syncthreads();
}

DI void moba_own_item(int ws, PP p, char* shm, int item) {
  const int tid = mytid(ws), wid = tid >> 6, lane = tid & 63, rl = lane & 31, hh = lane >> 5;
  const int qb = 31 - (item >> 5), b = (item >> 3) & 3, h = item & 7;
  const int t0 = qb * 256;
  const u16* u = p->big;
  u16* kvb = (u16*)shm;
  const int tq = t0 + wid * 32 + rl;
  bf16x8 qf[4];
  load_qf(qf, u + ((long)b * SEQ + tq) * IN0 + 1024 + h * 64, hh);
  qf[0] = rope_frag(qf[0], p->rope + tq * 16, hh);
  f32x16 o[2];
#pragma unroll
  for (int db = 0; db < 2; ++db)
#pragma unroll
    for (int i = 0; i < 16; ++i) o[db][i] = 0.f;
  float m = -1e30f, l = 0.f;
  const u16* kbase = u + ((long)b * SEQ + t0) * IN0 + 1536 + h * 64;
  const u16* vbase = p->vt + ((long)(b * 8 + h) * 64) * SEQ + t0;
  auto tf = [&](int i, const u16*& kp, long& ldk, const u16*& vp, long& ldv) {
    kp = kbase + (long)i * 64 * IN0; ldk = IN0;
    vp = vbase + i * 64; ldv = SEQ;
  };
  auto body = [&](int i, const u16* Ks, const u16* Vs) {
    const uint32_t vm = range_mask(i * 64, 0, wid * 32 + rl, hh);
    if (__ballot(vm != 0) != 0ull) {
      f32x16 s[2];
      qk_tile(Ks, qf, s, rl, hh);
      online_softmax(s, vm, m, l, o);
      pv_tile(Vs, s, o, rl, hh);
    }
  };
  kv_loop(kvb, 4, tid, tf, body);
  const int nsl = qb < 3 ? qb : 3;
#pragma unroll 1
  for (int sl = 0; sl < nsl; ++sl) {
    const u16* pe = p->part + (((long)(b * 8 + h) * SEQ + tq) * 3 + sl) * 72;
    const float ms = ((const float*)pe)[0], ls = ((const float*)pe)[1];
    const float mn = fmaxf(m, ms);
    const float a = fexp2(m - mn), c = fexp2(ms - mn) * ls;
#pragma unroll
    for (int db = 0; db < 2; ++db)
#pragma unroll
      for (int q = 0; q < 4; ++q) {
        const u32x2 w = *(const u32x2*)(pe + 8 + db * 32 + 8 * q + 4 * hh);
        o[db][4 * q] = o[db][4 * q] * a + c * bflo(w[0]);
        o[db][4 * q + 1] = o[db][4 * q + 1] * a + c * bfhi(w[0]);
        o[db][4 * q + 2] = o[db][4 * q + 2] * a + c * bflo(w[1]);
        o[db][4 * q + 3] = o[db][4 * q + 3] * a + c * bfhi(w[1]);
      }
    l = l * a + c;
    m = mn;
  }
  store_o(p->h + ((long)b * SEQ + tq) * DM + 512 + h * 64, o, 1.f / l, hh);
}

DI void rope1_phase(int ws, PP p) {
  const int tid = mytid(ws);
  u16* u = p->big;
  for (int e = blockIdx.x * NTHR + tid; e < NT * 4; e += gridDim.x * NTHR) {
    const int trow = e >> 2, w = e & 3, pos = trow & (SEQ - 1);
    u16* ptr = u + (long)trow * IN1P + ((w & 2) ? 1536 : 1280) + (w & 1) * 64;
    u32x4 a = *(const u32x4*)ptr, bq = *(const u32x4*)(ptr + 8);
    const float* cs = p->rope + pos * 16;
    float x1[8], x2[8], r1[8], r2[8];
#pragma unroll
    for (int q = 0; q < 4; ++q) { x1[2 * q] = bflo(a[q]); x1[2 * q + 1] = bfhi(a[q]); x2[2 * q] = bflo(bq[q]); x2[2 * q + 1] = bfhi(bq[q]); }
#pragma unroll
    for (int i = 0; i < 8; ++i) { r1[i] = x1[i] * cs[i] - x2[i] * cs[8 + i]; r2[i] = x2[i] * cs[i] + x1[i] * cs[8 + i]; }
    u32x4 oa = {pack2(r1[0], r1[1]), pack2(r1[2], r1[3]), pack2(r1[4], r1[5]), pack2(r1[6], r1[7])};
    u32x4 ob = {pack2(r2[0], r2[1]), pack2(r2[2], r2[3]), pack2(r2[4], r2[5]), pack2(r2[6], r2[7])};
    wt128(ptr, oa);
    wt128(ptr + 8, ob);
  }
}
DI void cmpfin_phase(int ws, PP p, char* shm) {
  const int tid = mytid(ws);
  float* hid = (float*)shm;
  float* w2s = (float*)(shm + 4096);
  int kvl = -1;
  for (int it = blockIdx.x; it < 1024; it += gridDim.x) {
    const int kv = it >> 9, bg = (it >> 6) & 7, i0 = (it & 63) * 8;
    const int row = tid >> 6, n = tid & 63, i = i0 + row;
    const float* pq = p->pq + ((long)kv * 4096 + bg * 512) * 256;
    __syncthreads();
    if (kv != kvl) {
      const float* w2 = p->cmp_w2 + (long)kv * 128 * 64;
      for (int e = tid; e < 128 * 64; e += NTHR) w2s[e] = w2[e];
      kvl = kv;
    }
#pragma unroll
    for (int hf = 0; hf < 2; ++hf) {
      const int nn = n + hf * 64;
      float v = 0.f;
      if (i < 511) v = gelu_tanh(pq[(long)i * 256 + nn] + pq[(long)(i + 1) * 256 + 128 + nn] + p->cvec[kv * 128 + nn]);
      hid[row * 128 + nn] = v;
    }
    __syncthreads();
    float acc = 0.f;
#pragma unroll 8
    for (int k = 0; k < 128; ++k) acc += hid[row * 128 + k] * w2s[k * 64 + n];
    if (i < 511) {
      if (kv == 0) wt16(p->kcmp + ((long)bg * 512 + i) * 64 + n, f2bf(acc));
      else wt16(p->vcmpT + ((long)bg * 64 + n) * 512 + i, f2bf(acc));
    }
  }
  __syncthreads();
}

DI void nsa_item(int ws, PP p, char* shm, int item) {
  const int tid = mytid(ws), wid = tid >> 6, lane = tid & 63, rl = lane & 31, hh = lane >> 5;
  const int tt = 255 - (item >> 3), bg = item & 7, b = bg >> 1, g = bg & 1;
  const int t0 = tt * 32, tokl = wid * 4 + (rl >> 3), tok = t0 + tokl, r = rl & 7, hq = g * 8 + r;
  const u16* u = p->big;
  u16* kvb = (u16*)shm;
  float* impm = (float*)(shm + 36864);
  float* imps = (float*)(shm + 53760);
  float* vals = (float*)(shm + 70656);
  unsigned char* selb = (unsigned char*)(shm + 147456);
  uint32_t* un = (uint32_t*)(shm + 147968);
  int* tl = (int*)(shm + 148032);
  __syncthreads();
  for (int i = tid; i < 2 * 32 * 132; i += NTHR) impm[i] = 0.f;
  if (tid < 8) un[tid] = 0;
  const u16* qrow = u + ((long)b * SEQ + tok) * IN1P + hq * 64;
  bf16x8 qn[4], qr[4];
  load_qf(qn, qrow, hh);
  qr[0] = rope_frag(qn[0], p->rope + tok * 16, hh);
  qr[1] = qn[1]; qr[2] = qn[2]; qr[3] = qn[3];
  float gt[3];
#pragma unroll
  for (int br = 0; br < 3; ++br) gt[br] = sigmoidf_(bf2f(qrow[1792 - hq * 64 + hq * 3 + br]));
  f32x16 yacc[2], o[2];
#pragma unroll
  for (int db = 0; db < 2; ++db)
#pragma unroll
    for (int i = 0; i < 16; ++i) { yacc[db][i] = 0.f; o[db][i] = 0.f; }
  {
    const int nct = (t0 >> 10) + 1;
    const int cmax = (tok - 31) >> 4;
    const u16* kc = p->kcmp + (long)bg * 512 * 64;
    const u16* vc = p->vcmpT + (long)bg * 64 * 512;
    auto tf = [&](int i, const u16*& kp, long& ldk, const u16*& vp, long& ldv) {
      kp = kc + (long)i * 64 * 64; ldk = 64;
      vp = vc + i * 64; ldv = 512;
    };
    float m = -1e30f, l = 0.f;
    auto body1 = [&](int i, const u16* Ks, const u16* Vs) {
      const uint32_t vm = range_mask(i * 64, 0, cmax, hh);
      f32x16 s[2];
      qk_tile(Ks, qn, s, rl, hh);
      float mx = -1e30f;
#pragma unroll
      for (int kb = 0; kb < 2; ++kb)
#pragma unroll
        for (int ii = 0; ii < 16; ++ii) {
          float v = s[kb][ii] * SCL2;
          v = ((vm >> (kb * 16 + ii)) & 1u) ? v : -1e30f;
          s[kb][ii] = v;
          mx = fmaxf(mx, v);
        }
      mx = xmax32(mx);
      const float mn = fmaxf(m, mx);
      float rs = 0.f;
#pragma unroll
      for (int kb = 0; kb < 2; ++kb)
#pragma unroll
        for (int ii = 0; ii < 16; ++ii) rs += ((vm >> (kb * 16 + ii)) & 1u) ? fexp2(s[kb][ii] - mn) : 0.f;
      rs = xsum32(rs);
      l = l * fexp2(m - mn) + rs;
      m = mn;
    };
    kv_loop(kvb, nct, tid, tf, body1);
    const float invl = l > 0.f ? 1.f / l : 0.f;
    auto body2 = [&](int i, const u16* Ks, const u16* Vs) {
      const uint32_t vm = range_mask(i * 64, 0, cmax, hh);
      f32x16 s[2];
      qk_tile(Ks, qn, s, rl, hh);
#pragma unroll
      for (int kb = 0; kb < 2; ++kb)
#pragma unroll
        for (int ii = 0; ii < 16; ++ii) s[kb][ii] = ((vm >> (kb * 16 + ii)) & 1u) ? fexp2(__builtin_fmaf(s[kb][ii], SCL2, -m)) * invl : 0.f;
      pv_tile(Vs, s, o, rl, hh);
#pragma unroll
      for (int kb = 0; kb < 2; ++kb)
#pragma unroll
        for (int q4 = 0; q4 < 4; ++q4) {
          float mainv = s[kb][4 * q4] + s[kb][4 * q4 + 1] + s[kb][4 * q4 + 2] + 0.5f * s[kb][4 * q4 + 3];
          float sp = 0.5f * s[kb][4 * q4 + 3];
          mainv = sum8(mainv);
          sp = sum8(sp);
          if (r == 0) {
            const int j = 16 * i + 8 * kb + 2 * q4 + hh;
            impm[tokl * 132 + j] = mainv;
            imps[tokl * 132 + j + 1] = sp;
          }
        }
    };
    kv_loop(kvb, nct, tid, tf, body2);
#pragma unroll
    for (int db = 0; db < 2; ++db)
#pragma unroll
      for (int i = 0; i < 16; ++i) { yacc[db][i] = gt[0] * o[db][i]; o[db][i] = 0.f; }
  }
  __syncthreads();
  {
    const int tk = tid >> 4, jg = tid & 15, blk = (t0 + tk) >> 6;
    float v[8];
#pragma unroll
    for (int e = 0; e < 8; ++e) {
      const int j = jg * 8 + e;
      float x = impm[tk * 132 + j] + imps[tk * 132 + j];
      if (j == 0 || j == blk || j == blk - 1) x = 1e30f;
      if (j > blk) x = -INFINITY;
      v[e] = x;
      vals[tk * 132 + j] = x;
    }
    uint32_t key[8];
#pragma unroll
    for (int e = 0; e < 8; ++e) {
      const uint32_t uu = __float_as_uint(v[e]);
      key[e] = (uu & 0x80000000u) ? ~uu : (uu | 0x80000000u);
    }
    auto rowsum = [](int c) {
      c += __builtin_amdgcn_update_dpp(0, c, 0x128, 0xF, 0xF, true);
      c += __builtin_amdgcn_update_dpp(0, c, 0x124, 0xF, 0xF, true);
      c += __builtin_amdgcn_update_dpp(0, c, 0x122, 0xF, 0xF, true);
      c += __builtin_amdgcn_update_dpp(0, c, 0x121, 0xF, 0xF, true);
      return c;
    };
    uint32_t pfx = 0;
#pragma unroll 1
    for (int b = 31; b >= 0; --b) {
      const uint32_t cand = pfx | (1u << b);
      int c = 0;
#pragma unroll
      for (int e = 0; e < 8; ++e) c += (key[e] >= cand) ? 1 : 0;
      c = rowsum(c);
      if (c >= 16) pfx = cand;
    }
    int cgt = 0, teq = 0;
#pragma unroll
    for (int e = 0; e < 8; ++e) { cgt += (key[e] > pfx) ? 1 : 0; teq += (key[e] == pfx) ? 1 : 0; }
    cgt = rowsum(cgt);
    int tin = teq;
    tin += __builtin_amdgcn_update_dpp(0, tin, 0x111, 0xF, 0xF, true);
    tin += __builtin_amdgcn_update_dpp(0, tin, 0x112, 0xF, 0xF, true);
    tin += __builtin_amdgcn_update_dpp(0, tin, 0x114, 0xF, 0xF, true);
    tin += __builtin_amdgcn_update_dpp(0, tin, 0x118, 0xF, 0xF, true);
    int run = cgt + tin - teq;
    uint32_t bits = 0;
#pragma unroll
    for (int e = 0; e < 8; ++e) {
      const bool eq = key[e] == pfx;
      const bool sel = (key[e] > pfx) || (eq && run < 16);
      run += eq ? 1 : 0;
      bits |= (sel && (jg * 8 + e) <= blk) ? (1u << e) : 0u;
    }
    selb[tk * 16 + jg] = (unsigned char)bits;
    __syncthreads();
    if (tid < 32) {
      const uint32_t* w = (const uint32_t*)(selb + tid * 16);
      atomicOr(&un[0], w[0]); atomicOr(&un[1], w[1]); atomicOr(&un[2], w[2]); atomicOr(&un[3], w[3]);
    }
    __syncthreads();
    if (tid < 128) {
      const uint32_t u0 = un[0], u1 = un[1], u2 = un[2], u3 = un[3];
      const int w = tid >> 5, bpos = tid & 31;
      const uint32_t uw = w == 0 ? u0 : w == 1 ? u1 : w == 2 ? u2 : u3;
      const int below = (w > 0 ? __popc(u0) : 0) + (w > 1 ? __popc(u1) : 0) + (w > 2 ? __popc(u2) : 0);
      if ((uw >> bpos) & 1u) tl[below + __popc(uw & ((1u << bpos) - 1u))] = tid;
      if (tid == 0) un[4] = __popc(u0) + __popc(u1) + __popc(u2) + __popc(u3);
    }
    __syncthreads();
  }
  {
    const int ntl = (int)un[4];
    const u32x4 ms = *(const u32x4*)(selb + tokl * 16);
    const u16* kb_ = u + (long)b * SEQ * IN1P + 1280 + g * 64;
    const u16* vb_ = p->vt + (long)bg * 64 * SEQ;
    auto tf = [&](int i, const u16*& kp, long& ldk, const u16*& vp, long& ldv) {
      const int j = tl[i];
      kp = kb_ + (long)j * 64 * IN1P; ldk = IN1P;
      vp = vb_ + j * 64; ldv = SEQ;
    };
    float m = -1e30f, l = 0.f;
    auto body = [&](int i, const u16* Ks, const u16* Vs) {
      const int j = tl[i];
      const uint32_t w = j < 32 ? ms[0] : j < 64 ? ms[1] : j < 96 ? ms[2] : ms[3];
      uint32_t vm = ((w >> (j & 31)) & 1u) ? range_mask(j * 64, 0, tok, hh) : 0u;
      if (__ballot(vm != 0) != 0ull) {
        f32x16 s[2];
        qk_tile(Ks, qr, s, rl, hh);
        online_softmax(s, vm, m, l, o);
        pv_tile(Vs, s, o, rl, hh);
      }
    };
    {
      const int ng = (ntl + 3) >> 2;
      const int row = tid >> 3, seg = tid & 7;
      u32x4 kr[4], vr[4];
      auto issue = [&](int g4) {
#pragma unroll
        for (int t = 0; t < 4; ++t) {
          const int idx = g4 * 4 + t;
          if (idx < ntl) {
            const int j = tl[idx];
            kr[t] = *(const u32x4*)(kb_ + ((long)j * 64 + row) * IN1P + seg * 8);
            vr[t] = *(const u32x4*)(vb_ + (long)row * SEQ + j * 64 + seg * 8);
          }
        }
      };
      auto wr = [&](int g4, int buf) {
#pragma unroll
        for (int t = 0; t < 4; ++t) {
          if (g4 * 4 + t < ntl) {
            u16* kd = kvb + (buf * 4 + t) * 2 * KVT;
            *(u32x4*)(kd + row * KVS + seg * 8) = kr[t];
            *(u32x4*)(kd + KVT + row * KVS + seg * 8) = vr[t];
          }
        }
      };
      __syncthreads();
      issue(0);
      wr(0, 0);
      __syncthreads();
#pragma unroll 1
      for (int g4 = 0; g4 < ng; ++g4) {
        if (g4 + 1 < ng) issue(g4 + 1);
#pragma unroll 1
        for (int t = 0; t < 4; ++t) {
          const int idx = g4 * 4 + t;
          if (idx < ntl) {
            const u16* kd = kvb + ((g4 & 1) * 4 + t) * 2 * KVT;
            body(idx, kd, kd + KVT);
          }
        }
        if (g4 + 1 < ng) wr(g4 + 1, (g4 + 1) & 1);
        __syncthreads();
      }
    }
    const float sc = gt[1] / l;
#pragma unroll
    for (int db = 0; db < 2; ++db)
#pragma unroll
      for (int i = 0; i < 16; ++i) { yacc[db][i] += sc * o[db][i]; o[db][i] = 0.f; }
  }
  {
    const int jlo = (t0 > 511 ? t0 - 511 : 0) >> 6, jhi = (t0 + 31) >> 6;
    const u16* kb_ = u + (long)b * SEQ * IN1P + 1536 + g * 64;
    const u16* vb_ = p->vt + (long)(8 + bg) * 64 * SEQ;
    auto tf = [&](int i, const u16*& kp, long& ldk, const u16*& vp, long& ldv) {
      const int j = jlo + i;
      kp = kb_ + (long)j * 64 * IN1P; ldk = IN1P;
      vp = vb_ + j * 64; ldv = SEQ;
    };
    float m = -1e30f, l = 0.f;
    auto body = [&](int i, const u16* Ks, const u16* Vs) {
      const int j = jlo + i;
      const uint32_t vm = range_mask(j * 64, tok - 511, tok, hh);
      if (__ballot(vm != 0) != 0ull) {
        f32x16 s[2];
        qk_tile(Ks, qr, s, rl, hh);
        online_softmax(s, vm, m, l, o);
        pv_tile(Vs, s, o, rl, hh);
      }
    };
    kv_loop(kvb, jhi - jlo + 1, tid, tf, body);
    const float sc = gt[2] / l;
#pragma unroll
    for (int db = 0; db < 2; ++db)
#pragma unroll
      for (int i = 0; i < 16; ++i) yacc[db][i] += sc * o[db][i];
  }
  store_o(p->h + ((long)b * SEQ + tok) * DM + hq * 64, yacc, 1.f, hh);
}

DI void local_barrier(unsigned* ctr, unsigned target, int ws) {
  asm volatile("s_waitcnt vmcnt(0)" ::: "memory");
  __syncthreads();
  if (ws == 0 && lane_id_() == 0) {
    __hip_atomic_fetch_add(ctr, 1u, __ATOMIC_RELAXED, __HIP_MEMORY_SCOPE_AGENT);
    unsigned sp = 0;
    while (__hip_atomic_load(ctr, __ATOMIC_RELAXED, __HIP_MEMORY_SCOPE_AGENT) < target) {
      __builtin_amdgcn_s_sleep(1);
      if (++sp > (1u << 22)) break;
    }
    __builtin_amdgcn_fence(__ATOMIC_ACQUIRE, "agent");
    asm volatile("s_waitcnt vmcnt(0)" ::: "memory");
  }
  __syncthreads();
}

__global__ void __launch_bounds__(NTHR) fwd_kernel(Params pk) {
  __shared__ __attribute__((aligned(1024))) char shm[151552];
  cg::grid_group grid = cg::this_grid();
  const PP p0 = (PP)__builtin_amdgcn_kernarg_segment_ptr();
  const int ws = __builtin_amdgcn_readfirstlane(threadIdx.x >> 6);
  prep_phase(ws, launder_p(p0), shm);
  grid.sync();
  int gx = blockIdx.x & 7, gslot = blockIdx.x >> 3;
  bool loc = false;
  unsigned lep = 0;
  {
    int* cs_ = (int*)(shm + 150024);
    if (ws == 0 && lane_id_() == 0) {
      const unsigned xcc = (unsigned)__builtin_amdgcn_s_getreg((3 << 11) | 20) & 0xFu;
      cs_[0] = (int)xcc;
      cs_[1] = (int)__hip_atomic_fetch_add(p0->xcnt + xcc, 1u, __ATOMIC_RELAXED, __HIP_MEMORY_SCOPE_AGENT);
      unsigned sp = 0, sum = 0;
      bool ok = false;
      for (;;) {
        sum = 0;
        ok = true;
        for (int j = 0; j < 16; ++j) {
          const unsigned c = __hip_atomic_load(p0->xcnt + j, __ATOMIC_RELAXED, __HIP_MEMORY_SCOPE_AGENT);
          sum += c;
          if (j < 8 ? (c != 32u) : (c != 0u)) ok = false;
        }
        if (sum == gridDim.x || ++sp > (1u << 20)) break;
        __builtin_amdgcn_s_sleep(1);
      }
      cs_[2] = (ok && sum == gridDim.x && gridDim.x == 256) ? 1 : 0;
    }
    __syncthreads();
    if (cs_[2]) { gx = cs_[0]; gslot = cs_[1]; loc = true; }
    __syncthreads();
  }
  auto seam = [&]() {
    if (loc) { ++lep; local_barrier(p0->lbar + gx * 64, lep * (gridDim.x >> 3), ws); }
    else grid.sync();
  };
  auto half = [&](const int l, const int s) __attribute__((always_inline)) {
    {
      PP p = launder_p(p0);
      const float* modl = p->mod + (long)l * 4 * 9216;
      const float* xin = (l == 0 && s == 0) ? p->x : p->out;
      norm_phase(ws, gx, gslot, xin, p->h, p->norm_g + (l * 3 + (s == 0 ? 0 : 2)) * DM, modl + (s == 0 ? 0 : 6) * DM, modl + (s == 0 ? 1 : 7) * DM);
      seam();
      p = launder_p(p0);
      {
        const u16* W = p->wt1 + (long)(l * 2 + s) * 5632 * 1024;
        u16* act = p->big;
        auto desc = [&](int pm, int pn) { return TileDesc{p->h + (long)pm * 256 * DM, DM, 64, W + (long)pn * 256 * DM, DM, DM / 64}; };
        auto epi = [&](int pm, int pn, Acc8& acc, int wr, int wc, int fr, int fq) {
#pragma unroll
          for (int ai = 0; ai < 2; ++ai)
#pragma unroll
            for (int bj = 0; bj < 2; ++bj)
#pragma unroll
              for (int m = 0; m < 4; ++m)
#pragma unroll
                for (int j = 0; j < 4; ++j) {
                  float a = acc[ai][bj][m][0][j], b = acc[ai][bj][m][1][j];
                  float v = a * __builtin_amdgcn_rcpf(1.f + __expf(-a)) * b;
                  long row = (long)pm * 256 + ai * 128 + wr * 64 + m * 16 + fq * 4 + j;
                  int col = pn * 128 + (bj * 4 + wc) * 16 + fr;
                  wt16(act + row * DFF + col, f2bf(v));
                }
        };
        gemm_phase(ws, gx, gslot, shm, NT / 256, 5632 / 256, desc, epi);
      }
      seam();
      p = launder_p(p0);
      modl = p->mod + (long)l * 4 * 9216;
      xin = (l == 0 && s == 0) ? p->x : p->out;
      {
        const u16* W = p->wt2 + (long)(l * 2 + s) * 1024 * DFF;
        const float* gate = modl + (s == 0 ? 2 : 8) * DM;
        float* xo = p->out;
        auto desc = [&](int pm, int pn) { return TileDesc{p->big + (long)pm * 256 * DFF, DFF, 64, W + (long)pn * 256 * DFF, DFF, DFF / 64}; };
        auto epi = [&](int pm, int pn, Acc8& acc, int wr, int wc, int fr, int fq) {
          const int b = (pm * 256) >> 13;
#pragma unroll
          for (int bj = 0; bj < 2; ++bj)
#pragma unroll
            for (int n = 0; n < 2; ++n) {
              const int col = pn * 256 + bj * 128 + wc * 32 + n * 16 + fr;
              const float gv = 0.5f * gate[(long)b * 9216 + col];
#pragma unroll
              for (int ai = 0; ai < 2; ++ai)
#pragma unroll
                for (int m = 0; m < 4; ++m) {
#pragma unroll
                  for (int j = 0; j < 4; ++j) {
                    long row = (long)pm * 256 + ai * 128 + wr * 64 + m * 16 + fq * 4 + j;
                    wt32f(xo + row * DM + col, xin[row * DM + col] + gv * acc[ai][bj][m][n][j]);
                  }
                  asm volatile("" ::: "memory");
                }
            }
        };
        gemm_phase(ws, gx, gslot, shm, NT / 256, DM / 256, desc, epi);
      }
      seam();
      if (s == 0) {
        p = launder_p(p0);
        modl = p->mod + (long)l * 4 * 9216;
        norm_phase(ws, gx, gslot, p->out, p->h, p->norm_g + (l * 3 + 1) * DM, modl + 3 * DM, modl + 4 * DM);
        seam();
        if (l == 0) {
          p = launder_p(p0);
          {
            u16* uu = p->big;
            u16* vt = p->vt;
            auto desc = [&](int pm, int pn) { return TileDesc{p->h + (long)pm * 256 * DM, DM, 64, p->wtin0 + (long)pn * 256 * DM, DM, DM / 64}; };
            auto epi = [&](int pm, int pn, Acc8& acc, int wr, int wc, int fr, int fq) {
#pragma unroll
              for (int ai = 0; ai < 2; ++ai)
#pragma unroll
                for (int bj = 0; bj < 2; ++bj)
#pragma unroll
                  for (int m = 0; m < 4; ++m)
#pragma unroll
                    for (int n = 0; n < 2; ++n) {
                      const int col = pn * 256 + bj * 128 + wc * 32 + n * 16 + fr;
                      const long row0 = (long)pm * 256 + ai * 128 + wr * 64 + m * 16 + fq * 4;
                      const f32x4 v = acc[ai][bj][m][n];
                      if (col >= 2048) {
                        const int vc = col - 2048, bb = (int)(row0 >> 13), t = (int)(row0 & 8191);
                        u32x2 pk = {pack2(v[0], v[1]), pack2(v[2], v[3])};
                        wt64(vt + ((long)(bb * 8 + (vc >> 6)) * 64 + (vc & 63)) * SEQ + t, pk);
                      } else {
#pragma unroll
                        for (int j = 0; j < 4; ++j) wt16(uu + (row0 + j) * IN0 + col, f2bf(v[j]));
                      }
                    }
            };
            gemm_phase(ws, gx, gslot, shm, NT / 256, IN0 / 256, desc, epi);
          }
          grid.sync();
          p = launder_p(p0);
          kprep0_phase(ws, p, shm);
          p = launder_p(p0);
#pragma unroll 1
          for (int it = grab(ws, p->ctr + 0, shm); it < 512;) {
            const int nx_ = grab_begin(ws, p->ctr + 0);
            lru_item<false>(ws, p, shm, it);
            it = grab_end(ws, nx_, shm);
          }
          grid.sync();
          p = launder_p(p0);
#pragma unroll 1
          for (int it = grab(ws, p->ctr + 1, shm); it < 1024;) {
            const int nx_ = grab_begin(ws, p->ctr + 1);
            moba_gate_item(ws, p, shm, it);
            it = grab_end(ws, nx_, shm);
          }
          grid.sync();
          p = launder_p(p0);
          moba_gather_phase(ws, p, shm);
          p = launder_p(p0);
#pragma unroll 1
          for (int it = grab(ws, p->ctr + 3, shm); it < 512;) {
            const int nx_ = grab_begin(ws, p->ctr + 3);
            lru_item<true>(ws, p, shm, it);
            it = grab_end(ws, nx_, shm);
          }
          grid.sync();
          p = launder_p(p0);
#pragma unroll 1
          for (int it = grab(ws, p->ctr + 4, shm); it < 1024;) {
            const int nx_ = grab_begin(ws, p->ctr + 4);
            moba_own_item(ws, p, shm, it);
            it = grab_end(ws, nx_, shm);
          }
          grid.sync();
        }
        if (l == 1) {
          p = launder_p(p0);
          {
            u16* uu = p->big;
            u16* vt = p->vt;
            auto desc = [&](int pm, int pn) { return TileDesc{p->h + (long)pm * 256 * DM, DM, 64, p->wtin1 + (long)pn * 256 * DM, DM, DM / 64}; };
            auto epi = [&](int pm, int pn, Acc8& acc, int wr, int wc, int fr, int fq) {
#pragma unroll
              for (int ai = 0; ai < 2; ++ai)
#pragma unroll
                for (int bj = 0; bj < 2; ++bj) {
                  const int c64 = (pn * 256 + bj * 128 + wc * 32) >> 6;
                  const bool isv = (c64 == 22 || c64 == 23 || c64 == 26 || c64 == 27);
#pragma unroll
                  for (int m = 0; m < 4; ++m)
#pragma unroll
                    for (int n = 0; n < 2; ++n) {
                      const int col = pn * 256 + bj * 128 + wc * 32 + n * 16 + fr;
                      const long row0 = (long)pm * 256 + ai * 128 + wr * 64 + m * 16 + fq * 4;
                      const f32x4 v = acc[ai][bj][m][n];
                      if (isv) {
                        const int bb = (int)(row0 >> 13), t = (int)(row0 & 8191);
                        const int which = c64 >= 26 ? 1 : 0, gg = c64 & 1;
                        u32x2 pk = {pack2(v[0], v[1]), pack2(v[2], v[3])};
                        wt64(vt + ((long)(which * 8 + bb * 2 + gg) * 64 + (col & 63)) * SEQ + t, pk);
                      } else if (col < IN1) {
#pragma unroll
                        for (int j = 0; j < 4; ++j) wt16(uu + (row0 + j) * IN1P + col, f2bf(v[j]));
                      }
                    }
                }
            };
            gemm_phase(ws, gx, gslot, shm, NT / 256, IN1P / 256, desc, epi);
          }
          grid.sync();
          p = launder_p(p0);
          rope1_phase(ws, p);
          p = launder_p(p0);
          {
            float* pq = p->pq;
            auto desc = [&](int pm, int pn) {
              const int kv = pm >> 4, rr = pm & 15, bg = rr >> 1, j0 = (rr & 1) * 256;
              return TileDesc{p->big + ((long)(bg >> 1) * SEQ + 16 * j0) * IN1P + 1024 + kv * 128 + (bg & 1) * 64, 16 * IN1P, IN1P,
                              p->wtcmp + (long)kv * 256 * 1024, 1024, 16};
            };
            auto epi = [&](int pm, int pn, Acc8& acc, int wr, int wc, int fr, int fq) {
#pragma unroll
              for (int ai = 0; ai < 2; ++ai)
#pragma unroll
                for (int bj = 0; bj < 2; ++bj)
#pragma unroll
                  for (int m = 0; m < 4; ++m)
#pragma unroll
                    for (int n = 0; n < 2; ++n)
#pragma unroll
                      for (int j = 0; j < 4; ++j)
                        wt32f(pq + ((long)pm * 256 + ai * 128 + wr * 64 + m * 16 + fq * 4 + j) * 256 + bj * 128 + wc * 32 + n * 16 + fr, acc[ai][bj][m][n][j]);
            };
            gemm_phase(ws, gx, gslot, shm, 32, 1, desc, epi);
          }
          grid.sync();
          p = launder_p(p0);
          cmpfin_phase(ws, p, shm);
          grid.sync();
          p = launder_p(p0);
#pragma unroll 1
          for (int it = grab(ws, p->ctr + 5, shm); it < 2048;) {
            const int nx_ = grab_begin(ws, p->ctr + 5);
            nsa_item(ws, p, shm, it);
            it = grab_end(ws, nx_, shm);
          }
          grid.sync();
        }
        {
          p = launder_p(p0);
          modl = p->mod + (long)l * 4 * 9216;
          const u16* W = l == 0 ? p->wtout0 : p->wtout1;
          const float* gate = modl + 5 * DM;
          float* xo = p->out;
          auto desc = [&](int pm, int pn) { return TileDesc{p->h + (long)pm * 256 * DM, DM, 64, W + (long)pn * 256 * DM, DM, DM / 64}; };
          auto epi = [&](int pm, int pn, Acc8& acc, int wr, int wc, int fr, int fq) {
            const int b = (pm * 256) >> 13;
#pragma unroll
            for (int bj = 0; bj < 2; ++bj)
#pragma unroll
              for (int n = 0; n < 2; ++n) {
                const int col = pn * 256 + bj * 128 + wc * 32 + n * 16 + fr;
                const float gv = gate[(long)b * 9216 + col];
#pragma unroll
                for (int ai = 0; ai < 2; ++ai)
#pragma unroll
                  for (int m = 0; m < 4; ++m) {
#pragma unroll
                    for (int j = 0; j < 4; ++j) {
                      long row = (long)pm * 256 + ai * 128 + wr * 64 + m * 16 + fq * 4 + j;
                      wt32f(xo + row * DM + col, xo[row * DM + col] + gv * acc[ai][bj][m][n][j]);
                    }
                    asm volatile("" ::: "memory");
                  }
              }
          };
          gemm_phase(ws, gx, gslot, shm, NT / 256, DM / 256, desc, epi);
          seam();
        }
      }
    }
  };
  half(0, 0);
  half(0, 1);
  half(1, 0);
  half(1, 1);
  { PP p = launder_p(p0); final_norm_phase(ws, gx, gslot, p->out, p->fng); }
}

extern "C" void kernel_launch(void* const* d_in, const int* in_sizes, int n_in, void* d_out, int out_size, void* d_ws, size_t ws_size,
                              hipStream_t stream) {
  Params p;
  memset(&p, 0, sizeof(p));
  const float** fp = (const float**)&p.x;
  for (int i = 0; i < 22; ++i) fp[i] = (const float*)d_in[i];
  p.out = (float*)d_out;
  char* ws = (char*)d_ws;
  size_t off = 0;
  auto take = [&](size_t bytes) { char* r = ws + off; off += (bytes + 255) & ~(size_t)255; return r; };
  p.wt1 = (u16*)take((size_t)4 * 5632 * 1024 * 2);
  p.wt2 = (u16*)take((size_t)4 * 1024 * DFF * 2);
  p.wtin0 = (u16*)take((size_t)IN0 * 1024 * 2);
  p.wtout0 = (u16*)take((size_t)1024 * 1024 * 2);
  p.wtin1 = (u16*)take((size_t)IN1P * 1024 * 2);
  p.wtout1 = (u16*)take((size_t)1024 * 1024 * 2);
  p.wtcmp = (u16*)take((size_t)2 * 256 * 1024 * 2);
  p.wat = (u16*)take((size_t)2 * 8 * 64 * 64 * 2);
  p.mod = (float*)take((size_t)2 * 4 * 9216 * 4);
  p.rope = (float*)take((size_t)SEQ * 16 * 4);
  p.cvec = (float*)take(2 * 128 * 4);
  p.cent = (float*)take((size_t)4 * 8 * 32 * 64 * 4);
  p.lrusum = (float*)take((size_t)4 * 128 * 512 * 2 * 4);
  p.pq = (float*)take((size_t)2 * 4096 * 256 * 4);
  p.h = (u16*)take((size_t)NT * 1024 * 2);
  p.big = (u16*)take((size_t)NT * DFF * 2);
  p.vt = (u16*)take((size_t)NT * 512 * 2);
  p.kcmp = (u16*)take((size_t)8 * 512 * 64 * 2);
  p.vcmpT = (u16*)take((size_t)8 * 512 * 64 * 2);
  p.mcnt = (unsigned*)take(1024 * 4);
  p.ctr = (unsigned*)take(64 * 4);
  p.xcnt = (unsigned*)take(64 * 4);
  p.lbar = (unsigned*)take(8 * 64 * 4);
  p.mlist = (unsigned*)take((size_t)32 * 126976 * 4);
  p.part = (u16*)take((size_t)NT * 8 * 3 * 144);
  int nj = 0, t0 = 0;
  auto add = [&](const float* src, u16* dst, int K, int N, int ldn, int perm, int npad) {
    TJob& j = p.jobs[nj++];
    j.src = src; j.dst = dst; j.K = K; j.N = N; j.ldn = ldn; j.perm = perm; j.tile0 = t0; j.ntn = npad / 64;
    t0 += (K / 64) * ((npad / 64 + 3) / 4);
  };
  for (int i = 0; i < 4; ++i) add(p.ffn_w1 + (size_t)i * 1024 * 5632, p.wt1 + (size_t)i * 5632 * 1024, 1024, 5632, 5632, 1, 5632);
  for (int i = 0; i < 4; ++i) add(p.ffn_w2 + (size_t)i * DFF * 1024, p.wt2 + (size_t)i * 1024 * DFF, DFF, 1024, 1024, 0, 1024);
  add(p.mix0_in_w, p.wtin0, 1024, IN0, IN0, 0, IN0);
  add(p.mix0_out_w, p.wtout0, 1024, 1024, 1024, 0, 1024);
  add(p.mix1_in_w, p.wtin1, 1024, IN1, IN1, 0, IN1P);
  add(p.mix1_out_w, p.wtout1, 1024, 1024, 1024, 0, 1024);
  for (int kv = 0; kv < 2; ++kv)
    for (int hf = 0; hf < 2; ++hf)
      add(p.cmp_w1 + ((size_t)kv * 2048 + hf * 1024) * 128, p.wtcmp + ((size_t)kv * 256 + hf * 128) * 1024, 1024, 128, 128, 0, 128);
  for (int n = 0; n < 8; ++n) add(p.wa + (size_t)n * 4096, p.wat + (size_t)n * 4096, 64, 64, 64, 0, 64);
  for (int n = 0; n < 8; ++n) add(p.wx + (size_t)n * 4096, p.wat + (size_t)(8 + n) * 4096, 64, 64, 64, 0, 64);
  p.njobs = nj;
  p.ntr_tiles = t0;

  static int grid_blocks = 0;
  if (!grid_blocks) {
    int dev = 0, cus = 0, per_cu = 0;
    (void)hipGetDevice(&dev);
    (void)hipDeviceGetAttribute(&cus, hipDeviceAttributeMultiprocessorCount, dev);
    (void)hipOccupancyMaxActiveBlocksPerMultiprocessor(&per_cu, fwd_kernel, NTHR, 0);
    if (per_cu < 1) per_cu = 1;
    grid_blocks = cus * 1;
  }
  void* args[] = {&p};
  hipError_t e = hipLaunchCooperativeKernel((void*)fwd_kernel, dim3(grid_blocks), dim3(NTHR), args, 0, stream);
  if (e != hipSuccess) fprintf(stderr, "cooperative launch failed: %s (grid %d)\n", hipGetErrorString(e), grid_blocks);
}
```

```cpp
#include <hip/hip_runtime.h>
#include <hip/hip_cooperative_groups.h>
#include <stdint.h>
#include <stdio.h>
#include <string.h>
namespace cg = cooperative_groups;

typedef unsigned short u16;
typedef __attribute__((ext_vector_type(8))) short bf16x8;
typedef __attribute__((ext_vector_type(4))) short s16x4;
typedef __attribute__((ext_vector_type(4))) float f32x4;
typedef __attribute__((ext_vector_type(16))) float f32x16;
typedef __attribute__((ext_vector_type(4))) int i32x4;
typedef __attribute__((ext_vector_type(4))) unsigned u32x4;
typedef __attribute__((ext_vector_type(2))) unsigned u32x2;

#define DI __device__ __forceinline__
#define MFMA32(a, b, c) __builtin_amdgcn_mfma_f32_32x32x16_bf16((a), (b), (c), 0, 0, 0)
#define MFMA16(a, b, c) __builtin_amdgcn_mfma_f32_16x16x32_bf16((a), (b), (c), 0, 0, 0)

constexpr int NB = 4, SEQ = 8192, DM = 1024, NT = NB * SEQ, DFF = 2816;
constexpr int IN0 = 2560, IN1 = 1840, IN1P = 2048;
constexpr int NTHR = 512;
constexpr int NJOBS = 32;

struct TJob { const float* src; u16* dst; int K, N, ldn, perm, tile0, ntn; };

struct Params {
  const float *x, *c, *mod_w, *mod_b, *norm_g, *ffn_w1, *ffn_w2, *mix0_in_w, *conv_w, *conv_b, *wa, *ba, *wx, *bx, *lam,
      *mix0_out_w, *mix1_in_w, *cmp_pos, *cmp_w1, *cmp_w2, *mix1_out_w, *fng;
  float* out;
  u16 *wt1, *wt2, *wtin0, *wtout0, *wtin1, *wtout1, *wtcmp, *wat;
  float *mod, *rope, *cvec, *cent, *lrusum, *pq;
  u16 *h, *big, *vt, *kcmp, *vcmpT;
  unsigned *mcnt, *mlist, *ctr, *xcnt, *lbar;
  u16* part;
  TJob jobs[NJOBS];
  int njobs, ntr_tiles;
};

typedef const __attribute__((address_space(4))) Params* PP;
DI PP launder_p(PP p) { asm volatile("" : "+s"(p)); return p; }

typedef __attribute__((ext_vector_type(2))) float f32x2_;
typedef __attribute__((ext_vector_type(2))) __bf16 bf16x2_;
DI uint32_t pack2(float a, float b) {
  f32x2_ v = {a, b};
  return __builtin_bit_cast(uint32_t, __builtin_convertvector(v, bf16x2_));
}
DI u16 f2bf(float f) { return (u16)(pack2(f, 0.f) & 0xffffu); }
DI float bf2f(u16 h) { return __uint_as_float(((uint32_t)h) << 16); }
DI float bflo(uint32_t w) { return __uint_as_float(w << 16); }
DI float bfhi(uint32_t w) { return __uint_as_float(w & 0xffff0000u); }

DI void wt16(u16* p, u16 v) { *p = v; }
DI void wt32u(unsigned* p, unsigned v) { *p = v; }
DI void wt32f(float* p, float v) { *p = v; }
DI void wt64(void* p, u32x2 v) { *(u32x2*)p = v; }
DI void wt128(void* p, u32x4 v) { *(u32x4*)p = v; }
DI bf16x8 pack8(float a0, float a1, float a2, float a3, float a4, float a5, float a6, float a7) {
  u32x4 p;
  asm volatile("v_cvt_pk_bf16_f32 %0, %4, %5\n\tv_cvt_pk_bf16_f32 %1, %6, %7\n\tv_cvt_pk_bf16_f32 %2, %8, %9\n\tv_cvt_pk_bf16_f32 %3, %10, %11\n\ts_nop 1"
               : "=&v"(p[0]), "=&v"(p[1]), "=&v"(p[2]), "=&v"(p[3])
               : "v"(a0), "v"(a1), "v"(a2), "v"(a3), "v"(a4), "v"(a5), "v"(a6), "v"(a7));
  return __builtin_bit_cast(bf16x8, p);
}
DI int launder(int v) { asm volatile("" : "+v"(v)); return v; }
DI int lane_id_() { int l = __builtin_amdgcn_mbcnt_hi(-1, __builtin_amdgcn_mbcnt_lo(-1, 0)); asm volatile("" : "+v"(l)); return l; }
DI int grab_begin(int ws, unsigned* ctr) {
  int v = 0;
  if (ws == 0 && lane_id_() == 0) v = (int)atomicAdd(ctr, 1u);
  return v;
}
DI int grab_end(int ws, int v, char* shm) {
  int* slot = (int*)(shm + 150016);
  __syncthreads();
  if (ws == 0 && lane_id_() == 0) *slot = v;
  __syncthreads();
  return *slot;
}
DI int grab(int ws, unsigned* ctr, char* shm) { return grab_end(ws, grab_begin(ws, ctr), shm); }
DI int mytid(int ws) { return launder(ws * 64 + lane_id_()); }
template <int M> DI int shxi(int v) {
  if (M < 32) return __builtin_amdgcn_ds_swizzle(v, (M << 10) | 0x1f);
  auto r = __builtin_amdgcn_permlane32_swap((unsigned)v, (unsigned)v, false, false);
  return (int)(r[0] ^ r[1] ^ (unsigned)v);
}
DI float sum8(float v) {
  v += __int_as_float(__builtin_amdgcn_update_dpp(0, __float_as_int(v), 0xB1, 0xF, 0xF, true));
  v += __int_as_float(__builtin_amdgcn_update_dpp(0, __float_as_int(v), 0x4E, 0xF, 0xF, true));
  v += __int_as_float(__builtin_amdgcn_update_dpp(0, __float_as_int(v), 0x141, 0xF, 0xF, true));
  return v;
}
DI float dppx1(float v) { return __int_as_float(__builtin_amdgcn_update_dpp(0, __float_as_int(v), 0xB1, 0xF, 0xF, true)); }
DI void store_pair_bf16(u16* base_even, long ld, bool odd, float v0, float v1, float v2, float v3) {
  const float sx = odd ? v0 : v2, sy = odd ? v1 : v3;
  const float rx = dppx1(sx), ry = dppx1(sy);
  const uint32_t p0 = odd ? pack2(rx, v2) : pack2(v0, rx);
  const uint32_t p1 = odd ? pack2(ry, v3) : pack2(v1, ry);
  u16* q = base_even + (odd ? 2 * ld : 0);
  *(uint32_t*)q = p0;
  *(uint32_t*)(q + ld) = p1;
}
DI float xmax32(float v) {
  auto r = __builtin_amdgcn_permlane32_swap(__float_as_uint(v), __float_as_uint(v), false, false);
  return fmaxf(__uint_as_float(r[0]), __uint_as_float(r[1]));
}
DI float xsum32(float v) {
  auto r = __builtin_amdgcn_permlane32_swap(__float_as_uint(v), __float_as_uint(v), false, false);
  return __uint_as_float(r[0]) + __uint_as_float(r[1]);
}
template <int M> DI float shxf(float v) { return __int_as_float(shxi<M>(__float_as_int(v))); }
DI float sigmoidf_(float x) { return __builtin_amdgcn_rcpf(1.f + __expf(-x)); }
DI float gelu_tanh(float x) {
  const float z = 0.7978845608028654f * (x + 0.044715f * x * x * x);
  const float th = 1.f - 2.f * __builtin_amdgcn_rcpf(1.f + __expf(2.f * z));
  return 0.5f * x * (1.f + th);
}

template <int KS> DI int lds_byte(int r, int c) {
  int st = (r >> 4) * KS + (c >> 5), ob = (r & 15) * 64 + (c & 31) * 2;
  return st * 1024 + (ob ^ (((ob >> 9) & 1) << 5));
}
template <int KS> DI void stage_rc(int b, int& R, int& C) {
  int st = b >> 10, sb = b & 1023, swz = sb ^ (((sb >> 9) & 1) << 5);
  R = (st / KS) * 16 + swz / 64;
  C = (st % KS) * 32 + (swz % 64) / 2;
}
#define WAIT_V(n) asm volatile("s_waitcnt vmcnt(%0)" ::"n"(n) : "memory")

struct TileDesc { const u16* a; long lda, kts; const u16* b; long ldb; int nt; };

typedef f32x4 Acc8[2][2][4][2];
template <class Epi>
DI void gemm_tile(int ws, char* shmc, const TileDesc& td, Epi& epi, int pm, int pn, bool first, bool has_next, const TileDesc& tdn) {
  constexpr int BK = 64, HALF = 128, HT = HALF * BK;
  u16* shm = (u16*)shmc;
  const int tid = mytid(ws), wid = tid >> 6, lane = tid & 63, wr = wid >> 2, wc = wid & 3, fr = lane & 15, fq = lane >> 4;
  const u16* ABASE = td.a;
  const u16* BBASE = td.b;
  const long lda = td.lda, kts = td.kts, ldb = td.ldb;
  const int nt = td.nt;
#define SA(b, h) (shm + ((b) * 2 + (h)) * HT)
#define SB(b, h) (shm + (4 + (b) * 2 + (h)) * HT)
  unsigned voffA, voffB;
  {
    int r0_, c0_;
    stage_rc<2>(tid * 16, r0_, c0_);
    voffA = (unsigned)(r0_ * (int)lda + c0_);
    voffB = (unsigned)(r0_ * (int)ldb + c0_);
  }
#define STAGE_A(P, hf, kt)                                                                                     \
  do {                                                                                                         \
    _Pragma("unroll") for (int _i = 0; _i < 2; ++_i)                                                           \
      __builtin_amdgcn_global_load_lds((const unsigned*)((ABASE + (long)((hf) * HALF + 64 * _i) * lda + (long)(kt) * kts) + voffA), \
                                       (__attribute__((address_space(3))) unsigned*)((char*)(P) + tid * 16 + _i * 8192), 16, 0, 0); \
  } while (0)
#define STAGE_B(P, hf, kt)                                                                                     \
  do {                                                                                                         \
    _Pragma("unroll") for (int _i = 0; _i < 2; ++_i)                                                           \
      __builtin_amdgcn_global_load_lds((const unsigned*)((BBASE + (long)((hf) * HALF + 64 * _i) * ldb + (long)(kt) * BK) + voffB), \
                                       (__attribute__((address_space(3))) unsigned*)((char*)(P) + tid * 16 + _i * 8192), 16, 0, 0); \
  } while (0)
#define LDA_(dst, b, h)                                    \
  _Pragma("unroll") for (int m = 0; m < 4; ++m)            \
  _Pragma("unroll") for (int k = 0; k < 2; ++k)            \
      dst[m][k] = *(const bf16x8*)((const char*)SA(b, h) + lds_byte<2>(wr * 64 + m * 16 + fr, k * 32 + fq * 8))
#define LDB_(dst, b, h)                                    \
  _Pragma("unroll") for (int n = 0; n < 2; ++n)            \
  _Pragma("unroll") for (int k = 0; k < 2; ++k)            \
      dst[n][k] = *(const bf16x8*)((const char*)SB(b, h) + lds_byte<2>(wc * 32 + n * 16 + fr, k * 32 + fq * 8))
#define MMA_(ai, bj, AT, BT)                                                           \
  do {                                                                                 \
    __builtin_amdgcn_s_setprio(1);                                                     \
    _Pragma("unroll") for (int m = 0; m < 4; ++m)                                      \
    _Pragma("unroll") for (int n = 0; n < 2; ++n)                                      \
    _Pragma("unroll") for (int k = 0; k < 2; ++k)                                      \
        acc[ai][bj][m][n] = MFMA16(AT[m][k], BT[n][k], acc[ai][bj][m][n]);             \
    __builtin_amdgcn_s_setprio(0);                                                     \
  } while (0)
#define WV(n) asm volatile("s_waitcnt vmcnt(" #n ")" ::: "memory")
#define WL(n) asm volatile("s_waitcnt lgkmcnt(" #n ")" ::: "memory")
#define BAR __builtin_amdgcn_s_barrier()
#define SCHED __builtin_amdgcn_sched_barrier(0)
  Acc8 acc;
#pragma unroll
  for (int a = 0; a < 2; ++a)
#pragma unroll
    for (int b = 0; b < 2; ++b)
#pragma unroll
      for (int m = 0; m < 4; ++m)
#pragma unroll
        for (int n = 0; n < 2; ++n) acc[a][b][m][n] = f32x4{0.f, 0.f, 0.f, 0.f};
  bf16x8 At[4][2], B0[2][2], B1[2][2];
  if (first) {
    STAGE_B(SB(0, 0), 0, 0); STAGE_A(SA(0, 0), 0, 0);
    STAGE_B(SB(0, 1), 1, 0); STAGE_A(SA(0, 1), 1, 0);
  }
  if (wr == 1) BAR;
  WV(4); BAR;
  STAGE_B(SB(1, 0), 0, 1); STAGE_A(SA(1, 0), 0, 1); STAGE_B(SB(1, 1), 1, 1);
  WV(6); BAR;
  for (int t = 0; t < nt - 2; t += 2) {
    LDB_(B0, 0, 0); SCHED; LDA_(At, 0, 0); STAGE_A(SA(1, 1), 1, t + 1);
    WL(8); BAR; WL(0); MMA_(0, 0, At, B0); BAR; SCHED;
    LDB_(B1, 0, 1); STAGE_B(SB(0, 0), 0, t + 2);
    BAR; WL(0); MMA_(0, 1, At, B1); BAR;
    LDA_(At, 0, 1); STAGE_A(SA(0, 0), 0, t + 2);
    BAR; WL(0); MMA_(1, 0, At, B0); BAR; SCHED;
    STAGE_B(SB(0, 1), 1, t + 2);
    WV(6); BAR; MMA_(1, 1, At, B1); BAR;
    LDB_(B0, 1, 0); SCHED; LDA_(At, 1, 0); STAGE_A(SA(0, 1), 1, t + 2);
    WL(8); BAR; WL(0); MMA_(0, 0, At, B0); BAR; SCHED;
    LDB_(B1, 1, 1); STAGE_B(SB(1, 0), 0, t + 3);
    BAR; WL(0); MMA_(0, 1, At, B1); BAR;
    LDA_(At, 1, 1); STAGE_A(SA(1, 0), 0, t + 3);
    BAR; WL(0); MMA_(1, 0, At, B0); BAR; SCHED;
    STAGE_B(SB(1, 1), 1, t + 3);
    WV(6); BAR; MMA_(1, 1, At, B1); BAR;
  }
  { LDB_(B0, 0, 0); LDA_(At, 0, 0); STAGE_A(SA(1, 1), 1, nt - 1);
    BAR; WL(0); MMA_(0, 0, At, B0); BAR;
    LDB_(B1, 0, 1); BAR; WL(0); MMA_(0, 1, At, B1); BAR;
    LDA_(At, 0, 1); WV(4); BAR; WL(0); MMA_(1, 0, At, B0); MMA_(1, 1, At, B1); BAR; }
  { LDB_(B0, 1, 0); LDA_(At, 1, 0); WV(2); BAR; WL(0); MMA_(0, 0, At, B0); BAR;
    LDB_(B1, 1, 1); WV(0); BAR; WL(0); MMA_(0, 1, At, B1); BAR;
    LDA_(At, 1, 1); BAR; WL(0); MMA_(1, 0, At, B0); MMA_(1, 1, At, B1); BAR; }
  if (wr == 0) BAR;
  if (has_next) {
    ABASE = tdn.a;
    BBASE = tdn.b;
    STAGE_B(SB(0, 0), 0, 0); STAGE_A(SA(0, 0), 0, 0);
    STAGE_B(SB(0, 1), 1, 0); STAGE_A(SA(0, 1), 1, 0);
  }
  epi(pm, pn, acc, wr, wc, fr, fq);
  asm volatile("s_waitcnt vmcnt(0)" ::: "memory");
  __syncthreads();
#undef SA
#undef SB
#undef STAGE_A
#undef STAGE_B
#undef LDA_
#undef LDB_
#undef MMA_
#undef WV
#undef WL
#undef BAR
#undef SCHED
}

template <class Desc, class Epi>
DI void gemm_phase(int ws, int gx, int gslot, char* shm, int nM, int nN, Desc desc, Epi epi) {
  const int ntiles = nM * nN;
  const int G = gridDim.x, bid = blockIdx.x;
  const bool xcdmap = (G % 8 == 0) && (ntiles % 8 == 0);
  const int per = ntiles / 8, slots = G / 8;
  auto tile_at = [&](int i, int& pm, int& pn) -> bool {
    int t;
    if (xcdmap) {
      int lt = gslot + slots * i;
      if (lt >= per) return false;
      t = gx * per + lt;
    } else {
      t = bid + G * i;
      if (t >= ntiles) return false;
    }
    const int WGM = 8;
    int nig = WGM * nN, gid = t / nig, fm = gid * WGM, gsz = min(nM - fm, WGM);
    pm = fm + ((t % nig) % gsz);
    pn = (t % nig) / gsz;
    return true;
  };
  __syncthreads();
  int pm, pn;
  if (!tile_at(0, pm, pn)) return;
  TileDesc td = desc(pm, pn);
  bool first = true;
  for (int i = 0;; ++i) {
    int pmn = 0, pnn = 0;
    const bool more = tile_at(i + 1, pmn, pnn);
    TileDesc tdn = td;
    if (more) tdn = desc(pmn, pnn);
    gemm_tile(ws, shm, td, epi, pm, pn, first, more, tdn);
    if (!more) break;
    td = tdn; pm = pmn; pn = pnn; first = false;
  }
}

DI float wave_sum(float v) {
  v += shxf<32>(v); v += shxf<16>(v); v += shxf<8>(v); v += shxf<4>(v); v += shxf<2>(v); v += shxf<1>(v);
  return v;
}

DI void norm_phase(int ws, int gx, int gslot, const float* __restrict__ x, u16* __restrict__ h, const float* __restrict__ g, const float* __restrict__ shift,
                   const float* __restrict__ scale  ) {
  const int tid_ = mytid(ws), wid = tid_ >> 6, lane = tid_ & 63;
  const int rbase = gx * (NT / 8) + gslot * (NT / 8 / (gridDim.x / 8)) + wid * (NT / 8 / (gridDim.x / 8) / 8);
  const int rcnt = NT / 8 / (gridDim.x / 8) / 8;
  for (int row = rbase; row < rbase + rcnt; ++row) {
    const float4* xr = (const float4*)(x + (long)row * DM);
    float4 v[4];
    float ss = 0.f;
#pragma unroll
    for (int i = 0; i < 4; ++i) {
      v[i] = xr[lane + 64 * i];
      ss += v[i].x * v[i].x + v[i].y * v[i].y + v[i].z * v[i].z + v[i].w * v[i].w;
    }
    ss = wave_sum(ss);
    const float rs = rsqrtf(ss * (1.f / DM) + 1e-6f);
    const int b = row >> 13;
#pragma unroll
    for (int i = 0; i < 4; ++i) {
      const int c4 = lane + 64 * i;
      const float4 gg = ((const float4*)g)[c4];
      const float4 sc = ((const float4*)(scale + (long)b * 9216))[c4];
      const float4 sh = ((const float4*)(shift + (long)b * 9216))[c4];
      float y0 = v[i].x * rs * gg.x * (1.f + sc.x) + sh.x;
      float y1 = v[i].y * rs * gg.y * (1.f + sc.y) + sh.y;
      float y2 = v[i].z * rs * gg.z * (1.f + sc.z) + sh.z;
      float y3 = v[i].w * rs * gg.w * (1.f + sc.w) + sh.w;
      u32x2 pk = {pack2(y0, y1), pack2(y2, y3)};
      wt64(h + (long)row * DM + c4 * 4, pk);
    }
  }
}

DI void final_norm_phase(int ws, int gx, int gslot, float* __restrict__ x, const float* __restrict__ g) {
  const int tid_ = mytid(ws), wid = tid_ >> 6, lane = tid_ & 63;
  const int rbase = gx * (NT / 8) + gslot * (NT / 8 / (gridDim.x / 8)) + wid * (NT / 8 / (gridDim.x / 8) / 8);
  const int rcnt = NT / 8 / (gridDim.x / 8) / 8;
  for (int row = rbase; row < rbase + rcnt; ++row) {
    float4* xr = (float4*)(x + (long)row * DM);
    float4 v[4];
    float ss = 0.f;
#pragma unroll
    for (int i = 0; i < 4; ++i) {
      v[i] = xr[lane + 64 * i];
      ss += v[i].x * v[i].x + v[i].y * v[i].y + v[i].z * v[i].z + v[i].w * v[i].w;
    }
    ss = wave_sum(ss);
    const float rs = rsqrtf(ss * (1.f / DM) + 1e-6f);
#pragma unroll
    for (int i = 0; i < 4; ++i) {
      const int c4 = lane + 64 * i;
      const float4 gg = ((const float4*)g)[c4];
      float4 o = {v[i].x * rs * gg.x, v[i].y * rs * gg.y, v[i].z * rs * gg.z, v[i].w * rs * gg.w};
      xr[c4] = o;
    }
  }
}

DI void prep_phase(int ws, PP p, char* shm) {
  const int tid = mytid(ws);
  float* fs = (float*)shm;
  const int n_tr = p->ntr_tiles;
  const int n_mod = 2 * 144;
  const int n_cv = 8;
  const int n_rope = 128;
  const int n_misc = 1;
  const int total = n_tr + n_mod + n_cv + n_rope + n_misc;
  for (int it = blockIdx.x; it < total; it += gridDim.x) {
    if (it < n_tr) {
      int j = 0;
      for (int q = 1; q < p->njobs; ++q)
        if (it >= p->jobs[q].tile0) j = q;
      TJob jb;
      jb.src = p->jobs[j].src; jb.dst = p->jobs[j].dst; jb.K = p->jobs[j].K; jb.N = p->jobs[j].N; jb.ldn = p->jobs[j].ldn; jb.perm = p->jobs[j].perm; jb.tile0 = p->jobs[j].tile0; jb.ntn = p->jobs[j].ntn;
      const int lt = it - jb.tile0;
      const int ngn = (jb.ntn + 3) >> 2;
      const int tk = lt / ngn, tg4 = lt % ngn;
      const int k0 = tk * 64;
      float4 v[4][2];
#pragma unroll
      for (int u = 0; u < 4; ++u)
#pragma unroll
        for (int rep = 0; rep < 2; ++rep) {
          const int idx = tid + rep * 512, r = idx >> 4, c4 = idx & 15;
          const int n = (tg4 * 4 + u) * 64 + c4 * 4;
          v[u][rep] = float4{0.f, 0.f, 0.f, 0.f};
          if (tg4 * 4 + u < jb.ntn && n < jb.N) v[u][rep] = *(const float4*)(jb.src + (long)(k0 + r) * jb.ldn + n);
        }
#pragma unroll
      for (int u = 0; u < 4; ++u)
#pragma unroll
        for (int rep = 0; rep < 2; ++rep) {
          const int idx = tid + rep * 512, r = idx >> 4, c4 = idx & 15;
          float* f = fs + u * (64 * 65) + r * 65 + c4 * 4;
          f[0] = v[u][rep].x; f[1] = v[u][rep].y; f[2] = v[u][rep].z; f[3] = v[u][rep].w;
        }
      __syncthreads();
#pragma unroll
      for (int u = 0; u < 4; ++u) {
        if (tg4 * 4 + u < jb.ntn) {
          const int n = tid >> 3, ks = tid & 7;
          float e[8];
#pragma unroll
          for (int q = 0; q < 8; ++q) e[q] = fs[u * (64 * 65) + (ks * 8 + q) * 65 + n];
          int ng = (tg4 * 4 + u) * 64 + n, drow = ng;
          if (jb.perm == 1) {
            int isb = ng >= DFF ? 1 : 0, jj = ng - isb * DFF;
            drow = (jj >> 4) * 32 + isb * 16 + (jj & 15);
          }
          u32x4 pk = {pack2(e[0], e[1]), pack2(e[2], e[3]), pack2(e[4], e[5]), pack2(e[6], e[7])};
          wt128(jb.dst + (long)drow * jb.K + k0 + ks * 8, pk);
        }
      }
      __syncthreads();
    } else if (it < n_tr + n_mod) {
      const int q = it - n_tr, l = q / 144, cg0 = (q % 144) * 64;
      for (int i = tid; i < 4096; i += NTHR) {
        float cv = p->c[i];
        fs[i] = cv / (1.f + __expf(-cv));
      }
      __syncthreads();
      const int col = tid & 63, kg = tid >> 6;
      const float* w = p->mod_w + (long)l * DM * 9216 + cg0 + col;
      float a0 = 0.f, a1 = 0.f, a2 = 0.f, a3 = 0.f;
#pragma unroll 16
      for (int k = kg * 128; k < kg * 128 + 128; ++k) {
        float wv = w[(long)k * 9216];
        a0 += fs[k] * wv;
        a1 += fs[1024 + k] * wv;
        a2 += fs[2048 + k] * wv;
        a3 += fs[3072 + k] * wv;
      }
      __syncthreads();
      float* red = fs;
      red[(kg * 4 + 0) * 64 + col] = a0;
      red[(kg * 4 + 1) * 64 + col] = a1;
      red[(kg * 4 + 2) * 64 + col] = a2;
      red[(kg * 4 + 3) * 64 + col] = a3;
      __syncthreads();
      if (tid < 256) {
        int b = tid >> 6;
        float s = 0.f;
#pragma unroll
        for (int g = 0; g < 8; ++g) s += red[(g * 4 + b) * 64 + col];
        wt32f(p->mod + ((long)l * 4 + b) * 9216 + cg0 + col, s + p->mod_b[(long)l * 9216 + cg0 + col]);
      }
      __syncthreads();
    } else if (it < n_tr + n_mod + n_cv) {
      const int q = it - n_tr - n_mod, kv = q >> 2, n = (q & 3) * 32 + (tid & 31), kg = tid >> 5;
      const float* w1 = p->cmp_w1 + (long)kv * 2048 * 128;
      const float* pe = p->cmp_pos + (long)kv * 2048;
      float a = 0.f;
      for (int k = kg * 128; k < kg * 128 + 128; ++k) a += pe[k] * w1[(long)k * 128 + n];
      fs[kg * 32 + (tid & 31)] = a;
      __syncthreads();
      if (tid < 32) {
        float s = 0.f;
        for (int g = 0; g < 16; ++g) s += fs[g * 32 + tid];
        p->cvec[kv * 128 + (q & 3) * 32 + tid] = s;
      }
      __syncthreads();
    } else if (it < n_tr + n_mod + n_cv + n_rope) {
      const int q = it - n_tr - n_mod - n_cv;
      const int e = q * 512 + tid, pos = e >> 3, i = e & 7;
      const float freq = powf(500000.f, -(float)i * 0.125f);
      const float angf = (float)pos * freq;
      const double ang = (double)angf;
      const double n = rint(ang * 0.15915494309189535);
      double r = fma(-n, 6.283185307179586, ang);
      r = fma(-n, 2.4492935982947064e-16, r);
      const float rf = (float)r;
      p->rope[pos * 16 + i] = cosf(rf);
      p->rope[pos * 16 + 8 + i] = sinf(rf);
    } else {
      if (tid < 512) {
        int bg = tid >> 6, d = tid & 63;
        p->kcmp[((long)bg * 512 + 511) * 64 + d] = 0;
        p->vcmpT[((long)bg * 64 + d) * 512 + 511] = 0;
        p->mcnt[tid] = 0u;
        p->mcnt[512 + tid] = 0u;
        if (tid < 64) { p->ctr[tid] = 0u; p->xcnt[tid] = 0u; }
        p->lbar[tid] = 0u;
      }
    }
  }
}

constexpr int KVS = 72;
constexpr int KVT = 64 * KVS;
constexpr float SCL2 = 0.125f * 1.4426950408889634f;

DI void qk_tile(const u16* Ks, const bf16x8* qf, f32x16* s, int rl, int hh) {
#pragma unroll
  for (int kb = 0; kb < 2; ++kb) {
#pragma unroll
    for (int i = 0; i < 16; ++i) s[kb][i] = 0.f;
#pragma unroll
    for (int ks = 0; ks < 4; ++ks) {
      bf16x8 a = *(const bf16x8*)(Ks + (kb * 32 + rl) * KVS + ks * 16 + hh * 8);
      s[kb] = MFMA32(a, qf[ks], s[kb]);
    }
  }
}
DI void pv_tile(const u16* Vs, const f32x16* s, f32x16* o, int rl, int hh) {
#pragma unroll
  for (int kk = 0; kk < 4; ++kk) {
    const int kb = kk >> 1, i0 = 8 * (kk & 1);
    bf16x8 pf = pack8(s[kb][i0], s[kb][i0 + 1], s[kb][i0 + 2], s[kb][i0 + 3], s[kb][i0 + 4], s[kb][i0 + 5], s[kb][i0 + 6], s[kb][i0 + 7]);
#pragma unroll
    for (int db = 0; db < 2; ++db) {
      const u16* vp = Vs + (db * 32 + rl) * KVS + kk * 16 + hh * 4;
      s16x4 lo = *(const s16x4*)vp, hi = *(const s16x4*)(vp + 8);
      bf16x8 a = __builtin_shufflevector(lo, hi, 0, 1, 2, 3, 4, 5, 6, 7);
      o[db] = MFMA32(a, pf, o[db]);
    }
  }
}
DI float fexp2(float x) { return __builtin_amdgcn_exp2f(x); }
template <int MODE>
DI void osm(f32x16* s, uint32_t vm, float& m, float& l, f32x16* o) {
  float mx = -1e30f;
#pragma unroll
  for (int kb = 0; kb < 2; ++kb)
#pragma unroll
    for (int i = 0; i < 16; ++i) {
      if (MODE == 2) s[kb][i] = ((vm >> (kb * 16 + i)) & 1u) ? s[kb][i] : -1e30f;
      mx = fmaxf(mx, s[kb][i]);
    }
  mx *= SCL2;
  if (MODE == 1) mx = vm ? mx : -1e30f;
  mx = xmax32(mx);
  const float mn = fmaxf(m, mx);
  const float alpha = fexp2(m - mn);
  const bool rowok = (MODE == 1) ? (vm != 0u) : true;
  const float mu = (rowok && mn > -1e29f) ? mn : 1e30f;
  float rs = 0.f;
#pragma unroll
  for (int kb = 0; kb < 2; ++kb)
#pragma unroll
    for (int i = 0; i < 16; ++i) {
      const float pv = fexp2(__builtin_fmaf(s[kb][i], SCL2, -mu));
      s[kb][i] = pv;
      rs += pv;
    }
  rs = xsum32(rs);
  l = l * alpha + rs;
  if (__ballot(mn > m) != 0ull) {
#pragma unroll
    for (int db = 0; db < 2; ++db)
#pragma unroll
      for (int i = 0; i < 16; ++i) o[db][i] *= alpha;
  }
  m = mn;
}
DI void online_softmax(f32x16* s, uint32_t vm, float& m, float& l, f32x16* o) {
  const unsigned long long ball = __ballot(vm == 0xffffffffu), bnone = __ballot(vm == 0u);
  if (ball == ~0ull) osm<0>(s, vm, m, l, o);
  else if ((ball | bnone) == ~0ull) osm<1>(s, vm, m, l, o);
  else osm<2>(s, vm, m, l, o);
}
DI uint32_t range_mask(int kpos0, int lo, int hi, int hh) {
  if (kpos0 >= lo && kpos0 + 63 <= hi) return 0xffffffffu;
  if (kpos0 > hi || kpos0 + 63 < lo) return 0u;
  uint32_t vm = 0;
#pragma unroll
  for (int kb = 0; kb < 2; ++kb)
#pragma unroll
    for (int i = 0; i < 16; ++i) {
      int kp = kpos0 + kb * 32 + hh * 4 + (i & 3) + 8 * (i >> 2);
      vm |= (kp >= lo && kp <= hi) ? (1u << (kb * 16 + i)) : 0u;
    }
  return vm;
}

struct KVRegs { u32x4 k, v; };
DI void kv_issue(KVRegs& r, const u16* kptr, long ldk, const u16* vptr, long ldv, int tid) {
  const int row = tid >> 3, seg = tid & 7;
  r.k = *(const u32x4*)(kptr + (long)row * ldk + seg * 8);
  r.v = *(const u32x4*)(vptr + (long)row * ldv + seg * 8);
}
DI void kv_write(const KVRegs& r, u16* Ks, u16* Vs, int tid) {
  const int row = tid >> 3, seg = tid & 7;
  *(u32x4*)(Ks + row * KVS + seg * 8) = r.k;
  *(u32x4*)(Vs + row * KVS + seg * 8) = r.v;
}
template <class TF, class BODY>
DI void kv_loop(u16* kvb, int ntiles, int tid, TF tf, BODY body) {
  KVRegs r;
  const u16 *kp, *vp;
  long ldk, ldv;
  __syncthreads();
  if (ntiles > 0) {
    tf(0, kp, ldk, vp, ldv);
    kv_issue(r, kp, ldk, vp, ldv, tid);
    kv_write(r, kvb, kvb + KVT, tid);
  }
  __syncthreads();
  for (int i = 0; i < ntiles; ++i) {
    const int cur = i & 1;
    if (i + 1 < ntiles) {
      tf(i + 1, kp, ldk, vp, ldv);
      kv_issue(r, kp, ldk, vp, ldv, tid);
    }
    body(i, kvb + cur * 2 * KVT, kvb + cur * 2 * KVT + KVT);
    if (i + 1 < ntiles) kv_write(r, kvb + (cur ^ 1) * 2 * KVT, kvb + (cur ^ 1) * 2 * KVT + KVT, tid);
    __syncthreads();
  }
}
DI void load_qf(bf16x8* qf, const u16* qrow, int hh) {
#pragma unroll
  for (int ks = 0; ks < 4; ++ks) qf[ks] = *(const bf16x8*)(qrow + ks * 16 + hh * 8);
}
DI bf16x8 rope_frag(bf16x8 f, const float* cs  , int hh) {
  u32x4 w = __builtin_bit_cast(u32x4, f), ow;
#pragma unroll
  for (int q = 0; q < 4; ++q) ow[q] = shxi<32>((int)w[q]);
  float mine[8], oth[8], res[8];
#pragma unroll
  for (int q = 0; q < 4; ++q) {
    mine[2 * q] = bflo(w[q]); mine[2 * q + 1] = bfhi(w[q]);
    oth[2 * q] = bflo(ow[q]); oth[2 * q + 1] = bfhi(ow[q]);
  }
  const float sg = hh ? 1.f : -1.f;
#pragma unroll
  for (int i = 0; i < 8; ++i) res[i] = mine[i] * cs[i] + sg * oth[i] * cs[8 + i];
  u32x4 r = {pack2(res[0], res[1]), pack2(res[2], res[3]), pack2(res[4], res[5]), pack2(res[6], res[7])};
  return __builtin_bit_cast(bf16x8, r);
}
DI void store_o(u16* yrow, const f32x16* o, float scale, int hh) {
#pragma unroll
  for (int db = 0; db < 2; ++db)
#pragma unroll
    for (int q = 0; q < 4; ++q) {
      u32x2 pk = {pack2(o[db][4 * q] * scale, o[db][4 * q + 1] * scale), pack2(o[db][4 * q + 2] * scale, o[db][4 * q + 3] * scale)};
      wt64(yrow + db * 32 + 8 * q + 4 * hh, pk);
    }
}

DI void kprep0_phase(int ws, PP p, char* shm) {
  const int tid = mytid(ws);
  float* fs = (float*)shm;
  u16* u = p->big;
  for (int item = blockIdx.x; item < 256; item += gridDim.x) {
    const int b = item >> 6, n = (item >> 1) & 31, hg = item & 1;
    const int cc = tid & 31, tg = tid >> 5, head = hg * 4 + (cc >> 3), dch = cc & 7;
    float sum[8];
#pragma unroll
    for (int e = 0; e < 8; ++e) sum[e] = 0.f;
#pragma unroll 1
    for (int tb = 0; tb < 16; tb += 8) {
    u32x4 wv[8];
#pragma unroll
    for (int t8 = 0; t8 < 8; ++t8) wv[t8] = *(const u32x4*)(u + ((long)b * SEQ + n * 256 + tg * 16 + tb + t8) * IN0 + 1536 + head * 64 + dch * 8);
#pragma unroll
    for (int t8 = 0; t8 < 8; ++t8) {
      const int tt = tb + t8;
      const int tok = n * 256 + tg * 16 + tt;
      u16* ptr = u + ((long)b * SEQ + tok) * IN0 + 1536 + head * 64 + dch * 8;
      u32x4 w = wv[t8], ow;
#pragma unroll
      for (int q = 0; q < 4; ++q) ow[q] = shxi<1>((int)w[q]);
      float mine[8], oth[8];
#pragma unroll
      for (int q = 0; q < 4; ++q) {
        mine[2 * q] = bflo(w[q]); mine[2 * q + 1] = bfhi(w[q]);
        oth[2 * q] = bflo(ow[q]); oth[2 * q + 1] = bfhi(ow[q]);
      }
      if (dch < 2) {
        const float* cs = p->rope + tok * 16;
        const float sg = dch ? 1.f : -1.f;
        float res[8];
#pragma unroll
        for (int i = 0; i < 8; ++i) res[i] = mine[i] * cs[i] + sg * oth[i] * cs[8 + i];
        u32x4 r = {pack2(res[0], res[1]), pack2(res[2], res[3]), pack2(res[4], res[5]), pack2(res[6], res[7])};
        wt128(ptr, r);
#pragma unroll
        for (int q = 0; q < 4; ++q) { mine[2 * q] = bflo(r[q]); mine[2 * q + 1] = bfhi(r[q]); }
      }
#pragma unroll
      for (int e = 0; e < 8; ++e) sum[e] += mine[e];
    }
    }
    __syncthreads();
#pragma unroll
    for (int e = 0; e < 8; ++e) fs[tg * 256 + cc * 8 + e] = sum[e];
    __syncthreads();
    if (tid < 256) {
      float t = 0.f;
#pragma unroll
      for (int g = 0; g < 16; ++g) t += fs[g * 256 + tid];
      wt32f(p->cent + (((long)b * 8 + hg * 4 + (tid >> 6)) * 32 + n) * 64 + (tid & 63), t * (1.f / 256.f));
    }
    __syncthreads();
  }
}

template <bool FINAL>
DI void lru_item(int ws, PP p, char* shm, int item) {
  const int tid = mytid(ws), wid = tid >> 6, lane = tid & 63, rl = lane & 31, hh = lane >> 5;
  const int b = item & 3, c = 127 - (item >> 2), t0 = c * 64;
  const u16* u = p->big;
  u16* XC = (u16*)shm + wid * KVT;
  {
    const int ch = wid * 64 + lane;
    const float w0 = p->conv_w[ch], w1 = p->conv_w[512 + ch], w2 = p->conv_w[1024 + ch], w3 = p->conv_w[1536 + ch], cb = p->conv_b[ch];
    const u16* up = u + ((long)b * SEQ + t0) * IN0 + ch;
    float xm3 = 0.f, xm2 = 0.f, xm1 = 0.f;
    if (t0 > 0) { xm3 = bf2f(up[-3 * IN0]); xm2 = bf2f(up[-2 * IN0]); xm1 = bf2f(up[-1 * IN0]); }
    for (int t = 0; t < 64; ++t) {
      float xv = bf2f(up[(long)t * IN0]);
      float xc = w0 * xm3 + w1 * xm2 + w2 * xm1 + w3 * xv + cb;
      XC[t * KVS + lane] = f2bf(xc);
      xm3 = xm2; xm2 = xm1; xm1 = xv;
    }
  }
  __syncthreads();
  const u16* wat = p->wat + (long)wid * 4096;
  const u16* wxt = p->wat + (long)(8 + wid) * 4096;
#pragma unroll 1
  for (int nb = 0; nb < 2; ++nb) {
    f32x16 ar[2], ai[2];
#pragma unroll
    for (int mb = 0; mb < 2; ++mb)
#pragma unroll
      for (int i = 0; i < 16; ++i) { ar[mb][i] = 0.f; ai[mb][i] = 0.f; }
#pragma unroll
    for (int ks = 0; ks < 4; ++ks) {
      bf16x8 ba_ = *(const bf16x8*)(wat + (nb * 32 + rl) * 64 + ks * 16 + hh * 8);
      bf16x8 bx_ = *(const bf16x8*)(wxt + (nb * 32 + rl) * 64 + ks * 16 + hh * 8);
#pragma unroll
      for (int mb = 0; mb < 2; ++mb) {
        bf16x8 a = *(const bf16x8*)(XC + (mb * 32 + rl) * KVS + ks * 16 + hh * 8);
        ar[mb] = MFMA32(a, ba_, ar[mb]);
        ai[mb] = MFMA32(a, bx_, ai[mb]);
      }
    }
    const int j = nb * 32 + rl, chj = wid * 64 + j;
    const float baj = p->ba[chj], bxj = p->bx[chj];
    const float la = -8.f * log1pf(__expf(-p->lam[chj]));
#pragma unroll
    for (int mb = 0; mb < 2; ++mb)
#pragma unroll
      for (int i = 0; i < 16; ++i) {
        const int tok = mb * 32 + hh * 4 + (i & 3) + 8 * (i >> 2);
        const float xc = bf2f(XC[tok * KVS + j]);
        const float r = sigmoidf_(ar[mb][i] + baj), ig = sigmoidf_(ai[mb][i] + bxj);
        const float aa = __expf(r * la);
        ar[mb][i] = aa;
        ai[mb][i] = __builtin_amdgcn_sqrtf(__builtin_fmaf(-aa, aa, 1.f)) * ig * xc;
      }
    float carry = 0.f, atot = 1.f;
    if (FINAL) {
      const float* sm = p->lrusum + ((long)b * 128 * 512 + chj) * 2;
#pragma unroll 8
      for (int cp = 0; cp < c; ++cp) {
        float2 ab = *(const float2*)(sm + (long)cp * 1024);
        carry = ab.y + ab.x * carry;
      }
    }
#pragma unroll
    for (int mb = 0; mb < 2; ++mb)
#pragma unroll
      for (int q = 0; q < 4; ++q) {
        float P = 1.f, H = 0.f;
#pragma unroll
        for (int e = 0; e < 4; ++e) {
          const int idx = 4 * q + e;
          H = ar[mb][idx] * H + ai[mb][idx];
          P *= ar[mb][idx];
          ar[mb][idx] = P;
          ai[mb][idx] = H;
        }
        const float Po = shxf<32>(P), Ho = shxf<32>(H);
        const float A0 = hh ? Po : P, B0 = hh ? Ho : H, A1 = hh ? P : Po, B1 = hh ? H : Ho;
        const float mid = B0 + A0 * carry;
        const float cin = hh ? mid : carry;
        carry = B1 + A1 * mid;
        atot *= A0 * A1;
        if (FINAL) {
          const int tl0 = launder(hh * 4);
#pragma unroll
          for (int e = 0; e < 4; ++e) {
            const int idx = 4 * q + e;
            const int tok = mb * 32 + tl0 + e + 8 * q;
            const float hv = ai[mb][idx] + ar[mb][idx] * cin;
            const long trow = (long)b * SEQ + t0 + tok;
            const float g = bf2f(u[trow * IN0 + 512 + chj]);
            wt16(p->h + trow * DM + chj, f2bf(hv * gelu_tanh(g)));
          }
        }
      }
    if (!FINAL && hh == 0) {
      float2 ab = {atot, carry};
      wt64(p->lrusum + (((long)b * 128 + c) * 512 + chj) * 2, __builtin_bit_cast(u32x2, ab));
    }
  }
  __syncthreads();
}

DI int moba_off(int n) { return 256 * (31 * n - (n * (n - 1)) / 2); }

DI void moba_gate_item(int ws, PP p, char* shm, int item) {
  const int tid = mytid(ws);
  const int qb = 31 - (item >> 5), b = (item >> 3) & 3, h = item & 7;
  if (qb == 0) return;
  const int t0 = qb * 256;
  const u16* u = p->big;
  float* cs = (float*)shm;
  float* tv = (float*)(shm + 8192);
  int* ti = (int*)(shm + 11264);
  __syncthreads();
  for (int i = tid; i < qb * 64; i += NTHR) cs[i] = p->cent[((long)(b * 8 + h) * 32) * 64 + i];
  __syncthreads();
  const int ql = tid & 255, half = tid >> 8, tq = t0 + ql;
  const u16* qp = u + ((long)b * SEQ + tq) * IN0 + 1024 + h * 64;
  float q[64];
#pragma unroll
  for (int s8 = 0; s8 < 8; ++s8) {
    u32x4 w = *(const u32x4*)(qp + s8 * 8);
#pragma unroll
    for (int e = 0; e < 4; ++e) { q[s8 * 8 + 2 * e] = bflo(w[e]); q[s8 * 8 + 2 * e + 1] = bfhi(w[e]); }
  }
  {
    const float* rc = p->rope + tq * 16;
#pragma unroll
    for (int i = 0; i < 8; ++i) {
      float x1 = q[i], x2 = q[8 + i], cc = rc[i], sn = rc[8 + i];
      q[i] = bf2f(f2bf(x1 * cc - x2 * sn));
      q[8 + i] = bf2f(f2bf(x2 * cc + x1 * sn));
    }
  }
  float v0 = -INFINITY, v1 = -INFINITY, v2 = -INFINITY;
  int i0 = -1, i1 = -1, i2 = -1;
  for (int n = half; n < qb; n += 2) {
    const float4* cr = (const float4*)(cs + n * 64);
    float d = 0.f;
#pragma unroll
    for (int e = 0; e < 16; ++e) {
      float4 cv = cr[e];
      d += q[4 * e] * cv.x + q[4 * e + 1] * cv.y + q[4 * e + 2] * cv.z + q[4 * e + 3] * cv.w;
    }
    if (d > v0) { v2 = v1; i2 = i1; v1 = v0; i1 = i0; v0 = d; i0 = n; }
    else if (d > v1) { v2 = v1; i2 = i1; v1 = d; i1 = n; }
    else if (d > v2) { v2 = d; i2 = n; }
  }
  if (half == 1) {
    tv[ql * 3] = v0; tv[ql * 3 + 1] = v1; tv[ql * 3 + 2] = v2;
    ti[ql * 3] = i0; ti[ql * 3 + 1] = i1; ti[ql * 3 + 2] = i2;
  }
  __syncthreads();
  if (half == 0) {
#pragma unroll
    for (int e = 0; e < 3; ++e) {
      const float d = tv[ql * 3 + e];
      const int n = ti[ql * 3 + e];
      if (n >= 0) {
        if (d > v0 || (d == v0 && n < i0)) { v2 = v1; i2 = i1; v1 = v0; i1 = i0; v0 = d; i0 = n; }
        else if (d > v1 || (d == v1 && n < i1)) { v2 = v1; i2 = i1; v1 = d; i1 = n; }
        else if (d > v2 || (d == v2 && n < i2)) { v2 = d; i2 = n; }
      }
    }
  }
  int* lcnt = (int*)(shm + 14336);
  if (tid < 64) lcnt[tid] = 0;
  __syncthreads();
  int r0 = 0, r1 = 0, r2 = 0;
  if (half == 0) {
    if (i0 >= 0) r0 = atomicAdd(&lcnt[i0], 1);
    if (i1 >= 0) r1 = atomicAdd(&lcnt[i1], 1);
    if (i2 >= 0) r2 = atomicAdd(&lcnt[i2], 1);
  }
  __syncthreads();
  const int bh = b * 8 + h;
  if (tid < 32 && lcnt[tid] > 0) lcnt[32 + tid] = (int)atomicAdd(&p->mcnt[bh * 32 + tid], (unsigned)lcnt[tid]);
  __syncthreads();
  if (half == 0) {
    unsigned* lst = p->mlist + (long)bh * 126976;
    if (i0 >= 0) wt32u(lst + moba_off(i0) + lcnt[32 + i0] + r0, ((unsigned)tq << 2) | 0u);
    if (i1 >= 0) wt32u(lst + moba_off(i1) + lcnt[32 + i1] + r1, ((unsigned)tq << 2) | 1u);
    if (i2 >= 0) wt32u(lst + moba_off(i2) + lcnt[32 + i2] + r2, ((unsigned)tq << 2) | 2u);
  }
}

DI void moba_gather_phase(int ws, PP p, char* shm) {
  const int tid = mytid(ws), wid = tid >> 6, lane = tid & 63, rl = lane & 31, hh = lane >> 5;
  const u16* u = p->big;
  u16* kvb = (u16*)shm;
  int* pre = (int*)(shm + 120000);
  __syncthreads();
  {
    const int c0 = (int)((p->mcnt[2 * tid] + 255u) >> 8), c1 = (int)((p->mcnt[2 * tid + 1] + 255u) >> 8);
    int sc = c0 + c1;
#pragma unroll
    for (int d = 1; d < 64; d <<= 1) {
      const int o = __shfl_up(sc, d);
      if (lane >= d) sc += o;
    }
    int* wtot = pre + 1032;
    if (lane == 63) wtot[wid] = sc;
    __syncthreads();
    int base = 0;
    for (int w = 0; w < wid; ++w) base += wtot[w];
    const int excl = base + sc - (c0 + c1);
    if (tid == 0) pre[0] = 0;
    pre[2 * tid + 1] = excl + c0;
    pre[2 * tid + 2] = excl + c0 + c1;
  }
  __syncthreads();
  const int total = pre[1024];
  const int row = tid >> 3, seg = tid & 7;
  u32x4 kr[4], vr[4];
  auto locate = [&](int it, int& li, int& chunk) {
    int lo = 0, hi = 1024;
    while (hi - lo > 1) {
      const int mid = (lo + hi) >> 1;
      if (pre[mid] <= it) lo = mid; else hi = mid;
    }
    li = lo;
    chunk = it - pre[lo];
  };
  auto issue = [&](int li) {
    const int bh = li >> 5, n = li & 31, b = bh >> 3, h = bh & 7;
    const u16* kbase = u + ((long)b * SEQ + n * 256) * IN0 + 1536 + h * 64;
    const u16* vbase = p->vt + ((long)bh * 64) * SEQ + n * 256;
#pragma unroll
    for (int st = 0; st < 4; ++st) {
      kr[st] = *(const u32x4*)(kbase + (long)(st * 64 + row) * IN0 + seg * 8);
      vr[st] = *(const u32x4*)(vbase + (long)row * SEQ + st * 64 + seg * 8);
    }
  };
  int li = 0, chunk = 0;
  int* gslot = (int*)(shm + 150016);
  int it = grab(ws, p->ctr + 2, shm);
  if (it < total) { locate(it, li, chunk); issue(li); }
#pragma unroll 1
  while (it < total) {
    const int bh = li >> 5, n = li & 31, b = bh >> 3, h = bh & 7;
    const int cnt = (int)p->mcnt[li];
    __syncthreads();
#pragma unroll
    for (int st = 0; st < 4; ++st) {
      *(u32x4*)(kvb + st * 2 * KVT + row * KVS + seg * 8) = kr[st];
      *(u32x4*)(kvb + st * 2 * KVT + KVT + row * KVS + seg * 8) = vr[st];
    }
    const int e = chunk * 256 + wid * 32 + rl;
    const bool valid = e < cnt;
    const unsigned ent = p->mlist[(long)bh * 126976 + moba_off(n) + (valid ? e : 0)];
    const int tq = (int)(ent >> 2), slot = (int)(ent & 3u);
    bf16x8 qf[4];
    load_qf(qf, u + ((long)b * SEQ + tq) * IN0 + 1024 + h * 64, hh);
    qf[0] = rope_frag(qf[0], p->rope + tq * 16, hh);
    if (tid == 0) *gslot = (int)atomicAdd(p->ctr + 2, 1u);
    f32x16 o[2];
#pragma unroll
    for (int db = 0; db < 2; ++db)
#pragma unroll
      for (int i = 0; i < 16; ++i) o[db][i] = 0.f;
    float m = -1e30f, l = 0.f;
    __syncthreads();
    const int itn = *gslot;
    int lin = 0, chunkn = 0;
    if (itn < total) { locate(itn, lin, chunkn); issue(lin); }
#pragma unroll
    for (int st = 0; st < 4; ++st) {
      f32x16 s[2];
      qk_tile(kvb + st * 2 * KVT, qf, s, rl, hh);
      osm<0>(s, 0xffffffffu, m, l, o);
      pv_tile(kvb + st * 2 * KVT + KVT, s, o, rl, hh);
    }
    if (valid) {
      u16* pe = p->part + (((long)bh * SEQ + tq) * 3 + slot) * 72;
      store_o(pe + 8, o, 1.f / l, hh);
      if (hh == 0) { wt32f((float*)pe, m); wt32f((float*)pe + 1, l); }
    }
    li = lin; chunk = chunkn; it = itn;
  }
  __syncthreads();
}

DI void moba_own_item(int ws, PP p, char* shm, int item) {
  const int tid = mytid(ws), wid = tid >> 6, lane = tid & 63, rl = lane & 31, hh = lane >> 5;
  const int qb = 31 - (item >> 5), b = (item >> 3) & 3, h = item & 7;
  const int t0 = qb * 256;
  const u16* u = p->big;
  u16* kvb = (u16*)shm;
  const int tq = t0 + wid * 32 + rl;
  bf16x8 qf[4];
  load_qf(qf, u + ((long)b * SEQ + tq) * IN0 + 1024 + h * 64, hh);
  qf[0] = rope_frag(qf[0], p->rope + tq * 16, hh);
  f32x16 o[2];
#pragma unroll
  for (int db = 0; db < 2; ++db)
#pragma unroll
    for (int i = 0; i < 16; ++i) o[db][i] = 0.f;
  float m = -1e30f, l = 0.f;
  const u16* kbase = u + ((long)b * SEQ + t0) * IN0 + 1536 + h * 64;
  const u16* vbase = p->vt + ((long)(b * 8 + h) * 64) * SEQ + t0;
  auto tf = [&](int i, const u16*& kp, long& ldk, const u16*& vp, long& ldv) {
    kp = kbase + (long)i * 64 * IN0; ldk = IN0;
    vp = vbase + i * 64; ldv = SEQ;
  };
  auto body = [&](int i, const u16* Ks, const u16* Vs) {
    const uint32_t vm = range_mask(i * 64, 0, wid * 32 + rl, hh);
    if (__ballot(vm != 0) != 0ull) {
      f32x16 s[2];
      qk_tile(Ks, qf, s, rl, hh);
      online_softmax(s, vm, m, l, o);
      pv_tile(Vs, s, o, rl, hh);
    }
  };
  kv_loop(kvb, 4, tid, tf, body);
  const int nsl = qb < 3 ? qb : 3;
#pragma unroll 1
  for (int sl = 0; sl < nsl; ++sl) {
    const u16* pe = p->part + (((long)(b * 8 + h) * SEQ + tq) * 3 + sl) * 72;
    const float ms = ((const float*)pe)[0], ls = ((const float*)pe)[1];
    const float mn = fmaxf(m, ms);
    const float a = fexp2(m - mn), c = fexp2(ms - mn) * ls;
#pragma unroll
    for (int db = 0; db < 2; ++db)
#pragma unroll
      for (int q = 0; q < 4; ++q) {
        const u32x2 w = *(const u32x2*)(pe + 8 + db * 32 + 8 * q + 4 * hh);
        o[db][4 * q] = o[db][4 * q] * a + c * bflo(w[0]);
        o[db][4 * q + 1] = o[db][4 * q + 1] * a + c * bfhi(w[0]);
        o[db][4 * q + 2] = o[db][4 * q + 2] * a + c * bflo(w[1]);
        o[db][4 * q + 3] = o[db][4 * q + 3] * a + c * bfhi(w[1]);
      }
    l = l * a + c;
    m = mn;
  }
  store_o(p->h + ((long)b * SEQ + tq) * DM + 512 + h * 64, o, 1.f / l, hh);
}

DI void rope1_phase(int ws, PP p) {
  const int tid = mytid(ws);
  u16* u = p->big;
  for (int e = blockIdx.x * NTHR + tid; e < NT * 4; e += gridDim.x * NTHR) {
    const int trow = e >> 2, w = e & 3, pos = trow & (SEQ - 1);
    u16* ptr = u + (long)trow * IN1P + ((w & 2) ? 1536 : 1280) + (w & 1) * 64;
    u32x4 a = *(const u32x4*)ptr, bq = *(const u32x4*)(ptr + 8);
    const float* cs = p->rope + pos * 16;
    float x1[8], x2[8], r1[8], r2[8];
#pragma unroll
    for (int q = 0; q < 4; ++q) { x1[2 * q] = bflo(a[q]); x1[2 * q + 1] = bfhi(a[q]); x2[2 * q] = bflo(bq[q]); x2[2 * q + 1] = bfhi(bq[q]); }
#pragma unroll
    for (int i = 0; i < 8; ++i) { r1[i] = x1[i] * cs[i] - x2[i] * cs[8 + i]; r2[i] = x2[i] * cs[i] + x1[i] * cs[8 + i]; }
    u32x4 oa = {pack2(r1[0], r1[1]), pack2(r1[2], r1[3]), pack2(r1[4], r1[5]), pack2(r1[6], r1[7])};
    u32x4 ob = {pack2(r2[0], r2[1]), pack2(r2[2], r2[3]), pack2(r2[4], r2[5]), pack2(r2[6], r2[7])};
    wt128(ptr, oa);
    wt128(ptr + 8, ob);
  }
}
DI void cmpfin_phase(int ws, int gx, int gslot, PP p, char* shm) {
  const int tid = mytid(ws);
  float* hid = (float*)shm;
  float* w2s = (float*)(shm + 4096);
  int kvl = -1;
  const int slots = gridDim.x >> 3;
  for (int li = gslot; li < 128; li += slots) {
    const int kv = gx >> 2, bg = 2 * (gx & 3) + (li >> 6), i0 = (li & 63) * 8;
    const int row = tid >> 6, n = tid & 63, i = i0 + row;
    const float* pq = p->pq + ((long)kv * 4096 + bg * 512) * 256;
    __syncthreads();
    if (kv != kvl) {
      const float* w2 = p->cmp_w2 + (long)kv * 128 * 64;
      for (int e = tid; e < 128 * 64; e += NTHR) w2s[e] = w2[e];
      kvl = kv;
    }
#pragma unroll
    for (int hf = 0; hf < 2; ++hf) {
      const int nn = n + hf * 64;
      float v = 0.f;
      if (i < 511) v = gelu_tanh(pq[(long)i * 256 + nn] + pq[(long)(i + 1) * 256 + 128 + nn] + p->cvec[kv * 128 + nn]);
      hid[row * 128 + nn] = v;
    }
    __syncthreads();
    float acc = 0.f;
#pragma unroll 8
    for (int k = 0; k < 128; ++k) acc += hid[row * 128 + k] * w2s[k * 64 + n];
    if (i < 511) {
      if (kv == 0) wt16(p->kcmp + ((long)bg * 512 + i) * 64 + n, f2bf(acc));
      else wt16(p->vcmpT + ((long)bg * 64 + n) * 512 + i, f2bf(acc));
    }
  }
  __syncthreads();
}

DI void nsa_item(int ws, PP p, char* shm, int item) {
  const int tid = mytid(ws), wid = tid >> 6, lane = tid & 63, rl = lane & 31, hh = lane >> 5;
  const int tt = 255 - (item >> 3), bg = item & 7, b = bg >> 1, g = bg & 1;
  const int t0 = tt * 32, tokl = wid * 4 + (rl >> 3), tok = t0 + tokl, r = rl & 7, hq = g * 8 + r;
  const u16* u = p->big;
  u16* kvb = (u16*)shm;
  float* impm = (float*)(shm + 36864);
  float* imps = (float*)(shm + 53760);
  float* vals = (float*)(shm + 70656);
  unsigned char* selb = (unsigned char*)(shm + 147456);
  uint32_t* un = (uint32_t*)(shm + 147968);
  int* tl = (int*)(shm + 148032);
  __syncthreads();
  for (int i = tid; i < 2 * 32 * 132; i += NTHR) impm[i] = 0.f;
  if (tid < 8) un[tid] = 0;
  const u16* qrow = u + ((long)b * SEQ + tok) * IN1P + hq * 64;
  bf16x8 qn[4], qr[4];
  load_qf(qn, qrow, hh);
  qr[0] = rope_frag(qn[0], p->rope + tok * 16, hh);
  qr[1] = qn[1]; qr[2] = qn[2]; qr[3] = qn[3];
  float gt[3];
#pragma unroll
  for (int br = 0; br < 3; ++br) gt[br] = sigmoidf_(bf2f(qrow[1792 - hq * 64 + hq * 3 + br]));
  f32x16 yacc[2], o[2];
#pragma unroll
  for (int db = 0; db < 2; ++db)
#pragma unroll
    for (int i = 0; i < 16; ++i) { yacc[db][i] = 0.f; o[db][i] = 0.f; }
  {
    const int nct = (t0 >> 10) + 1;
    const int cmax = (tok - 31) >> 4;
    const u16* kc = p->kcmp + (long)bg * 512 * 64;
    const u16* vc = p->vcmpT + (long)bg * 64 * 512;
    auto tf = [&](int i, const u16*& kp, long& ldk, const u16*& vp, long& ldv) {
      kp = kc + (long)i * 64 * 64; ldk = 64;
      vp = vc + i * 64; ldv = 512;
    };
    float m = -1e30f, l = 0.f;
    auto body1 = [&](int i, const u16* Ks, const u16* Vs) {
      const uint32_t vm = range_mask(i * 64, 0, cmax, hh);
      f32x16 s[2];
      qk_tile(Ks, qn, s, rl, hh);
      float mx = -1e30f;
#pragma unroll
      for (int kb = 0; kb < 2; ++kb)
#pragma unroll
        for (int ii = 0; ii < 16; ++ii) {
          float v = s[kb][ii] * SCL2;
          v = ((vm >> (kb * 16 + ii)) & 1u) ? v : -1e30f;
          s[kb][ii] = v;
          mx = fmaxf(mx, v);
        }
      mx = xmax32(mx);
      const float mn = fmaxf(m, mx);
      float rs = 0.f;
#pragma unroll
      for (int kb = 0; kb < 2; ++kb)
#pragma unroll
        for (int ii = 0; ii < 16; ++ii) rs += ((vm >> (kb * 16 + ii)) & 1u) ? fexp2(s[kb][ii] - mn) : 0.f;
      rs = xsum32(rs);
      l = l * fexp2(m - mn) + rs;
      m = mn;
    };
    kv_loop(kvb, nct, tid, tf, body1);
    const float invl = l > 0.f ? 1.f / l : 0.f;
    auto body2 = [&](int i, const u16* Ks, const u16* Vs) {
      const uint32_t vm = range_mask(i * 64, 0, cmax, hh);
      f32x16 s[2];
      qk_tile(Ks, qn, s, rl, hh);
#pragma unroll
      for (int kb = 0; kb < 2; ++kb)
#pragma unroll
        for (int ii = 0; ii < 16; ++ii) s[kb][ii] = ((vm >> (kb * 16 + ii)) & 1u) ? fexp2(__builtin_fmaf(s[kb][ii], SCL2, -m)) * invl : 0.f;
      pv_tile(Vs, s, o, rl, hh);
#pragma unroll
      for (int kb = 0; kb < 2; ++kb)
#pragma unroll
        for (int q4 = 0; q4 < 4; ++q4) {
          float mainv = s[kb][4 * q4] + s[kb][4 * q4 + 1] + s[kb][4 * q4 + 2] + 0.5f * s[kb][4 * q4 + 3];
          float sp = 0.5f * s[kb][4 * q4 + 3];
          mainv = sum8(mainv);
          sp = sum8(sp);
          if (r == 0) {
            const int j = 16 * i + 8 * kb + 2 * q4 + hh;
            impm[tokl * 132 + j] = mainv;
            imps[tokl * 132 + j + 1] = sp;
          }
        }
    };
    kv_loop(kvb, nct, tid, tf, body2);
#pragma unroll
    for (int db = 0; db < 2; ++db)
#pragma unroll
      for (int i = 0; i < 16; ++i) { yacc[db][i] = gt[0] * o[db][i]; o[db][i] = 0.f; }
  }
  __syncthreads();
  {
    const int tk = tid >> 4, jg = tid & 15, blk = (t0 + tk) >> 6;
    float v[8];
#pragma unroll
    for (int e = 0; e < 8; ++e) {
      const int j = jg * 8 + e;
      float x = impm[tk * 132 + j] + imps[tk * 132 + j];
      if (j == 0 || j == blk || j == blk - 1) x = 1e30f;
      if (j > blk) x = -INFINITY;
      v[e] = x;
      vals[tk * 132 + j] = x;
    }
    uint32_t key[8];
#pragma unroll
    for (int e = 0; e < 8; ++e) {
      const uint32_t uu = __float_as_uint(v[e]);
      key[e] = (uu & 0x80000000u) ? ~uu : (uu | 0x80000000u);
    }
    auto rowsum = [](int c) {
      c += __builtin_amdgcn_update_dpp(0, c, 0x128, 0xF, 0xF, true);
      c += __builtin_amdgcn_update_dpp(0, c, 0x124, 0xF, 0xF, true);
      c += __builtin_amdgcn_update_dpp(0, c, 0x122, 0xF, 0xF, true);
      c += __builtin_amdgcn_update_dpp(0, c, 0x121, 0xF, 0xF, true);
      return c;
    };
    uint32_t pfx = 0;
#pragma unroll 1
    for (int b = 31; b >= 0; --b) {
      const uint32_t cand = pfx | (1u << b);
      int c = 0;
#pragma unroll
      for (int e = 0; e < 8; ++e) c += (key[e] >= cand) ? 1 : 0;
      c = rowsum(c);
      if (c >= 16) pfx = cand;
    }
    int cgt = 0, teq = 0;
#pragma unroll
    for (int e = 0; e < 8; ++e) { cgt += (key[e] > pfx) ? 1 : 0; teq += (key[e] == pfx) ? 1 : 0; }
    cgt = rowsum(cgt);
    int tin = teq;
    tin += __builtin_amdgcn_update_dpp(0, tin, 0x111, 0xF, 0xF, true);
    tin += __builtin_amdgcn_update_dpp(0, tin, 0x112, 0xF, 0xF, true);
    tin += __builtin_amdgcn_update_dpp(0, tin, 0x114, 0xF, 0xF, true);
    tin += __builtin_amdgcn_update_dpp(0, tin, 0x118, 0xF, 0xF, true);
    int run = cgt + tin - teq;
    uint32_t bits = 0;
#pragma unroll
    for (int e = 0; e < 8; ++e) {
      const bool eq = key[e] == pfx;
      const bool sel = (key[e] > pfx) || (eq && run < 16);
      run += eq ? 1 : 0;
      bits |= (sel && (jg * 8 + e) <= blk) ? (1u << e) : 0u;
    }
    selb[tk * 16 + jg] = (unsigned char)bits;
    __syncthreads();
    if (tid < 32) {
      const uint32_t* w = (const uint32_t*)(selb + tid * 16);
      atomicOr(&un[0], w[0]); atomicOr(&un[1], w[1]); atomicOr(&un[2], w[2]); atomicOr(&un[3], w[3]);
    }
    __syncthreads();
    if (tid < 128) {
      const uint32_t u0 = un[0], u1 = un[1], u2 = un[2], u3 = un[3];
      const int w = tid >> 5, bpos = tid & 31;
      const uint32_t uw = w == 0 ? u0 : w == 1 ? u1 : w == 2 ? u2 : u3;
      const int below = (w > 0 ? __popc(u0) : 0) + (w > 1 ? __popc(u1) : 0) + (w > 2 ? __popc(u2) : 0);
      if ((uw >> bpos) & 1u) tl[below + __popc(uw & ((1u << bpos) - 1u))] = tid;
      if (tid == 0) un[4] = __popc(u0) + __popc(u1) + __popc(u2) + __popc(u3);
    }
    __syncthreads();
  }
  {
    const int ntl = (int)un[4];
    const u32x4 ms = *(const u32x4*)(selb + tokl * 16);
    const u16* kb_ = u + (long)b * SEQ * IN1P + 1280 + g * 64;
    const u16* vb_ = p->vt + (long)bg * 64 * SEQ;
    auto tf = [&](int i, const u16*& kp, long& ldk, const u16*& vp, long& ldv) {
      const int j = tl[i];
      kp = kb_ + (long)j * 64 * IN1P; ldk = IN1P;
      vp = vb_ + j * 64; ldv = SEQ;
    };
    float m = -1e30f, l = 0.f;
    auto body = [&](int i, const u16* Ks, const u16* Vs) {
      const int j = tl[i];
      const uint32_t w = j < 32 ? ms[0] : j < 64 ? ms[1] : j < 96 ? ms[2] : ms[3];
      uint32_t vm = ((w >> (j & 31)) & 1u) ? range_mask(j * 64, 0, tok, hh) : 0u;
      if (__ballot(vm != 0) != 0ull) {
        f32x16 s[2];
        qk_tile(Ks, qr, s, rl, hh);
        online_softmax(s, vm, m, l, o);
        pv_tile(Vs, s, o, rl, hh);
      }
    };
    {
      const int ng = (ntl + 3) >> 2;
      const int row = tid >> 3, seg = tid & 7;
      u32x4 kr[4], vr[4];
      auto issue = [&](int g4) {
#pragma unroll
        for (int t = 0; t < 4; ++t) {
          const int idx = g4 * 4 + t;
          if (idx < ntl) {
            const int j = tl[idx];
            kr[t] = *(const u32x4*)(kb_ + ((long)j * 64 + row) * IN1P + seg * 8);
            vr[t] = *(const u32x4*)(vb_ + (long)row * SEQ + j * 64 + seg * 8);
          }
        }
      };
      auto wr = [&](int g4, int buf) {
#pragma unroll
        for (int t = 0; t < 4; ++t) {
          if (g4 * 4 + t < ntl) {
            u16* kd = kvb + (buf * 4 + t) * 2 * KVT;
            *(u32x4*)(kd + row * KVS + seg * 8) = kr[t];
            *(u32x4*)(kd + KVT + row * KVS + seg * 8) = vr[t];
          }
        }
      };
      __syncthreads();
      issue(0);
      wr(0, 0);
      __syncthreads();
#pragma unroll 1
      for (int g4 = 0; g4 < ng; ++g4) {
        if (g4 + 1 < ng) issue(g4 + 1);
#pragma unroll 1
        for (int t = 0; t < 4; ++t) {
          const int idx = g4 * 4 + t;
          if (idx < ntl) {
            const u16* kd = kvb + ((g4 & 1) * 4 + t) * 2 * KVT;
            body(idx, kd, kd + KVT);
          }
        }
        if (g4 + 1 < ng) wr(g4 + 1, (g4 + 1) & 1);
        __syncthreads();
      }
    }
    const float sc = gt[1] / l;
#pragma unroll
    for (int db = 0; db < 2; ++db)
#pragma unroll
      for (int i = 0; i < 16; ++i) { yacc[db][i] += sc * o[db][i]; o[db][i] = 0.f; }
  }
  {
    const int jlo = (t0 > 511 ? t0 - 511 : 0) >> 6, jhi = (t0 + 31) >> 6;
    const u16* kb_ = u + (long)b * SEQ * IN1P + 1536 + g * 64;
    const u16* vb_ = p->vt + (long)(8 + bg) * 64 * SEQ;
    auto tf = [&](int i, const u16*& kp, long& ldk, const u16*& vp, long& ldv) {
      const int j = jlo + i;
      kp = kb_ + (long)j * 64 * IN1P; ldk = IN1P;
      vp = vb_ + j * 64; ldv = SEQ;
    };
    float m = -1e30f, l = 0.f;
    auto body = [&](int i, const u16* Ks, const u16* Vs) {
      const int j = jlo + i;
      const uint32_t vm = range_mask(j * 64, tok - 511, tok, hh);
      if (__ballot(vm != 0) != 0ull) {
        f32x16 s[2];
        qk_tile(Ks, qr, s, rl, hh);
        online_softmax(s, vm, m, l, o);
        pv_tile(Vs, s, o, rl, hh);
      }
    };
    kv_loop(kvb, jhi - jlo + 1, tid, tf, body);
    const float sc = gt[2] / l;
#pragma unroll
    for (int db = 0; db < 2; ++db)
#pragma unroll
      for (int i = 0; i < 16; ++i) yacc[db][i] += sc * o[db][i];
  }
  store_o(p->h + ((long)b * SEQ + tok) * DM + hq * 64, yacc, 1.f, hh);
}

DI void local_barrier(unsigned* ctr, unsigned target, int ws) {
  asm volatile("s_waitcnt vmcnt(0)" ::: "memory");
  __syncthreads();
  if (ws == 0 && lane_id_() == 0) {
    __hip_atomic_fetch_add(ctr, 1u, __ATOMIC_RELAXED, __HIP_MEMORY_SCOPE_AGENT);
    unsigned sp = 0;
    while (__hip_atomic_load(ctr, __ATOMIC_RELAXED, __HIP_MEMORY_SCOPE_AGENT) < target) {
      __builtin_amdgcn_s_sleep(1);
      if (++sp > (1u << 22)) break;
    }
    __builtin_amdgcn_fence(__ATOMIC_ACQUIRE, "agent");
    asm volatile("s_waitcnt vmcnt(0)" ::: "memory");
  }
  __syncthreads();
}

__global__ void __launch_bounds__(NTHR) fwd_kernel(Params pk) {
  __shared__ __attribute__((aligned(1024))) char shm[151552];
  cg::grid_group grid = cg::this_grid();
  const PP p0 = (PP)__builtin_amdgcn_kernarg_segment_ptr();
  const int ws = __builtin_amdgcn_readfirstlane(threadIdx.x >> 6);
  prep_phase(ws, launder_p(p0), shm);
  grid.sync();
  int gx = blockIdx.x & 7, gslot = blockIdx.x >> 3;
  bool loc = false;
  unsigned lep = 0;
  {
    int* cs_ = (int*)(shm + 150024);
    if (ws == 0 && lane_id_() == 0) {
      const unsigned xcc = (unsigned)__builtin_amdgcn_s_getreg((3 << 11) | 20) & 0xFu;
      cs_[0] = (int)xcc;
      cs_[1] = (int)__hip_atomic_fetch_add(p0->xcnt + xcc, 1u, __ATOMIC_RELAXED, __HIP_MEMORY_SCOPE_AGENT);
      unsigned sp = 0, sum = 0;
      bool ok = false;
      for (;;) {
        sum = 0;
        ok = true;
        for (int j = 0; j < 16; ++j) {
          const unsigned c = __hip_atomic_load(p0->xcnt + j, __ATOMIC_RELAXED, __HIP_MEMORY_SCOPE_AGENT);
          sum += c;
          if (j < 8 ? (c != 32u) : (c != 0u)) ok = false;
        }
        if (sum == gridDim.x || ++sp > (1u << 20)) break;
        __builtin_amdgcn_s_sleep(1);
      }
      cs_[2] = (ok && sum == gridDim.x && gridDim.x == 256) ? 1 : 0;
    }
    __syncthreads();
    if (cs_[2]) { gx = cs_[0]; gslot = cs_[1]; loc = true; }
    __syncthreads();
  }
  auto seam = [&]() {
    if (loc) { ++lep; local_barrier(p0->lbar + gx * 64, lep * (gridDim.x >> 3), ws); }
    else grid.sync();
  };
  auto half = [&](const int l, const int s) __attribute__((always_inline)) {
    {
      PP p = launder_p(p0);
      const float* modl = p->mod + (long)l * 4 * 9216;
      const float* xin = (l == 0 && s == 0) ? p->x : p->out;
      norm_phase(ws, gx, gslot, xin, p->h, p->norm_g + (l * 3 + (s == 0 ? 0 : 2)) * DM, modl + (s == 0 ? 0 : 6) * DM, modl + (s == 0 ? 1 : 7) * DM);
      seam();
      p = launder_p(p0);
      {
        const u16* W = p->wt1 + (long)(l * 2 + s) * 5632 * 1024;
        u16* act = p->big;
        auto desc = [&](int pm, int pn) { return TileDesc{p->h + (long)pm * 256 * DM, DM, 64, W + (long)pn * 256 * DM, DM, DM / 64}; };
        auto epi = [&](int pm, int pn, Acc8& acc, int wr, int wc, int fr, int fq) {
#pragma unroll
          for (int ai = 0; ai < 2; ++ai)
#pragma unroll
            for (int bj = 0; bj < 2; ++bj)
#pragma unroll
              for (int m = 0; m < 4; ++m)
                {
                  float v[4];
#pragma unroll
                  for (int j = 0; j < 4; ++j) {
                    float a = acc[ai][bj][m][0][j], b = acc[ai][bj][m][1][j];
                    v[j] = a * __builtin_amdgcn_rcpf(1.f + __expf(-a)) * b;
                  }
                  const long row0 = (long)pm * 256 + ai * 128 + wr * 64 + m * 16 + fq * 4;
                  const int cole = pn * 128 + (bj * 4 + wc) * 16 + (fr & ~1);
                  store_pair_bf16(act + row0 * DFF + cole, DFF, fr & 1, v[0], v[1], v[2], v[3]);
                }
        };
        gemm_phase(ws, gx, gslot, shm, NT / 256, 5632 / 256, desc, epi);
      }
      seam();
      p = launder_p(p0);
      modl = p->mod + (long)l * 4 * 9216;
      xin = (l == 0 && s == 0) ? p->x : p->out;
      {
        const u16* W = p->wt2 + (long)(l * 2 + s) * 1024 * DFF;
        const float* gate = modl + (s == 0 ? 2 : 8) * DM;
        float* xo = p->out;
        auto desc = [&](int pm, int pn) { return TileDesc{p->big + (long)pm * 256 * DFF, DFF, 64, W + (long)pn * 256 * DFF, DFF, DFF / 64}; };
        auto epi = [&](int pm, int pn, Acc8& acc, int wr, int wc, int fr, int fq) {
          const int b = (pm * 256) >> 13;
#pragma unroll
          for (int bj = 0; bj < 2; ++bj)
#pragma unroll
            for (int n = 0; n < 2; ++n) {
              const int col = pn * 256 + bj * 128 + wc * 32 + n * 16 + fr;
              const float gv = 0.5f * gate[(long)b * 9216 + col];
#pragma unroll
              for (int ai = 0; ai < 2; ++ai)
#pragma unroll
                for (int m = 0; m < 4; ++m) {
#pragma unroll
                  for (int j = 0; j < 4; ++j) {
                    long row = (long)pm * 256 + ai * 128 + wr * 64 + m * 16 + fq * 4 + j;
                    wt32f(xo + row * DM + col, xin[row * DM + col] + gv * acc[ai][bj][m][n][j]);
                  }
                  asm volatile("" ::: "memory");
                }
            }
        };
        gemm_phase(ws, gx, gslot, shm, NT / 256, DM / 256, desc, epi);
      }
      seam();
      if (s == 0) {
        p = launder_p(p0);
        modl = p->mod + (long)l * 4 * 9216;
        norm_phase(ws, gx, gslot, p->out, p->h, p->norm_g + (l * 3 + 1) * DM, modl + 3 * DM, modl + 4 * DM);
        seam();
        if (l == 0) {
          p = launder_p(p0);
          {
            u16* uu = p->big;
            u16* vt = p->vt;
            auto desc = [&](int pm, int pn) { return TileDesc{p->h + (long)pm * 256 * DM, DM, 64, p->wtin0 + (long)pn * 256 * DM, DM, DM / 64}; };
            auto epi = [&](int pm, int pn, Acc8& acc, int wr, int wc, int fr, int fq) {
#pragma unroll
              for (int ai = 0; ai < 2; ++ai)
#pragma unroll
                for (int bj = 0; bj < 2; ++bj)
#pragma unroll
                  for (int m = 0; m < 4; ++m)
#pragma unroll
                    for (int n = 0; n < 2; ++n) {
                      const int col = pn * 256 + bj * 128 + wc * 32 + n * 16 + fr;
                      const long row0 = (long)pm * 256 + ai * 128 + wr * 64 + m * 16 + fq * 4;
                      const f32x4 v = acc[ai][bj][m][n];
                      if (col >= 2048) {
                        const int vc = col - 2048, bb = (int)(row0 >> 13), t = (int)(row0 & 8191);
                        u32x2 pk = {pack2(v[0], v[1]), pack2(v[2], v[3])};
                        wt64(vt + ((long)(bb * 8 + (vc >> 6)) * 64 + (vc & 63)) * SEQ + t, pk);
                      } else {
                        store_pair_bf16(uu + row0 * IN0 + (col & ~1), IN0, col & 1, v[0], v[1], v[2], v[3]);
                      }
                    }
            };
            gemm_phase(ws, gx, gslot, shm, NT / 256, IN0 / 256, desc, epi);
          }
          grid.sync();
          p = launder_p(p0);
          kprep0_phase(ws, p, shm);
          p = launder_p(p0);
#pragma unroll 1
          for (int it = grab(ws, p->ctr + 0, shm); it < 512;) {
            const int nx_ = grab_begin(ws, p->ctr + 0);
            lru_item<false>(ws, p, shm, it);
            it = grab_end(ws, nx_, shm);
          }
          grid.sync();
          p = launder_p(p0);
#pragma unroll 1
          for (int it = grab(ws, p->ctr + 1, shm); it < 1024;) {
            const int nx_ = grab_begin(ws, p->ctr + 1);
            moba_gate_item(ws, p, shm, it);
            it = grab_end(ws, nx_, shm);
          }
          grid.sync();
          p = launder_p(p0);
          moba_gather_phase(ws, p, shm);
          p = launder_p(p0);
#pragma unroll 1
          for (int it = grab(ws, p->ctr + 3, shm); it < 512;) {
            const int nx_ = grab_begin(ws, p->ctr + 3);
            lru_item<true>(ws, p, shm, it);
            it = grab_end(ws, nx_, shm);
          }
          grid.sync();
          p = launder_p(p0);
#pragma unroll 1
          for (int it = grab(ws, p->ctr + 4, shm); it < 1024;) {
            const int nx_ = grab_begin(ws, p->ctr + 4);
            moba_own_item(ws, p, shm, it);
            it = grab_end(ws, nx_, shm);
          }
          grid.sync();
        }
        if (l == 1) {
          p = launder_p(p0);
          {
            u16* uu = p->big;
            u16* vt = p->vt;
            auto desc = [&](int pm, int pn) { return TileDesc{p->h + (long)pm * 256 * DM, DM, 64, p->wtin1 + (long)pn * 256 * DM, DM, DM / 64}; };
            auto epi = [&](int pm, int pn, Acc8& acc, int wr, int wc, int fr, int fq) {
#pragma unroll
              for (int ai = 0; ai < 2; ++ai)
#pragma unroll
                for (int bj = 0; bj < 2; ++bj) {
                  const int c64 = (pn * 256 + bj * 128 + wc * 32) >> 6;
                  const bool isv = (c64 == 22 || c64 == 23 || c64 == 26 || c64 == 27);
#pragma unroll
                  for (int m = 0; m < 4; ++m)
#pragma unroll
                    for (int n = 0; n < 2; ++n) {
                      const int col = pn * 256 + bj * 128 + wc * 32 + n * 16 + fr;
                      const long row0 = (long)pm * 256 + ai * 128 + wr * 64 + m * 16 + fq * 4;
                      const f32x4 v = acc[ai][bj][m][n];
                      if (isv) {
                        const int bb = (int)(row0 >> 13), t = (int)(row0 & 8191);
                        const int which = c64 >= 26 ? 1 : 0, gg = c64 & 1;
                        u32x2 pk = {pack2(v[0], v[1]), pack2(v[2], v[3])};
                        wt64(vt + ((long)(which * 8 + bb * 2 + gg) * 64 + (col & 63)) * SEQ + t, pk);
                      } else if (col < IN1) {
#pragma unroll
                        for (int j = 0; j < 4; ++j) wt16(uu + (row0 + j) * IN1P + col, f2bf(v[j]));
                      }
                    }
                }
            };
            gemm_phase(ws, gx, gslot, shm, NT / 256, IN1P / 256, desc, epi);
          }
          grid.sync();
          p = launder_p(p0);
          rope1_phase(ws, p);
          p = launder_p(p0);
          {
            float* pq = p->pq;
            auto desc = [&](int pm, int pn) {
              const int kv = pm >> 4, rr = pm & 15, bg = rr >> 1, j0 = (rr & 1) * 256;
              return TileDesc{p->big + ((long)(bg >> 1) * SEQ + 16 * j0) * IN1P + 1024 + kv * 128 + (bg & 1) * 64, 16 * IN1P, IN1P,
                              p->wtcmp + (long)kv * 256 * 1024, 1024, 16};
            };
            auto epi = [&](int pm, int pn, Acc8& acc, int wr, int wc, int fr, int fq) {
#pragma unroll
              for (int ai = 0; ai < 2; ++ai)
#pragma unroll
                for (int bj = 0; bj < 2; ++bj)
#pragma unroll
                  for (int m = 0; m < 4; ++m)
#pragma unroll
                    for (int n = 0; n < 2; ++n)
#pragma unroll
                      for (int j = 0; j < 4; ++j)
                        wt32f(pq + ((long)pm * 256 + ai * 128 + wr * 64 + m * 16 + fq * 4 + j) * 256 + bj * 128 + wc * 32 + n * 16 + fr, acc[ai][bj][m][n][j]);
            };
            gemm_phase(ws, gx, gslot, shm, 32, 1, desc, epi);
          }
          seam();
          p = launder_p(p0);
          cmpfin_phase(ws, gx, gslot, p, shm);
          grid.sync();
          p = launder_p(p0);
#pragma unroll 1
          for (int it = grab(ws, p->ctr + 5, shm); it < 2048;) {
            const int nx_ = grab_begin(ws, p->ctr + 5);
            nsa_item(ws, p, shm, it);
            it = grab_end(ws, nx_, shm);
          }
          grid.sync();
        }
        {
          p = launder_p(p0);
          modl = p->mod + (long)l * 4 * 9216;
          const u16* W = l == 0 ? p->wtout0 : p->wtout1;
          const float* gate = modl + 5 * DM;
          float* xo = p->out;
          auto desc = [&](int pm, int pn) { return TileDesc{p->h + (long)pm * 256 * DM, DM, 64, W + (long)pn * 256 * DM, DM, DM / 64}; };
          auto epi = [&](int pm, int pn, Acc8& acc, int wr, int wc, int fr, int fq) {
            const int b = (pm * 256) >> 13;
#pragma unroll
            for (int bj = 0; bj < 2; ++bj)
#pragma unroll
              for (int n = 0; n < 2; ++n) {
                const int col = pn * 256 + bj * 128 + wc * 32 + n * 16 + fr;
                const float gv = gate[(long)b * 9216 + col];
#pragma unroll
                for (int ai = 0; ai < 2; ++ai)
#pragma unroll
                  for (int m = 0; m < 4; ++m) {
#pragma unroll
                    for (int j = 0; j < 4; ++j) {
                      long row = (long)pm * 256 + ai * 128 + wr * 64 + m * 16 + fq * 4 + j;
                      wt32f(xo + row * DM + col, xo[row * DM + col] + gv * acc[ai][bj][m][n][j]);
                    }
                    asm volatile("" ::: "memory");
                  }
              }
          };
          gemm_phase(ws, gx, gslot, shm, NT / 256, DM / 256, desc, epi);
          seam();
        }
      }
    }
  };
  half(0, 0);
  half(0, 1);
  half(1, 0);
  half(1, 1);
  { PP p = launder_p(p0); final_norm_phase(ws, gx, gslot, p->out, p->fng); }
}

extern "C" void kernel_launch(void* const* d_in, const int* in_sizes, int n_in, void* d_out, int out_size, void* d_ws, size_t ws_size,
                              hipStream_t stream) {
  Params p;
  memset(&p, 0, sizeof(p));
  const float** fp = (const float**)&p.x;
  for (int i = 0; i < 22; ++i) fp[i] = (const float*)d_in[i];
  p.out = (float*)d_out;
  char* ws = (char*)d_ws;
  size_t off = 0;
  auto take = [&](size_t bytes) { char* r = ws + off; off += (bytes + 255) & ~(size_t)255; return r; };
  p.wt1 = (u16*)take((size_t)4 * 5632 * 1024 * 2);
  p.wt2 = (u16*)take((size_t)4 * 1024 * DFF * 2);
  p.wtin0 = (u16*)take((size_t)IN0 * 1024 * 2);
  p.wtout0 = (u16*)take((size_t)1024 * 1024 * 2);
  p.wtin1 = (u16*)take((size_t)IN1P * 1024 * 2);
  p.wtout1 = (u16*)take((size_t)1024 * 1024 * 2);
  p.wtcmp = (u16*)take((size_t)2 * 256 * 1024 * 2);
  p.wat = (u16*)take((size_t)2 * 8 * 64 * 64 * 2);
  p.mod = (float*)take((size_t)2 * 4 * 9216 * 4);
  p.rope = (float*)take((size_t)SEQ * 16 * 4);
  p.cvec = (float*)take(2 * 128 * 4);
  p.cent = (float*)take((size_t)4 * 8 * 32 * 64 * 4);
  p.lrusum = (float*)take((size_t)4 * 128 * 512 * 2 * 4);
  p.pq = (float*)take((size_t)2 * 4096 * 256 * 4);
  p.h = (u16*)take((size_t)NT * 1024 * 2);
  p.big = (u16*)take((size_t)NT * DFF * 2);
  p.vt = (u16*)take((size_t)NT * 512 * 2);
  p.kcmp = (u16*)take((size_t)8 * 512 * 64 * 2);
  p.vcmpT = (u16*)take((size_t)8 * 512 * 64 * 2);
  p.mcnt = (unsigned*)take(1024 * 4);
  p.ctr = (unsigned*)take(64 * 4);
  p.xcnt = (unsigned*)take(64 * 4);
  p.lbar = (unsigned*)take(8 * 64 * 4);
  p.mlist = (unsigned*)take((size_t)32 * 126976 * 4);
  p.part = (u16*)take((size_t)NT * 8 * 3 * 144);
  int nj = 0, t0 = 0;
  auto add = [&](const float* src, u16* dst, int K, int N, int ldn, int perm, int npad) {
    TJob& j = p.jobs[nj++];
    j.src = src; j.dst = dst; j.K = K; j.N = N; j.ldn = ldn; j.perm = perm; j.tile0 = t0; j.ntn = npad / 64;
    t0 += (K / 64) * ((npad / 64 + 3) / 4);
  };
  for (int i = 0; i < 4; ++i) add(p.ffn_w1 + (size_t)i * 1024 * 5632, p.wt1 + (size_t)i * 5632 * 1024, 1024, 5632, 5632, 1, 5632);
  for (int i = 0; i < 4; ++i) add(p.ffn_w2 + (size_t)i * DFF * 1024, p.wt2 + (size_t)i * 1024 * DFF, DFF, 1024, 1024, 0, 1024);
  add(p.mix0_in_w, p.wtin0, 1024, IN0, IN0, 0, IN0);
  add(p.mix0_out_w, p.wtout0, 1024, 1024, 1024, 0, 1024);
  add(p.mix1_in_w, p.wtin1, 1024, IN1, IN1, 0, IN1P);
  add(p.mix1_out_w, p.wtout1, 1024, 1024, 1024, 0, 1024);
  for (int kv = 0; kv < 2; ++kv)
    for (int hf = 0; hf < 2; ++hf)
      add(p.cmp_w1 + ((size_t)kv * 2048 + hf * 1024) * 128, p.wtcmp + ((size_t)kv * 256 + hf * 128) * 1024, 1024, 128, 128, 0, 128);
  for (int n = 0; n < 8; ++n) add(p.wa + (size_t)n * 4096, p.wat + (size_t)n * 4096, 64, 64, 64, 0, 64);
  for (int n = 0; n < 8; ++n) add(p.wx + (size_t)n * 4096, p.wat + (size_t)(8 + n) * 4096, 64, 64, 64, 0, 64);
  p.njobs = nj;
  p.ntr_tiles = t0;

  static int grid_blocks = 0;
  if (!grid_blocks) {
    int dev = 0, cus = 0, per_cu = 0;
    (void)hipGetDevice(&dev);
    (void)hipDeviceGetAttribute(&cus, hipDeviceAttributeMultiprocessorCount, dev);
    (void)hipOccupancyMaxActiveBlocksPerMultiprocessor(&per_cu, fwd_kernel, NTHR, 0);
    if (per_cu < 1) per_cu = 1;
    grid_blocks = cus * 1;
  }
  void* args[] = {&p};
  hipError_t e = hipLaunchCooperativeKernel((void*)fwd_kernel, dim3(grid_blocks), dim3(NTHR), args, 0, stream);
  if (e != hipSuccess) fprintf(stderr, "cooperative launch failed: %s (grid %d)\n", hipGetErrorString(e), grid_blocks);
}
```

```cpp
#include <hip/hip_runtime.h>
#include <hip/hip_cooperative_groups.h>
#include <stdint.h>
#include <stdio.h>
#include <string.h>
namespace cg = cooperative_groups;

typedef unsigned short u16;
typedef __attribute__((ext_vector_type(8))) short bf16x8;
typedef __attribute__((ext_vector_type(4))) short s16x4;
typedef __attribute__((ext_vector_type(4))) float f32x4;
typedef __attribute__((ext_vector_type(16))) float f32x16;
typedef __attribute__((ext_vector_type(4))) int i32x4;
typedef __attribute__((ext_vector_type(4))) unsigned u32x4;
typedef __attribute__((ext_vector_type(2))) unsigned u32x2;

#define DI __device__ __forceinline__
#define MFMA32(a, b, c) __builtin_amdgcn_mfma_f32_32x32x16_bf16((a), (b), (c), 0, 0, 0)
#define MFMA16(a, b, c) __builtin_amdgcn_mfma_f32_16x16x32_bf16((a), (b), (c), 0, 0, 0)

constexpr int NB = 4, SEQ = 8192, DM = 1024, NT = NB * SEQ, DFF = 2816;
constexpr int IN0 = 2560, IN1 = 1840, IN1P = 2048;
constexpr int NTHR = 512;
constexpr int NJOBS = 32;

struct TJob { const float* src; u16* dst; int K, N, ldn, perm, tile0, ntn; };

struct Params {
  const float *x, *c, *mod_w, *mod_b, *norm_g, *ffn_w1, *ffn_w2, *mix0_in_w, *conv_w, *conv_b, *wa, *ba, *wx, *bx, *lam,
      *mix0_out_w, *mix1_in_w, *cmp_pos, *cmp_w1, *cmp_w2, *mix1_out_w, *fng;
  float* out;
  u16 *wt1, *wt2, *wtin0, *wtout0, *wtin1, *wtout1, *wtcmp, *wat;
  float *mod, *rope, *cvec, *cent, *lrusum, *pq;
  u16 *h, *big, *vt, *kcmp, *vcmpT;
  unsigned *mcnt, *mlist, *ctr, *xcnt, *lbar;
  u16* part;
  TJob jobs[NJOBS];
  int njobs, ntr_tiles;
};

typedef const __attribute__((address_space(4))) Params* PP;
DI PP launder_p(PP p) { asm volatile("" : "+s"(p)); return p; }

typedef __attribute__((ext_vector_type(2))) float f32x2_;
typedef __attribute__((ext_vector_type(2))) __bf16 bf16x2_;
DI uint32_t pack2(float a, float b) {
  f32x2_ v = {a, b};
  return __builtin_bit_cast(uint32_t, __builtin_convertvector(v, bf16x2_));
}
DI u16 f2bf(float f) { return (u16)(pack2(f, 0.f) & 0xffffu); }
DI float bf2f(u16 h) { return __uint_as_float(((uint32_t)h) << 16); }
DI float bflo(uint32_t w) { return __uint_as_float(w << 16); }
DI float bfhi(uint32_t w) { return __uint_as_float(w & 0xffff0000u); }

DI void wt16(u16* p, u16 v) { *p = v; }
DI void wt32u(unsigned* p, unsigned v) { *p = v; }
DI void wt32f(float* p, float v) { *p = v; }
DI void wt64(void* p, u32x2 v) { *(u32x2*)p = v; }
DI void wt128(void* p, u32x4 v) { *(u32x4*)p = v; }
DI bf16x8 pack8(float a0, float a1, float a2, float a3, float a4, float a5, float a6, float a7) {
  u32x4 p;
  asm volatile("v_cvt_pk_bf16_f32 %0, %4, %5\n\tv_cvt_pk_bf16_f32 %1, %6, %7\n\tv_cvt_pk_bf16_f32 %2, %8, %9\n\tv_cvt_pk_bf16_f32 %3, %10, %11\n\ts_nop 1"
               : "=&v"(p[0]), "=&v"(p[1]), "=&v"(p[2]), "=&v"(p[3])
               : "v"(a0), "v"(a1), "v"(a2), "v"(a3), "v"(a4), "v"(a5), "v"(a6), "v"(a7));
  return __builtin_bit_cast(bf16x8, p);
}
DI int launder(int v) { asm volatile("" : "+v"(v)); return v; }
DI int lane_id_() { int l = __builtin_amdgcn_mbcnt_hi(-1, __builtin_amdgcn_mbcnt_lo(-1, 0)); asm volatile("" : "+v"(l)); return l; }
DI int grab_begin(int ws, unsigned* ctr) {
  int v = 0;
  if (ws == 0 && lane_id_() == 0) v = (int)atomicAdd(ctr, 1u);
  return v;
}
DI int grab_end(int ws, int v, char* shm) {
  int* slot = (int*)(shm + 150016);
  __syncthreads();
  if (ws == 0 && lane_id_() == 0) *slot = v;
  __syncthreads();
  return *slot;
}
DI int grab(int ws, unsigned* ctr, char* shm) { return grab_end(ws, grab_begin(ws, ctr), shm); }
DI int mytid(int ws) { return launder(ws * 64 + lane_id_()); }
template <int M> DI int shxi(int v) {
  if (M < 32) return __builtin_amdgcn_ds_swizzle(v, (M << 10) | 0x1f);
  auto r = __builtin_amdgcn_permlane32_swap((unsigned)v, (unsigned)v, false, false);
  return (int)(r[0] ^ r[1] ^ (unsigned)v);
}
DI float sum8(float v) {
  v += __int_as_float(__builtin_amdgcn_update_dpp(0, __float_as_int(v), 0xB1, 0xF, 0xF, true));
  v += __int_as_float(__builtin_amdgcn_update_dpp(0, __float_as_int(v), 0x4E, 0xF, 0xF, true));
  v += __int_as_float(__builtin_amdgcn_update_dpp(0, __float_as_int(v), 0x141, 0xF, 0xF, true));
  return v;
}
DI float dppx1(float v) { return __int_as_float(__builtin_amdgcn_update_dpp(0, __float_as_int(v), 0xB1, 0xF, 0xF, true)); }
DI void store_pair_bf16(u16* base_even, long ld, bool odd, float v0, float v1, float v2, float v3) {
  const float sx = odd ? v0 : v2, sy = odd ? v1 : v3;
  const float rx = dppx1(sx), ry = dppx1(sy);
  const uint32_t p0 = odd ? pack2(rx, v2) : pack2(v0, rx);
  const uint32_t p1 = odd ? pack2(ry, v3) : pack2(v1, ry);
  u16* q = base_even + (odd ? 2 * ld : 0);
  *(uint32_t*)q = p0;
  *(uint32_t*)(q + ld) = p1;
}
DI void rmw_pair_f32(float* xo_even, const float* xi_even, long ld, bool odd, float v0, float v1, float v2, float v3) {
  const float sx = odd ? v0 : v2, sy = odd ? v1 : v3;
  const float rx = dppx1(sx), ry = dppx1(sy);
  const long off = odd ? 2 * ld : 0;
  const float2 a0 = *(const float2*)(xi_even + off), a1 = *(const float2*)(xi_even + off + ld);
  float2 o0, o1;
  if (odd) { o0 = float2{a0.x + rx, a0.y + v2}; o1 = float2{a1.x + ry, a1.y + v3}; }
  else     { o0 = float2{a0.x + v0, a0.y + rx}; o1 = float2{a1.x + v1, a1.y + ry}; }
  *(float2*)(xo_even + off) = o0;
  *(float2*)(xo_even + off + ld) = o1;
}
DI float xmax32(float v) {
  auto r = __builtin_amdgcn_permlane32_swap(__float_as_uint(v), __float_as_uint(v), false, false);
  return fmaxf(__uint_as_float(r[0]), __uint_as_float(r[1]));
}
DI float xsum32(float v) {
  auto r = __builtin_amdgcn_permlane32_swap(__float_as_uint(v), __float_as_uint(v), false, false);
  return __uint_as_float(r[0]) + __uint_as_float(r[1]);
}
template <int M> DI float shxf(float v) { return __int_as_float(shxi<M>(__float_as_int(v))); }
DI float sigmoidf_(float x) { return __builtin_amdgcn_rcpf(1.f + __expf(-x)); }
DI float gelu_tanh(float x) {
  const float z = 0.7978845608028654f * (x + 0.044715f * x * x * x);
  const float th = 1.f - 2.f * __builtin_amdgcn_rcpf(1.f + __expf(2.f * z));
  return 0.5f * x * (1.f + th);
}

template <int KS> DI int lds_byte(int r, int c) {
  int st = (r >> 4) * KS + (c >> 5), ob = (r & 15) * 64 + (c & 31) * 2;
  return st * 1024 + (ob ^ (((ob >> 9) & 1) << 5));
}
template <int KS> DI void stage_rc(int b, int& R, int& C) {
  int st = b >> 10, sb = b & 1023, swz = sb ^ (((sb >> 9) & 1) << 5);
  R = (st / KS) * 16 + swz / 64;
  C = (st % KS) * 32 + (swz % 64) / 2;
}
#define WAIT_V(n) asm volatile("s_waitcnt vmcnt(%0)" ::"n"(n) : "memory")

struct TileDesc { const u16* a; long lda, kts; const u16* b; long ldb; int nt; };

typedef f32x4 Acc8[2][2][4][2];
template <class Epi>
DI void gemm_tile(int ws, char* shmc, const TileDesc& td, Epi& epi, int pm, int pn, bool first, bool has_next, const TileDesc& tdn) {
  constexpr int BK = 64, HALF = 128, HT = HALF * BK;
  u16* shm = (u16*)shmc;
  const int tid = mytid(ws), wid = tid >> 6, lane = tid & 63, wr = wid >> 2, wc = wid & 3, fr = lane & 15, fq = lane >> 4;
  const u16* ABASE = td.a;
  const u16* BBASE = td.b;
  const long lda = td.lda, kts = td.kts, ldb = td.ldb;
  const int nt = td.nt;
#define SA(b, h) (shm + ((b) * 2 + (h)) * HT)
#define SB(b, h) (shm + (4 + (b) * 2 + (h)) * HT)
  unsigned voffA, voffB;
  {
    int r0_, c0_;
    stage_rc<2>(tid * 16, r0_, c0_);
    voffA = (unsigned)(r0_ * (int)lda + c0_);
    voffB = (unsigned)(r0_ * (int)ldb + c0_);
  }
#define STAGE_A(P, hf, kt)                                                                                     \
  do {                                                                                                         \
    _Pragma("unroll") for (int _i = 0; _i < 2; ++_i)                                                           \
      __builtin_amdgcn_global_load_lds((const unsigned*)((ABASE + (long)((hf) * HALF + 64 * _i) * lda + (long)(kt) * kts) + voffA), \
                                       (__attribute__((address_space(3))) unsigned*)((char*)(P) + tid * 16 + _i * 8192), 16, 0, 0); \
  } while (0)
#define STAGE_B(P, hf, kt)                                                                                     \
  do {                                                                                                         \
    _Pragma("unroll") for (int _i = 0; _i < 2; ++_i)                                                           \
      __builtin_amdgcn_global_load_lds((const unsigned*)((BBASE + (long)((hf) * HALF + 64 * _i) * ldb + (long)(kt) * BK) + voffB), \
                                       (__attribute__((address_space(3))) unsigned*)((char*)(P) + tid * 16 + _i * 8192), 16, 0, 0); \
  } while (0)
#define LDA_(dst, b, h)                                    \
  _Pragma("unroll") for (int m = 0; m < 4; ++m)            \
  _Pragma("unroll") for (int k = 0; k < 2; ++k)            \
      dst[m][k] = *(const bf16x8*)((const char*)SA(b, h) + lds_byte<2>(wr * 64 + m * 16 + fr, k * 32 + fq * 8))
#define LDB_(dst, b, h)                                    \
  _Pragma("unroll") for (int n = 0; n < 2; ++n)            \
  _Pragma("unroll") for (int k = 0; k < 2; ++k)            \
      dst[n][k] = *(const bf16x8*)((const char*)SB(b, h) + lds_byte<2>(wc * 32 + n * 16 + fr, k * 32 + fq * 8))
#define MMA_(ai, bj, AT, BT)                                                           \
  do {                                                                                 \
    __builtin_amdgcn_s_setprio(1);                                                     \
    _Pragma("unroll") for (int m = 0; m < 4; ++m)                                      \
    _Pragma("unroll") for (int n = 0; n < 2; ++n)                                      \
    _Pragma("unroll") for (int k = 0; k < 2; ++k)                                      \
        acc[ai][bj][m][n] = MFMA16(AT[m][k], BT[n][k], acc[ai][bj][m][n]);             \
    __builtin_amdgcn_s_setprio(0);                                                     \
  } while (0)
#define WV(n) asm volatile("s_waitcnt vmcnt(" #n ")" ::: "memory")
#define WL(n) asm volatile("s_waitcnt lgkmcnt(" #n ")" ::: "memory")
#define BAR __builtin_amdgcn_s_barrier()
#define SCHED __builtin_amdgcn_sched_barrier(0)
  Acc8 acc;
#pragma unroll
  for (int a = 0; a < 2; ++a)
#pragma unroll
    for (int b = 0; b < 2; ++b)
#pragma unroll
      for (int m = 0; m < 4; ++m)
#pragma unroll
        for (int n = 0; n < 2; ++n) acc[a][b][m][n] = f32x4{0.f, 0.f, 0.f, 0.f};
  bf16x8 At[4][2], B0[2][2], B1[2][2];
  if (first) {
    STAGE_B(SB(0, 0), 0, 0); STAGE_A(SA(0, 0), 0, 0);
    STAGE_B(SB(0, 1), 1, 0); STAGE_A(SA(0, 1), 1, 0);
  }
  if (wr == 1) BAR;
  WV(4); BAR;
  STAGE_B(SB(1, 0), 0, 1); STAGE_A(SA(1, 0), 0, 1); STAGE_B(SB(1, 1), 1, 1);
  WV(6); BAR;
  for (int t = 0; t < nt - 2; t += 2) {
    LDB_(B0, 0, 0); SCHED; LDA_(At, 0, 0); STAGE_A(SA(1, 1), 1, t + 1);
    WL(8); BAR; WL(0); MMA_(0, 0, At, B0); BAR; SCHED;
    LDB_(B1, 0, 1); STAGE_B(SB(0, 0), 0, t + 2);
    BAR; WL(0); MMA_(0, 1, At, B1); BAR;
    LDA_(At, 0, 1); STAGE_A(SA(0, 0), 0, t + 2);
    BAR; WL(0); MMA_(1, 0, At, B0); BAR; SCHED;
    STAGE_B(SB(0, 1), 1, t + 2);
    WV(6); BAR; MMA_(1, 1, At, B1); BAR;
    LDB_(B0, 1, 0); SCHED; LDA_(At, 1, 0); STAGE_A(SA(0, 1), 1, t + 2);
    WL(8); BAR; WL(0); MMA_(0, 0, At, B0); BAR; SCHED;
    LDB_(B1, 1, 1); STAGE_B(SB(1, 0), 0, t + 3);
    BAR; WL(0); MMA_(0, 1, At, B1); BAR;
    LDA_(At, 1, 1); STAGE_A(SA(1, 0), 0, t + 3);
    BAR; WL(0); MMA_(1, 0, At, B0); BAR; SCHED;
    STAGE_B(SB(1, 1), 1, t + 3);
    WV(6); BAR; MMA_(1, 1, At, B1); BAR;
  }
  { LDB_(B0, 0, 0); LDA_(At, 0, 0); STAGE_A(SA(1, 1), 1, nt - 1);
    BAR; WL(0); MMA_(0, 0, At, B0); BAR;
    LDB_(B1, 0, 1); BAR; WL(0); MMA_(0, 1, At, B1); BAR;
    LDA_(At, 0, 1); WV(4); BAR; WL(0); MMA_(1, 0, At, B0); MMA_(1, 1, At, B1); BAR; }
  { LDB_(B0, 1, 0); LDA_(At, 1, 0); WV(2); BAR; WL(0); MMA_(0, 0, At, B0); BAR;
    LDB_(B1, 1, 1); WV(0); BAR; WL(0); MMA_(0, 1, At, B1); BAR;
    LDA_(At, 1, 1); BAR; WL(0); MMA_(1, 0, At, B0); MMA_(1, 1, At, B1); BAR; }
  if (wr == 0) BAR;
  if (has_next) {
    ABASE = tdn.a;
    BBASE = tdn.b;
    STAGE_B(SB(0, 0), 0, 0); STAGE_A(SA(0, 0), 0, 0);
    STAGE_B(SB(0, 1), 1, 0); STAGE_A(SA(0, 1), 1, 0);
  }
  epi(pm, pn, acc, wr, wc, fr, fq);
  asm volatile("s_waitcnt vmcnt(0)" ::: "memory");
  __syncthreads();
#undef SA
#undef SB
#undef STAGE_A
#undef STAGE_B
#undef LDA_
#undef LDB_
#undef MMA_
#undef WV
#undef WL
#undef BAR
#undef SCHED
}

template <class Desc, class Epi>
DI void gemm_phase(int ws, int gx, int gslot, char* shm, int nM, int nN, Desc desc, Epi epi) {
  const int ntiles = nM * nN;
  const int G = gridDim.x, bid = blockIdx.x;
  const bool xcdmap = (G % 8 == 0) && (ntiles % 8 == 0);
  const int per = ntiles / 8, slots = G / 8;
  auto tile_at = [&](int i, int& pm, int& pn) -> bool {
    int t;
    if (xcdmap) {
      int lt = gslot + slots * i;
      if (lt >= per) return false;
      t = gx * per + lt;
    } else {
      t = bid + G * i;
      if (t >= ntiles) return false;
    }
    const int WGM = 8;
    int nig = WGM * nN, gid = t / nig, fm = gid * WGM, gsz = min(nM - fm, WGM);
    pm = fm + ((t % nig) % gsz);
    pn = (t % nig) / gsz;
    return true;
  };
  __syncthreads();
  int pm, pn;
  if (!tile_at(0, pm, pn)) return;
  TileDesc td = desc(pm, pn);
  bool first = true;
  for (int i = 0;; ++i) {
    int pmn = 0, pnn = 0;
    const bool more = tile_at(i + 1, pmn, pnn);
    TileDesc tdn = td;
    if (more) tdn = desc(pmn, pnn);
    gemm_tile(ws, shm, td, epi, pm, pn, first, more, tdn);
    if (!more) break;
    td = tdn; pm = pmn; pn = pnn; first = false;
  }
}

DI float wave_sum(float v) {
  v += shxf<32>(v); v += shxf<16>(v); v += shxf<8>(v); v += shxf<4>(v); v += shxf<2>(v); v += shxf<1>(v);
  return v;
}

DI void norm_phase(int ws, int gx, int gslot, const float* __restrict__ x, u16* __restrict__ h, const float* __restrict__ g, const float* __restrict__ shift,
                   const float* __restrict__ scale  ) {
  const int tid_ = mytid(ws), wid = tid_ >> 6, lane = tid_ & 63;
  const int rbase = gx * (NT / 8) + gslot * (NT / 8 / (gridDim.x / 8)) + wid * (NT / 8 / (gridDim.x / 8) / 8);
  const int rcnt = NT / 8 / (gridDim.x / 8) / 8;
  for (int row = rbase; row < rbase + rcnt; ++row) {
    const float4* xr = (const float4*)(x + (long)row * DM);
    float4 v[4];
    float ss = 0.f;
#pragma unroll
    for (int i = 0; i < 4; ++i) {
      v[i] = xr[lane + 64 * i];
      ss += v[i].x * v[i].x + v[i].y * v[i].y + v[i].z * v[i].z + v[i].w * v[i].w;
    }
    ss = wave_sum(ss);
    const float rs = rsqrtf(ss * (1.f / DM) + 1e-6f);
    const int b = row >> 13;
#pragma unroll
    for (int i = 0; i < 4; ++i) {
      const int c4 = lane + 64 * i;
      const float4 gg = ((const float4*)g)[c4];
      const float4 sc = ((const float4*)(scale + (long)b * 9216))[c4];
      const float4 sh = ((const float4*)(shift + (long)b * 9216))[c4];
      float y0 = v[i].x * rs * gg.x * (1.f + sc.x) + sh.x;
      float y1 = v[i].y * rs * gg.y * (1.f + sc.y) + sh.y;
      float y2 = v[i].z * rs * gg.z * (1.f + sc.z) + sh.z;
      float y3 = v[i].w * rs * gg.w * (1.f + sc.w) + sh.w;
      u32x2 pk = {pack2(y0, y1), pack2(y2, y3)};
      wt64(h + (long)row * DM + c4 * 4, pk);
    }
  }
}

DI void final_norm_phase(int ws, int gx, int gslot, float* __restrict__ x, const float* __restrict__ g) {
  const int tid_ = mytid(ws), wid = tid_ >> 6, lane = tid_ & 63;
  const int rbase = gx * (NT / 8) + gslot * (NT / 8 / (gridDim.x / 8)) + wid * (NT / 8 / (gridDim.x / 8) / 8);
  const int rcnt = NT / 8 / (gridDim.x / 8) / 8;
  for (int row = rbase; row < rbase + rcnt; ++row) {
    float4* xr = (float4*)(x + (long)row * DM);
    float4 v[4];
    float ss = 0.f;
#pragma unroll
    for (int i = 0; i < 4; ++i) {
      v[i] = xr[lane + 64 * i];
      ss += v[i].x * v[i].x + v[i].y * v[i].y + v[i].z * v[i].z + v[i].w * v[i].w;
    }
    ss = wave_sum(ss);
    const float rs = rsqrtf(ss * (1.f / DM) + 1e-6f);
#pragma unroll
    for (int i = 0; i < 4; ++i) {
      const int c4 = lane + 64 * i;
      const float4 gg = ((const float4*)g)[c4];
      float4 o = {v[i].x * rs * gg.x, v[i].y * rs * gg.y, v[i].z * rs * gg.z, v[i].w * rs * gg.w};
      xr[c4] = o;
    }
  }
}

DI void prep_phase(int ws, PP p, char* shm) {
  const int tid = mytid(ws);
  float* fs = (float*)shm;
  const int n_tr = p->ntr_tiles;
  const int n_mod = 2 * 144;
  const int n_cv = 8;
  const int n_rope = 128;
  const int n_misc = 1;
  const int total = n_tr + n_mod + n_cv + n_rope + n_misc;
  for (int it = blockIdx.x; it < total; it += gridDim.x) {
    if (it < n_tr) {
      int j = 0;
      for (int q = 1; q < p->njobs; ++q)
        if (it >= p->jobs[q].tile0) j = q;
      TJob jb;
      jb.src = p->jobs[j].src; jb.dst = p->jobs[j].dst; jb.K = p->jobs[j].K; jb.N = p->jobs[j].N; jb.ldn = p->jobs[j].ldn; jb.perm = p->jobs[j].perm; jb.tile0 = p->jobs[j].tile0; jb.ntn = p->jobs[j].ntn;
      const int lt = it - jb.tile0;
      const int ngn = (jb.ntn + 3) >> 2;
      const int tk = lt / ngn, tg4 = lt % ngn;
      const int k0 = tk * 64;
      float4 v[4][2];
#pragma unroll
      for (int u = 0; u < 4; ++u)
#pragma unroll
        for (int rep = 0; rep < 2; ++rep) {
          const int idx = tid + rep * 512, r = idx >> 4, c4 = idx & 15;
          const int n = (tg4 * 4 + u) * 64 + c4 * 4;
          v[u][rep] = float4{0.f, 0.f, 0.f, 0.f};
          if (tg4 * 4 + u < jb.ntn && n < jb.N) v[u][rep] = *(const float4*)(jb.src + (long)(k0 + r) * jb.ldn + n);
        }
#pragma unroll
      for (int u = 0; u < 4; ++u)
#pragma unroll
        for (int rep = 0; rep < 2; ++rep) {
          const int idx = tid + rep * 512, r = idx >> 4, c4 = idx & 15;
          float* f = fs + u * (64 * 65) + r * 65 + c4 * 4;
          f[0] = v[u][rep].x; f[1] = v[u][rep].y; f[2] = v[u][rep].z; f[3] = v[u][rep].w;
        }
      __syncthreads();
#pragma unroll
      for (int u = 0; u < 4; ++u) {
        if (tg4 * 4 + u < jb.ntn) {
          const int n = tid >> 3, ks = tid & 7;
          float e[8];
#pragma unroll
          for (int q = 0; q < 8; ++q) e[q] = fs[u * (64 * 65) + (ks * 8 + q) * 65 + n];
          int ng = (tg4 * 4 + u) * 64 + n, drow = ng;
          if (jb.perm == 1) {
            int isb = ng >= DFF ? 1 : 0, jj = ng - isb * DFF;
            drow = (jj >> 4) * 32 + isb * 16 + (jj & 15);
          }
          u32x4 pk = {pack2(e[0], e[1]), pack2(e[2], e[3]), pack2(e[4], e[5]), pack2(e[6], e[7])};
          wt128(jb.dst + (long)drow * jb.K + k0 + ks * 8, pk);
        }
      }
      __syncthreads();
    } else if (it < n_tr + n_mod) {
      const int q = it - n_tr, l = q / 144, cg0 = (q % 144) * 64;
      for (int i = tid; i < 4096; i += NTHR) {
        float cv = p->c[i];
        fs[i] = cv / (1.f + __expf(-cv));
      }
      __syncthreads();
      const int col = tid & 63, kg = tid >> 6;
      const float* w = p->mod_w + (long)l * DM * 9216 + cg0 + col;
      float a0 = 0.f, a1 = 0.f, a2 = 0.f, a3 = 0.f;
#pragma unroll 16
      for (int k = kg * 128; k < kg * 128 + 128; ++k) {
        float wv = w[(long)k * 9216];
        a0 += fs[k] * wv;
        a1 += fs[1024 + k] * wv;
        a2 += fs[2048 + k] * wv;
        a3 += fs[3072 + k] * wv;
      }
      __syncthreads();
      float* red = fs;
      red[(kg * 4 + 0) * 64 + col] = a0;
      red[(kg * 4 + 1) * 64 + col] = a1;
      red[(kg * 4 + 2) * 64 + col] = a2;
      red[(kg * 4 + 3) * 64 + col] = a3;
      __syncthreads();
      if (tid < 256) {
        int b = tid >> 6;
        float s = 0.f;
#pragma unroll
        for (int g = 0; g < 8; ++g) s += red[(g * 4 + b) * 64 + col];
        wt32f(p->mod + ((long)l * 4 + b) * 9216 + cg0 + col, s + p->mod_b[(long)l * 9216 + cg0 + col]);
      }
      __syncthreads();
    } else if (it < n_tr + n_mod + n_cv) {
      const int q = it - n_tr - n_mod, kv = q >> 2, n = (q & 3) * 32 + (tid & 31), kg = tid >> 5;
      const float* w1 = p->cmp_w1 + (long)kv * 2048 * 128;
      const float* pe = p->cmp_pos + (long)kv * 2048;
      float a = 0.f;
      for (int k = kg * 128; k < kg * 128 + 128; ++k) a += pe[k] * w1[(long)k * 128 + n];
      fs[kg * 32 + (tid & 31)] = a;
      __syncthreads();
      if (tid < 32) {
        float s = 0.f;
        for (int g = 0; g < 16; ++g) s += fs[g * 32 + tid];
        p->cvec[kv * 128 + (q & 3) * 32 + tid] = s;
      }
      __syncthreads();
    } else if (it < n_tr + n_mod + n_cv + n_rope) {
      const int q = it - n_tr - n_mod - n_cv;
      const int e = q * 512 + tid, pos = e >> 3, i = e & 7;
      const float freq = powf(500000.f, -(float)i * 0.125f);
      const float angf = (float)pos * freq;
      const double ang = (double)angf;
      const double n = rint(ang * 0.15915494309189535);
      double r = fma(-n, 6.283185307179586, ang);
      r = fma(-n, 2.4492935982947064e-16, r);
      const float rf = (float)r;
      p->rope[pos * 16 + i] = cosf(rf);
      p->rope[pos * 16 + 8 + i] = sinf(rf);
    } else {
      if (tid < 512) {
        int bg = tid >> 6, d = tid & 63;
        p->kcmp[((long)bg * 512 + 511) * 64 + d] = 0;
        p->vcmpT[((long)bg * 64 + d) * 512 + 511] = 0;
        p->mcnt[tid] = 0u;
        p->mcnt[512 + tid] = 0u;
        if (tid < 64) { p->ctr[tid] = 0u; p->xcnt[tid] = 0u; }
        p->lbar[tid] = 0u;
      }
    }
  }
}

constexpr int KVS = 72;
constexpr int KVT = 64 * KVS;
constexpr float SCL2 = 0.125f * 1.4426950408889634f;

DI void qk_tile(const u16* Ks, const bf16x8* qf, f32x16* s, int rl, int hh) {
#pragma unroll
  for (int kb = 0; kb < 2; ++kb) {
#pragma unroll
    for (int i = 0; i < 16; ++i) s[kb][i] = 0.f;
#pragma unroll
    for (int ks = 0; ks < 4; ++ks) {
      bf16x8 a = *(const bf16x8*)(Ks + (kb * 32 + rl) * KVS + ks * 16 + hh * 8);
      s[kb] = MFMA32(a, qf[ks], s[kb]);
    }
  }
}
DI void pv_tile(const u16* Vs, const f32x16* s, f32x16* o, int rl, int hh) {
#pragma unroll
  for (int kk = 0; kk < 4; ++kk) {
    const int kb = kk >> 1, i0 = 8 * (kk & 1);
    bf16x8 pf = pack8(s[kb][i0], s[kb][i0 + 1], s[kb][i0 + 2], s[kb][i0 + 3], s[kb][i0 + 4], s[kb][i0 + 5], s[kb][i0 + 6], s[kb][i0 + 7]);
#pragma unroll
    for (int db = 0; db < 2; ++db) {
      const u16* vp = Vs + (db * 32 + rl) * KVS + kk * 16 + hh * 4;
      s16x4 lo = *(const s16x4*)vp, hi = *(const s16x4*)(vp + 8);
      bf16x8 a = __builtin_shufflevector(lo, hi, 0, 1, 2, 3, 4, 5, 6, 7);
      o[db] = MFMA32(a, pf, o[db]);
    }
  }
}
DI float fexp2(float x) { return __builtin_amdgcn_exp2f(x); }
template <int MODE>
DI void osm(f32x16* s, uint32_t vm, float& m, float& l, f32x16* o) {
  float mx = -1e30f;
#pragma unroll
  for (int kb = 0; kb < 2; ++kb)
#pragma unroll
    for (int i = 0; i < 16; ++i) {
      if (MODE == 2) s[kb][i] = ((vm >> (kb * 16 + i)) & 1u) ? s[kb][i] : -1e30f;
      mx = fmaxf(mx, s[kb][i]);
    }
  mx *= SCL2;
  if (MODE == 1) mx = vm ? mx : -1e30f;
  mx = xmax32(mx);
  const float mn = fmaxf(m, mx);
  const float alpha = fexp2(m - mn);
  const bool rowok = (MODE == 1) ? (vm != 0u) : true;
  const float mu = (rowok && mn > -1e29f) ? mn : 1e30f;
  float rs = 0.f;
#pragma unroll
  for (int kb = 0; kb < 2; ++kb)
#pragma unroll
    for (int i = 0; i < 16; ++i) {
      const float pv = fexp2(__builtin_fmaf(s[kb][i], SCL2, -mu));
      s[kb][i] = pv;
      rs += pv;
    }
  rs = xsum32(rs);
  l = l * alpha + rs;
  if (__ballot(mn > m) != 0ull) {
#pragma unroll
    for (int db = 0; db < 2; ++db)
#pragma unroll
      for (int i = 0; i < 16; ++i) o[db][i] *= alpha;
  }
  m = mn;
}
DI void online_softmax(f32x16* s, uint32_t vm, float& m, float& l, f32x16* o) {
  const unsigned long long ball = __ballot(vm == 0xffffffffu), bnone = __ballot(vm == 0u);
  if (ball == ~0ull) osm<0>(s, vm, m, l, o);
  else if ((ball | bnone) == ~0ull) osm<1>(s, vm, m, l, o);
  else osm<2>(s, vm, m, l, o);
}
DI uint32_t range_mask(int kpos0, int lo, int hi, int hh) {
  if (kpos0 >= lo && kpos0 + 63 <= hi) return 0xffffffffu;
  if (kpos0 > hi || kpos0 + 63 < lo) return 0u;
  uint32_t vm = 0;
#pragma unroll
  for (int kb = 0; kb < 2; ++kb)
#pragma unroll
    for (int i = 0; i < 16; ++i) {
      int kp = kpos0 + kb * 32 + hh * 4 + (i & 3) + 8 * (i >> 2);
      vm |= (kp >= lo && kp <= hi) ? (1u << (kb * 16 + i)) : 0u;
    }
  return vm;
}

struct KVRegs { u32x4 k, v; };
DI void kv_issue(KVRegs& r, const u16* kptr, long ldk, const u16* vptr, long ldv, int tid) {
  const int row = tid >> 3, seg = tid & 7;
  r.k = *(const u32x4*)(kptr + (long)row * ldk + seg * 8);
  r.v = *(const u32x4*)(vptr + (long)row * ldv + seg * 8);
}
DI void kv_write(const KVRegs& r, u16* Ks, u16* Vs, int tid) {
  const int row = tid >> 3, seg = tid & 7;
  *(u32x4*)(Ks + row * KVS + seg * 8) = r.k;
  *(u32x4*)(Vs + row * KVS + seg * 8) = r.v;
}
template <class TF, class BODY>
DI void kv_loop(u16* kvb, int ntiles, int tid, TF tf, BODY body) {
  KVRegs r;
  const u16 *kp, *vp;
  long ldk, ldv;
  __syncthreads();
  if (ntiles > 0) {
    tf(0, kp, ldk, vp, ldv);
    kv_issue(r, kp, ldk, vp, ldv, tid);
    kv_write(r, kvb, kvb + KVT, tid);
  }
  __syncthreads();
  for (int i = 0; i < ntiles; ++i) {
    const int cur = i & 1;
    if (i + 1 < ntiles) {
      tf(i + 1, kp, ldk, vp, ldv);
      kv_issue(r, kp, ldk, vp, ldv, tid);
    }
    body(i, kvb + cur * 2 * KVT, kvb + cur * 2 * KVT + KVT);
    if (i + 1 < ntiles) kv_write(r, kvb + (cur ^ 1) * 2 * KVT, kvb + (cur ^ 1) * 2 * KVT + KVT, tid);
    __syncthreads();
  }
}
DI void load_qf(bf16x8* qf, const u16* qrow, int hh) {
#pragma unroll
  for (int ks = 0; ks < 4; ++ks) qf[ks] = *(const bf16x8*)(qrow + ks * 16 + hh * 8);
}
DI bf16x8 rope_frag(bf16x8 f, const float* cs  , int hh) {
  u32x4 w = __builtin_bit_cast(u32x4, f), ow;
#pragma unroll
  for (int q = 0; q < 4; ++q) ow[q] = shxi<32>((int)w[q]);
  float mine[8], oth[8], res[8];
#pragma unroll
  for (int q = 0; q < 4; ++q) {
    mine[2 * q] = bflo(w[q]); mine[2 * q + 1] = bfhi(w[q]);
    oth[2 * q] = bflo(ow[q]); oth[2 * q + 1] = bfhi(ow[q]);
  }
  const float sg = hh ? 1.f : -1.f;
#pragma unroll
  for (int i = 0; i < 8; ++i) res[i] = mine[i] * cs[i] + sg * oth[i] * cs[8 + i];
  u32x4 r = {pack2(res[0], res[1]), pack2(res[2], res[3]), pack2(res[4], res[5]), pack2(res[6], res[7])};
  return __builtin_bit_cast(bf16x8, r);
}
DI void store_o(u16* yrow, const f32x16* o, float scale, int hh) {
#pragma unroll
  for (int db = 0; db < 2; ++db)
#pragma unroll
    for (int q = 0; q < 4; ++q) {
      u32x2 pk = {pack2(o[db][4 * q] * scale, o[db][4 * q + 1] * scale), pack2(o[db][4 * q + 2] * scale, o[db][4 * q + 3] * scale)};
      wt64(yrow + db * 32 + 8 * q + 4 * hh, pk);
    }
}

DI void kprep0_phase(int ws, PP p, char* shm) {
  const int tid = mytid(ws);
  float* fs = (float*)shm;
  u16* u = p->big;
  for (int item = blockIdx.x; item < 256; item += gridDim.x) {
    const int b = item >> 6, n = (item >> 1) & 31, hg = item & 1;
    const int cc = tid & 31, tg = tid >> 5, head = hg * 4 + (cc >> 3), dch = cc & 7;
    float sum[8];
#pragma unroll
    for (int e = 0; e < 8; ++e) sum[e] = 0.f;
#pragma unroll 1
    for (int tb = 0; tb < 16; tb += 8) {
    u32x4 wv[8];
#pragma unroll
    for (int t8 = 0; t8 < 8; ++t8) wv[t8] = *(const u32x4*)(u + ((long)b * SEQ + n * 256 + tg * 16 + tb + t8) * IN0 + 1536 + head * 64 + dch * 8);
#pragma unroll
    for (int t8 = 0; t8 < 8; ++t8) {
      const int tt = tb + t8;
      const int tok = n * 256 + tg * 16 + tt;
      u16* ptr = u + ((long)b * SEQ + tok) * IN0 + 1536 + head * 64 + dch * 8;
      u32x4 w = wv[t8], ow;
#pragma unroll
      for (int q = 0; q < 4; ++q) ow[q] = shxi<1>((int)w[q]);
      float mine[8], oth[8];
#pragma unroll
      for (int q = 0; q < 4; ++q) {
        mine[2 * q] = bflo(w[q]); mine[2 * q + 1] = bfhi(w[q]);
        oth[2 * q] = bflo(ow[q]); oth[2 * q + 1] = bfhi(ow[q]);
      }
      if (dch < 2) {
        const float* cs = p->rope + tok * 16;
        const float sg = dch ? 1.f : -1.f;
        float res[8];
#pragma unroll
        for (int i = 0; i < 8; ++i) res[i] = mine[i] * cs[i] + sg * oth[i] * cs[8 + i];
        u32x4 r = {pack2(res[0], res[1]), pack2(res[2], res[3]), pack2(res[4], res[5]), pack2(res[6], res[7])};
        wt128(ptr, r);
#pragma unroll
        for (int q = 0; q < 4; ++q) { mine[2 * q] = bflo(r[q]); mine[2 * q + 1] = bfhi(r[q]); }
      }
#pragma unroll
      for (int e = 0; e < 8; ++e) sum[e] += mine[e];
    }
    }
    __syncthreads();
#pragma unroll
    for (int e = 0; e < 8; ++e) fs[tg * 256 + cc * 8 + e] = sum[e];
    __syncthreads();
    if (tid < 256) {
      float t = 0.f;
#pragma unroll
      for (int g = 0; g < 16; ++g) t += fs[g * 256 + tid];
      wt32f(p->cent + (((long)b * 8 + hg * 4 + (tid >> 6)) * 32 + n) * 64 + (tid & 63), t * (1.f / 256.f));
    }
    __syncthreads();
  }
}

template <bool FINAL>
DI void lru_item(int ws, PP p, char* shm, int item) {
  const int tid = mytid(ws), wid = tid >> 6, lane = tid & 63, rl = lane & 31, hh = lane >> 5;
  const int b = item & 3, c = 127 - (item >> 2), t0 = c * 64;
  const u16* u = p->big;
  u16* XC = (u16*)shm + wid * KVT;
  {
    const int ch = wid * 64 + lane;
    const float w0 = p->conv_w[ch], w1 = p->conv_w[512 + ch], w2 = p->conv_w[1024 + ch], w3 = p->conv_w[1536 + ch], cb = p->conv_b[ch];
    const u16* up = u + ((long)b * SEQ + t0) * IN0 + ch;
    float xm3 = 0.f, xm2 = 0.f, xm1 = 0.f;
    if (t0 > 0) { xm3 = bf2f(up[-3 * IN0]); xm2 = bf2f(up[-2 * IN0]); xm1 = bf2f(up[-1 * IN0]); }
    for (int t = 0; t < 64; ++t) {
      float xv = bf2f(up[(long)t * IN0]);
      float xc = w0 * xm3 + w1 * xm2 + w2 * xm1 + w3 * xv + cb;
      XC[t * KVS + lane] = f2bf(xc);
      xm3 = xm2; xm2 = xm1; xm1 = xv;
    }
  }
  __syncthreads();
  const u16* wat = p->wat + (long)wid * 4096;
  const u16* wxt = p->wat + (long)(8 + wid) * 4096;
#pragma unroll 1
  for (int nb = 0; nb < 2; ++nb) {
    f32x16 ar[2], ai[2];
#pragma unroll
    for (int mb = 0; mb < 2; ++mb)
#pragma unroll
      for (int i = 0; i < 16; ++i) { ar[mb][i] = 0.f; ai[mb][i] = 0.f; }
#pragma unroll
    for (int ks = 0; ks < 4; ++ks) {
      bf16x8 ba_ = *(const bf16x8*)(wat + (nb * 32 + rl) * 64 + ks * 16 + hh * 8);
      bf16x8 bx_ = *(const bf16x8*)(wxt + (nb * 32 + rl) * 64 + ks * 16 + hh * 8);
#pragma unroll
      for (int mb = 0; mb < 2; ++mb) {
        bf16x8 a = *(const bf16x8*)(XC + (mb * 32 + rl) * KVS + ks * 16 + hh * 8);
        ar[mb] = MFMA32(a, ba_, ar[mb]);
        ai[mb] = MFMA32(a, bx_, ai[mb]);
      }
    }
    const int j = nb * 32 + rl, chj = wid * 64 + j;
    const float baj = p->ba[chj], bxj = p->bx[chj];
    const float la = -8.f * log1pf(__expf(-p->lam[chj]));
#pragma unroll
    for (int mb = 0; mb < 2; ++mb)
#pragma unroll
      for (int i = 0; i < 16; ++i) {
        const int tok = mb * 32 + hh * 4 + (i & 3) + 8 * (i >> 2);
        const float xc = bf2f(XC[tok * KVS + j]);
        const float r = sigmoidf_(ar[mb][i] + baj), ig = sigmoidf_(ai[mb][i] + bxj);
        const float aa = __expf(r * la);
        ar[mb][i] = aa;
        ai[mb][i] = __builtin_amdgcn_sqrtf(__builtin_fmaf(-aa, aa, 1.f)) * ig * xc;
      }
    float carry = 0.f, atot = 1.f;
    if (FINAL) {
      const float* sm = p->lrusum + ((long)b * 128 * 512 + chj) * 2;
#pragma unroll 8
      for (int cp = 0; cp < c; ++cp) {
        float2 ab = *(const float2*)(sm + (long)cp * 1024);
        carry = ab.y + ab.x * carry;
      }
    }
#pragma unroll
    for (int mb = 0; mb < 2; ++mb)
#pragma unroll
      for (int q = 0; q < 4; ++q) {
        float P = 1.f, H = 0.f;
#pragma unroll
        for (int e = 0; e < 4; ++e) {
          const int idx = 4 * q + e;
          H = ar[mb][idx] * H + ai[mb][idx];
          P *= ar[mb][idx];
          ar[mb][idx] = P;
          ai[mb][idx] = H;
        }
        const float Po = shxf<32>(P), Ho = shxf<32>(H);
        const float A0 = hh ? Po : P, B0 = hh ? Ho : H, A1 = hh ? P : Po, B1 = hh ? H : Ho;
        const float mid = B0 + A0 * carry;
        const float cin = hh ? mid : carry;
        carry = B1 + A1 * mid;
        atot *= A0 * A1;
        if (FINAL) {
          const int tl0 = launder(hh * 4);
#pragma unroll
          for (int e = 0; e < 4; ++e) {
            const int idx = 4 * q + e;
            const int tok = mb * 32 + tl0 + e + 8 * q;
            const float hv = ai[mb][idx] + ar[mb][idx] * cin;
            const long trow = (long)b * SEQ + t0 + tok;
            const float g = bf2f(u[trow * IN0 + 512 + chj]);
            wt16(p->h + trow * DM + chj, f2bf(hv * gelu_tanh(g)));
          }
        }
      }
    if (!FINAL && hh == 0) {
      float2 ab = {atot, carry};
      wt64(p->lrusum + (((long)b * 128 + c) * 512 + chj) * 2, __builtin_bit_cast(u32x2, ab));
    }
  }
  __syncthreads();
}

DI int moba_off(int n) { return 256 * (31 * n - (n * (n - 1)) / 2); }

DI void moba_gate_item(int ws, PP p, char* shm, int item) {
  const int tid = mytid(ws);
  const int qb = 31 - (item >> 5), b = (item >> 3) & 3, h = item & 7;
  if (qb == 0) return;
  const int t0 = qb * 256;
  const u16* u = p->big;
  float* cs = (float*)shm;
  float* tv = (float*)(shm + 8192);
  int* ti = (int*)(shm + 11264);
  __syncthreads();
  for (int i = tid; i < qb * 64; i += NTHR) cs[i] = p->cent[((long)(b * 8 + h) * 32) * 64 + i];
  __syncthreads();
  const int ql = tid & 255, half = tid >> 8, tq = t0 + ql;
  const u16* qp = u + ((long)b * SEQ + tq) * IN0 + 1024 + h * 64;
  float q[64];
#pragma unroll
  for (int s8 = 0; s8 < 8; ++s8) {
    u32x4 w = *(const u32x4*)(qp + s8 * 8);
#pragma unroll
    for (int e = 0; e < 4; ++e) { q[s8 * 8 + 2 * e] = bflo(w[e]); q[s8 * 8 + 2 * e + 1] = bfhi(w[e]); }
  }
  {
    const float* rc = p->rope + tq * 16;
#pragma unroll
    for (int i = 0; i < 8; ++i) {
      float x1 = q[i], x2 = q[8 + i], cc = rc[i], sn = rc[8 + i];
      q[i] = bf2f(f2bf(x1 * cc - x2 * sn));
      q[8 + i] = bf2f(f2bf(x2 * cc + x1 * sn));
    }
  }
  float v0 = -INFINITY, v1 = -INFINITY, v2 = -INFINITY;
  int i0 = -1, i1 = -1, i2 = -1;
  for (int n = half; n < qb; n += 2) {
    const float4* cr = (const float4*)(cs + n * 64);
    float d = 0.f;
#pragma unroll
    for (int e = 0; e < 16; ++e) {
      float4 cv = cr[e];
      d += q[4 * e] * cv.x + q[4 * e + 1] * cv.y + q[4 * e + 2] * cv.z + q[4 * e + 3] * cv.w;
    }
    if (d > v0) { v2 = v1; i2 = i1; v1 = v0; i1 = i0; v0 = d; i0 = n; }
    else if (d > v1) { v2 = v1; i2 = i1; v1 = d; i1 = n; }
    else if (d > v2) { v2 = d; i2 = n; }
  }
  if (half == 1) {
    tv[ql * 3] = v0; tv[ql * 3 + 1] = v1; tv[ql * 3 + 2] = v2;
    ti[ql * 3] = i0; ti[ql * 3 + 1] = i1; ti[ql * 3 + 2] = i2;
  }
  __syncthreads();
  if (half == 0) {
#pragma unroll
    for (int e = 0; e < 3; ++e) {
      const float d = tv[ql * 3 + e];
      const int n = ti[ql * 3 + e];
      if (n >= 0) {
        if (d > v0 || (d == v0 && n < i0)) { v2 = v1; i2 = i1; v1 = v0; i1 = i0; v0 = d; i0 = n; }
        else if (d > v1 || (d == v1 && n < i1)) { v2 = v1; i2 = i1; v1 = d; i1 = n; }
        else if (d > v2 || (d == v2 && n < i2)) { v2 = d; i2 = n; }
      }
    }
  }
  int* lcnt = (int*)(shm + 14336);
  if (tid < 64) lcnt[tid] = 0;
  __syncthreads();
  int r0 = 0, r1 = 0, r2 = 0;
  if (half == 0) {
    if (i0 >= 0) r0 = atomicAdd(&lcnt[i0], 1);
    if (i1 >= 0) r1 = atomicAdd(&lcnt[i1], 1);
    if (i2 >= 0) r2 = atomicAdd(&lcnt[i2], 1);
  }
  __syncthreads();
  const int bh = b * 8 + h;
  if (tid < 32 && lcnt[tid] > 0) lcnt[32 + tid] = (int)atomicAdd(&p->mcnt[bh * 32 + tid], (unsigned)lcnt[tid]);
  __syncthreads();
  if (half == 0) {
    unsigned* lst = p->mlist + (long)bh * 126976;
    if (i0 >= 0) wt32u(lst + moba_off(i0) + lcnt[32 + i0] + r0, ((unsigned)tq << 2) | 0u);
    if (i1 >= 0) wt32u(lst + moba_off(i1) + lcnt[32 + i1] + r1, ((unsigned)tq << 2) | 1u);
    if (i2 >= 0) wt32u(lst + moba_off(i2) + lcnt[32 + i2] + r2, ((unsigned)tq << 2) | 2u);
  }
}

DI void moba_gather_phase(int ws, PP p, char* shm) {
  const int tid = mytid(ws), wid = tid >> 6, lane = tid & 63, rl = lane & 31, hh = lane >> 5;
  const u16* u = p->big;
  u16* kvb = (u16*)shm;
  int* pre = (int*)(shm + 120000);
  __syncthreads();
  {
    const int c0 = (int)((p->mcnt[2 * tid] + 255u) >> 8), c1 = (int)((p->mcnt[2 * tid + 1] + 255u) >> 8);
    int sc = c0 + c1;
#pragma unroll
    for (int d = 1; d < 64; d <<= 1) {
      const int o = __shfl_up(sc, d);
      if (lane >= d) sc += o;
    }
    int* wtot = pre + 1032;
    if (lane == 63) wtot[wid] = sc;
    __syncthreads();
    int base = 0;
    for (int w = 0; w < wid; ++w) base += wtot[w];
    const int excl = base + sc - (c0 + c1);
    if (tid == 0) pre[0] = 0;
    pre[2 * tid + 1] = excl + c0;
    pre[2 * tid + 2] = excl + c0 + c1;
  }
  __syncthreads();
  const int total = pre[1024];
  const int row = tid >> 3, seg = tid & 7;
  u32x4 kr[4], vr[4];
  auto locate = [&](int it, int& li, int& chunk) {
    int lo = 0, hi = 1024;
    while (hi - lo > 1) {
      const int mid = (lo + hi) >> 1;
      if (pre[mid] <= it) lo = mid; else hi = mid;
    }
    li = lo;
    chunk = it - pre[lo];
  };
  auto issue = [&](int li) {
    const int bh = li >> 5, n = li & 31, b = bh >> 3, h = bh & 7;
    const u16* kbase = u + ((long)b * SEQ + n * 256) * IN0 + 1536 + h * 64;
    const u16* vbase = p->vt + ((long)bh * 64) * SEQ + n * 256;
#pragma unroll
    for (int st = 0; st < 4; ++st) {
      kr[st] = *(const u32x4*)(kbase + (long)(st * 64 + row) * IN0 + seg * 8);
      vr[st] = *(const u32x4*)(vbase + (long)row * SEQ + st * 64 + seg * 8);
    }
  };
  int li = 0, chunk = 0;
  int* gslot = (int*)(shm + 150016);
  int it = grab(ws, p->ctr + 2, shm);
  if (it < total) { locate(it, li, chunk); issue(li); }
#pragma unroll 1
  while (it < total) {
    const int bh = li >> 5, n = li & 31, b = bh >> 3, h = bh & 7;
    const int cnt = (int)p->mcnt[li];
    __syncthreads();
#pragma unroll
    for (int st = 0; st < 4; ++st) {
      *(u32x4*)(kvb + st * 2 * KVT + row * KVS + seg * 8) = kr[st];
      *(u32x4*)(kvb + st * 2 * KVT + KVT + row * KVS + seg * 8) = vr[st];
    }
    const int e = chunk * 256 + wid * 32 + rl;
    const bool valid = e < cnt;
    const unsigned ent = p->mlist[(long)bh * 126976 + moba_off(n) + (valid ? e : 0)];
    const int tq = (int)(ent >> 2), slot = (int)(ent & 3u);
    bf16x8 qf[4];
    load_qf(qf, u + ((long)b * SEQ + tq) * IN0 + 1024 + h * 64, hh);
    qf[0] = rope_frag(qf[0], p->rope + tq * 16, hh);
    if (tid == 0) *gslot = (int)atomicAdd(p->ctr + 2, 1u);
    f32x16 o[2];
#pragma unroll
    for (int db = 0; db < 2; ++db)
#pragma unroll
      for (int i = 0; i < 16; ++i) o[db][i] = 0.f;
    float m = -1e30f, l = 0.f;
    __syncthreads();
    const int itn = *gslot;
    int lin = 0, chunkn = 0;
    if (itn < total) { locate(itn, lin, chunkn); issue(lin); }
#pragma unroll
    for (int st = 0; st < 4; ++st) {
      f32x16 s[2];
      qk_tile(kvb + st * 2 * KVT, qf, s, rl, hh);
      osm<0>(s, 0xffffffffu, m, l, o);
      pv_tile(kvb + st * 2 * KVT + KVT, s, o, rl, hh);
    }
    if (valid) {
      u16* pe = p->part + (((long)bh * SEQ + tq) * 3 + slot) * 72;
      store_o(pe + 8, o, 1.f / l, hh);
      if (hh == 0) { wt32f((float*)pe, m); wt32f((float*)pe + 1, l); }
    }
    li = lin; chunk = chunkn; it = itn;
  }
  __syncthreads();
}

DI void moba_own_item(int ws, PP p, char* shm, int item) {
  const int tid = mytid(ws), wid = tid >> 6, lane = tid & 63, rl = lane & 31, hh = lane >> 5;
  const int qb = 31 - (item >> 5), b = (item >> 3) & 3, h = item & 7;
  const int t0 = qb * 256;
  const u16* u = p->big;
  u16* kvb = (u16*)shm;
  const int tq = t0 + wid * 32 + rl;
  bf16x8 qf[4];
  load_qf(qf, u + ((long)b * SEQ + tq) * IN0 + 1024 + h * 64, hh);
  qf[0] = rope_frag(qf[0], p->rope + tq * 16, hh);
  f32x16 o[2];
#pragma unroll
  for (int db = 0; db < 2; ++db)
#pragma unroll
    for (int i = 0; i < 16; ++i) o[db][i] = 0.f;
  float m = -1e30f, l = 0.f;
  const u16* kbase = u + ((long)b * SEQ + t0) * IN0 + 1536 + h * 64;
  const u16* vbase = p->vt + ((long)(b * 8 + h) * 64) * SEQ + t0;
  auto tf = [&](int i, const u16*& kp, long& ldk, const u16*& vp, long& ldv) {
    kp = kbase + (long)i * 64 * IN0; ldk = IN0;
    vp = vbase + i * 64; ldv = SEQ;
  };
  auto body = [&](int i, const u16* Ks, const u16* Vs) {
    const uint32_t vm = range_mask(i * 64, 0, wid * 32 + rl, hh);
    if (__ballot(vm != 0) != 0ull) {
      f32x16 s[2];
      qk_tile(Ks, qf, s, rl, hh);
      online_softmax(s, vm, m, l, o);
      pv_tile(Vs, s, o, rl, hh);
    }
  };
  kv_loop(kvb, 4, tid, tf, body);
  const int nsl = qb < 3 ? qb : 3;
#pragma unroll 1
  for (int sl = 0; sl < nsl; ++sl) {
    const u16* pe = p->part + (((long)(b * 8 + h) * SEQ + tq) * 3 + sl) * 72;
    const float ms = ((const float*)pe)[0], ls = ((const float*)pe)[1];
    const float mn = fmaxf(m, ms);
    const float a = fexp2(m - mn), c = fexp2(ms - mn) * ls;
#pragma unroll
    for (int db = 0; db < 2; ++db)
#pragma unroll
      for (int q = 0; q < 4; ++q) {
        const u32x2 w = *(const u32x2*)(pe + 8 + db * 32 + 8 * q + 4 * hh);
        o[db][4 * q] = o[db][4 * q] * a + c * bflo(w[0]);
        o[db][4 * q + 1] = o[db][4 * q + 1] * a + c * bfhi(w[0]);
        o[db][4 * q + 2] = o[db][4 * q + 2] * a + c * bflo(w[1]);
        o[db][4 * q + 3] = o[db][4 * q + 3] * a + c * bfhi(w[1]);
      }
    l = l * a + c;
    m = mn;
  }
  store_o(p->h + ((long)b * SEQ + tq) * DM + 512 + h * 64, o, 1.f / l, hh);
}

DI void rope1_phase(int ws, PP p) {
  const int tid = mytid(ws);
  u16* u = p->big;
  for (int e = blockIdx.x * NTHR + tid; e < NT * 4; e += gridDim.x * NTHR) {
    const int trow = e >> 2, w = e & 3, pos = trow & (SEQ - 1);
    u16* ptr = u + (long)trow * IN1P + ((w & 2) ? 1536 : 1280) + (w & 1) * 64;
    u32x4 a = *(const u32x4*)ptr, bq = *(const u32x4*)(ptr + 8);
    const float* cs = p->rope + pos * 16;
    float x1[8], x2[8], r1[8], r2[8];
#pragma unroll
    for (int q = 0; q < 4; ++q) { x1[2 * q] = bflo(a[q]); x1[2 * q + 1] = bfhi(a[q]); x2[2 * q] = bflo(bq[q]); x2[2 * q + 1] = bfhi(bq[q]); }
#pragma unroll
    for (int i = 0; i < 8; ++i) { r1[i] = x1[i] * cs[i] - x2[i] * cs[8 + i]; r2[i] = x2[i] * cs[i] + x1[i] * cs[8 + i]; }
    u32x4 oa = {pack2(r1[0], r1[1]), pack2(r1[2], r1[3]), pack2(r1[4], r1[5]), pack2(r1[6], r1[7])};
    u32x4 ob = {pack2(r2[0], r2[1]), pack2(r2[2], r2[3]), pack2(r2[4], r2[5]), pack2(r2[6], r2[7])};
    wt128(ptr, oa);
    wt128(ptr + 8, ob);
  }
}
DI void cmpfin_phase(int ws, int gx, int gslot, PP p, char* shm) {
  const int tid = mytid(ws);
  float* hid = (float*)shm;
  float* w2s = (float*)(shm + 4096);
  int kvl = -1;
  const int slots = gridDim.x >> 3;
  for (int li = gslot; li < 128; li += slots) {
    const int kv = gx >> 2, bg = 2 * (gx & 3) + (li >> 6), i0 = (li & 63) * 8;
    const int row = tid >> 6, n = tid & 63, i = i0 + row;
    const float* pq = p->pq + ((long)kv * 4096 + bg * 512) * 256;
    __syncthreads();
    if (kv != kvl) {
      const float* w2 = p->cmp_w2 + (long)kv * 128 * 64;
      for (int e = tid; e < 128 * 64; e += NTHR) w2s[e] = w2[e];
      kvl = kv;
    }
#pragma unroll
    for (int hf = 0; hf < 2; ++hf) {
      const int nn = n + hf * 64;
      float v = 0.f;
      if (i < 511) v = gelu_tanh(pq[(long)i * 256 + nn] + pq[(long)(i + 1) * 256 + 128 + nn] + p->cvec[kv * 128 + nn]);
      hid[row * 128 + nn] = v;
    }
    __syncthreads();
    float acc = 0.f;
#pragma unroll 8
    for (int k = 0; k < 128; ++k) acc += hid[row * 128 + k] * w2s[k * 64 + n];
    if (i < 511) {
      if (kv == 0) wt16(p->kcmp + ((long)bg * 512 + i) * 64 + n, f2bf(acc));
      else wt16(p->vcmpT + ((long)bg * 64 + n) * 512 + i, f2bf(acc));
    }
  }
  __syncthreads();
}

DI void nsa_item(int ws, PP p, char* shm, int item) {
  const int tid = mytid(ws), wid = tid >> 6, lane = tid & 63, rl = lane & 31, hh = lane >> 5;
  const int tt = 255 - (item >> 3), bg = item & 7, b = bg >> 1, g = bg & 1;
  const int t0 = tt * 32, tokl = wid * 4 + (rl >> 3), tok = t0 + tokl, r = rl & 7, hq = g * 8 + r;
  const u16* u = p->big;
  u16* kvb = (u16*)shm;
  float* impm = (float*)(shm + 36864);
  float* imps = (float*)(shm + 53760);
  float* vals = (float*)(shm + 70656);
  unsigned char* selb = (unsigned char*)(shm + 147456);
  uint32_t* un = (uint32_t*)(shm + 147968);
  int* tl = (int*)(shm + 148032);
  __syncthreads();
  for (int i = tid; i < 2 * 32 * 132; i += NTHR) impm[i] = 0.f;
  if (tid < 8) un[tid] = 0;
  const u16* qrow = u + ((long)b * SEQ + tok) * IN1P + hq * 64;
  bf16x8 qn[4], qr[4];
  load_qf(qn, qrow, hh);
  qr[0] = rope_frag(qn[0], p->rope + tok * 16, hh);
  qr[1] = qn[1]; qr[2] = qn[2]; qr[3] = qn[3];
  float gt[3];
#pragma unroll
  for (int br = 0; br < 3; ++br) gt[br] = sigmoidf_(bf2f(qrow[1792 - hq * 64 + hq * 3 + br]));
  f32x16 yacc[2], o[2];
#pragma unroll
  for (int db = 0; db < 2; ++db)
#pragma unroll
    for (int i = 0; i < 16; ++i) { yacc[db][i] = 0.f; o[db][i] = 0.f; }
  {
    const int nct = (t0 >> 10) + 1;
    const int cmax = (tok - 31) >> 4;
    const u16* kc = p->kcmp + (long)bg * 512 * 64;
    const u16* vc = p->vcmpT + (long)bg * 64 * 512;
    auto tf = [&](int i, const u16*& kp, long& ldk, const u16*& vp, long& ldv) {
      kp = kc + (long)i * 64 * 64; ldk = 64;
      vp = vc + i * 64; ldv = 512;
    };
    float m = -1e30f, l = 0.f;
    auto body1 = [&](int i, const u16* Ks, const u16* Vs) {
      const uint32_t vm = range_mask(i * 64, 0, cmax, hh);
      f32x16 s[2];
      qk_tile(Ks, qn, s, rl, hh);
      float mx = -1e30f;
#pragma unroll
      for (int kb = 0; kb < 2; ++kb)
#pragma unroll
        for (int ii = 0; ii < 16; ++ii) {
          float v = s[kb][ii] * SCL2;
          v = ((vm >> (kb * 16 + ii)) & 1u) ? v : -1e30f;
          s[kb][ii] = v;
          mx = fmaxf(mx, v);
        }
      mx = xmax32(mx);
      const float mn = fmaxf(m, mx);
      float rs = 0.f;
#pragma unroll
      for (int kb = 0; kb < 2; ++kb)
#pragma unroll
        for (int ii = 0; ii < 16; ++ii) rs += ((vm >> (kb * 16 + ii)) & 1u) ? fexp2(s[kb][ii] - mn) : 0.f;
      rs = xsum32(rs);
      l = l * fexp2(m - mn) + rs;
      m = mn;
    };
    kv_loop(kvb, nct, tid, tf, body1);
    const float invl = l > 0.f ? 1.f / l : 0.f;
    auto body2 = [&](int i, const u16* Ks, const u16* Vs) {
      const uint32_t vm = range_mask(i * 64, 0, cmax, hh);
      f32x16 s[2];
      qk_tile(Ks, qn, s, rl, hh);
#pragma unroll
      for (int kb = 0; kb < 2; ++kb)
#pragma unroll
        for (int ii = 0; ii < 16; ++ii) s[kb][ii] = ((vm >> (kb * 16 + ii)) & 1u) ? fexp2(__builtin_fmaf(s[kb][ii], SCL2, -m)) * invl : 0.f;
      pv_tile(Vs, s, o, rl, hh);
#pragma unroll
      for (int kb = 0; kb < 2; ++kb)
#pragma unroll
        for (int q4 = 0; q4 < 4; ++q4) {
          float mainv = s[kb][4 * q4] + s[kb][4 * q4 + 1] + s[kb][4 * q4 + 2] + 0.5f * s[kb][4 * q4 + 3];
          float sp = 0.5f * s[kb][4 * q4 + 3];
          mainv = sum8(mainv);
          sp = sum8(sp);
          if (r == 0) {
            const int j = 16 * i + 8 * kb + 2 * q4 + hh;
            impm[tokl * 132 + j] = mainv;
            imps[tokl * 132 + j + 1] = sp;
          }
        }
    };
    kv_loop(kvb, nct, tid, tf, body2);
#pragma unroll
    for (int db = 0; db < 2; ++db)
#pragma unroll
      for (int i = 0; i < 16; ++i) { yacc[db][i] = gt[0] * o[db][i]; o[db][i] = 0.f; }
  }
  __syncthreads();
  {
    const int tk = tid >> 4, jg = tid & 15, blk = (t0 + tk) >> 6;
    float v[8];
#pragma unroll
    for (int e = 0; e < 8; ++e) {
      const int j = jg * 8 + e;
      float x = impm[tk * 132 + j] + imps[tk * 132 + j];
      if (j == 0 || j == blk || j == blk - 1) x = 1e30f;
      if (j > blk) x = -INFINITY;
      v[e] = x;
      vals[tk * 132 + j] = x;
    }
    uint32_t key[8];
#pragma unroll
    for (int e = 0; e < 8; ++e) {
      const uint32_t uu = __float_as_uint(v[e]);
      key[e] = (uu & 0x80000000u) ? ~uu : (uu | 0x80000000u);
    }
    auto rowsum = [](int c) {
      c += __builtin_amdgcn_update_dpp(0, c, 0x128, 0xF, 0xF, true);
      c += __builtin_amdgcn_update_dpp(0, c, 0x124, 0xF, 0xF, true);
      c += __builtin_amdgcn_update_dpp(0, c, 0x122, 0xF, 0xF, true);
      c += __builtin_amdgcn_update_dpp(0, c, 0x121, 0xF, 0xF, true);
      return c;
    };
    uint32_t pfx = 0;
#pragma unroll 1
    for (int b = 31; b >= 0; --b) {
      const uint32_t cand = pfx | (1u << b);
      int c = 0;
#pragma unroll
      for (int e = 0; e < 8; ++e) c += (key[e] >= cand) ? 1 : 0;
      c = rowsum(c);
      if (c >= 16) pfx = cand;
    }
    int cgt = 0, teq = 0;
#pragma unroll
    for (int e = 0; e < 8; ++e) { cgt += (key[e] > pfx) ? 1 : 0; teq += (key[e] == pfx) ? 1 : 0; }
    cgt = rowsum(cgt);
    int tin = teq;
    tin += __builtin_amdgcn_update_dpp(0, tin, 0x111, 0xF, 0xF, true);
    tin += __builtin_amdgcn_update_dpp(0, tin, 0x112, 0xF, 0xF, true);
    tin += __builtin_amdgcn_update_dpp(0, tin, 0x114, 0xF, 0xF, true);
    tin += __builtin_amdgcn_update_dpp(0, tin, 0x118, 0xF, 0xF, true);
    int run = cgt + tin - teq;
    uint32_t bits = 0;
#pragma unroll
    for (int e = 0; e < 8; ++e) {
      const bool eq = key[e] == pfx;
      const bool sel = (key[e] > pfx) || (eq && run < 16);
      run += eq ? 1 : 0;
      bits |= (sel && (jg * 8 + e) <= blk) ? (1u << e) : 0u;
    }
    selb[tk * 16 + jg] = (unsigned char)bits;
    __syncthreads();
    if (tid < 32) {
      const uint32_t* w = (const uint32_t*)(selb + tid * 16);
      atomicOr(&un[0], w[0]); atomicOr(&un[1], w[1]); atomicOr(&un[2], w[2]); atomicOr(&un[3], w[3]);
    }
    __syncthreads();
    if (tid < 128) {
      const uint32_t u0 = un[0], u1 = un[1], u2 = un[2], u3 = un[3];
      const int w = tid >> 5, bpos = tid & 31;
      const uint32_t uw = w == 0 ? u0 : w == 1 ? u1 : w == 2 ? u2 : u3;
      const int below = (w > 0 ? __popc(u0) : 0) + (w > 1 ? __popc(u1) : 0) + (w > 2 ? __popc(u2) : 0);
      if ((uw >> bpos) & 1u) tl[below + __popc(uw & ((1u << bpos) - 1u))] = tid;
      if (tid == 0) un[4] = __popc(u0) + __popc(u1) + __popc(u2) + __popc(u3);
    }
    __syncthreads();
  }
  {
    const int ntl = (int)un[4];
    const u32x4 ms = *(const u32x4*)(selb + tokl * 16);
    const u16* kb_ = u + (long)b * SEQ * IN1P + 1280 + g * 64;
    const u16* vb_ = p->vt + (long)bg * 64 * SEQ;
    auto tf = [&](int i, const u16*& kp, long& ldk, const u16*& vp, long& ldv) {
      const int j = tl[i];
      kp = kb_ + (long)j * 64 * IN1P; ldk = IN1P;
      vp = vb_ + j * 64; ldv = SEQ;
    };
    float m = -1e30f, l = 0.f;
    auto body = [&](int i, const u16* Ks, const u16* Vs) {
      const int j = tl[i];
      const uint32_t w = j < 32 ? ms[0] : j < 64 ? ms[1] : j < 96 ? ms[2] : ms[3];
      uint32_t vm = ((w >> (j & 31)) & 1u) ? range_mask(j * 64, 0, tok, hh) : 0u;
      if (__ballot(vm != 0) != 0ull) {
        f32x16 s[2];
        qk_tile(Ks, qr, s, rl, hh);
        online_softmax(s, vm, m, l, o);
        pv_tile(Vs, s, o, rl, hh);
      }
    };
    {
      const int ng = (ntl + 3) >> 2;
      const int row = tid >> 3, seg = tid & 7;
      u32x4 kr[4], vr[4];
      auto issue = [&](int g4) {
#pragma unroll
        for (int t = 0; t < 4; ++t) {
          const int idx = g4 * 4 + t;
          if (idx < ntl) {
            const int j = tl[idx];
            kr[t] = *(const u32x4*)(kb_ + ((long)j * 64 + row) * IN1P + seg * 8);
            vr[t] = *(const u32x4*)(vb_ + (long)row * SEQ + j * 64 + seg * 8);
          }
        }
      };
      auto wr = [&](int g4, int buf) {
#pragma unroll
        for (int t = 0; t < 4; ++t) {
          if (g4 * 4 + t < ntl) {
            u16* kd = kvb + (buf * 4 + t) * 2 * KVT;
            *(u32x4*)(kd + row * KVS + seg * 8) = kr[t];
            *(u32x4*)(kd + KVT + row * KVS + seg * 8) = vr[t];
          }
        }
      };
      __syncthreads();
      issue(0);
      wr(0, 0);
      __syncthreads();
#pragma unroll 1
      for (int g4 = 0; g4 < ng; ++g4) {
        if (g4 + 1 < ng) issue(g4 + 1);
#pragma unroll 1
        for (int t = 0; t < 4; ++t) {
          const int idx = g4 * 4 + t;
          if (idx < ntl) {
            const u16* kd = kvb + ((g4 & 1) * 4 + t) * 2 * KVT;
            body(idx, kd, kd + KVT);
          }
        }
        if (g4 + 1 < ng) wr(g4 + 1, (g4 + 1) & 1);
        __syncthreads();
      }
    }
    const float sc = gt[1] / l;
#pragma unroll
    for (int db = 0; db < 2; ++db)
#pragma unroll
      for (int i = 0; i < 16; ++i) { yacc[db][i] += sc * o[db][i]; o[db][i] = 0.f; }
  }
  {
    const int jlo = (t0 > 511 ? t0 - 511 : 0) >> 6, jhi = (t0 + 31) >> 6;
    const u16* kb_ = u + (long)b * SEQ * IN1P + 1536 + g * 64;
    const u16* vb_ = p->vt + (long)(8 + bg) * 64 * SEQ;
    auto tf = [&](int i, const u16*& kp, long& ldk, const u16*& vp, long& ldv) {
      const int j = jlo + i;
      kp = kb_ + (long)j * 64 * IN1P; ldk = IN1P;
      vp = vb_ + j * 64; ldv = SEQ;
    };
    float m = -1e30f, l = 0.f;
    auto body = [&](int i, const u16* Ks, const u16* Vs) {
      const int j = jlo + i;
      const uint32_t vm = range_mask(j * 64, tok - 511, tok, hh);
      if (__ballot(vm != 0) != 0ull) {
        f32x16 s[2];
        qk_tile(Ks, qr, s, rl, hh);
        online_softmax(s, vm, m, l, o);
        pv_tile(Vs, s, o, rl, hh);
      }
    };
    kv_loop(kvb, jhi - jlo + 1, tid, tf, body);
    const float sc = gt[2] / l;
#pragma unroll
    for (int db = 0; db < 2; ++db)
#pragma unroll
      for (int i = 0; i < 16; ++i) yacc[db][i] += sc * o[db][i];
  }
  store_o(p->h + ((long)b * SEQ + tok) * DM + hq * 64, yacc, 1.f, hh);
}

DI void local_barrier(unsigned* ctr, unsigned target, int ws) {
  asm volatile("s_waitcnt vmcnt(0)" ::: "memory");
  __syncthreads();
  if (ws == 0 && lane_id_() == 0) {
    __hip_atomic_fetch_add(ctr, 1u, __ATOMIC_RELAXED, __HIP_MEMORY_SCOPE_AGENT);
    unsigned sp = 0;
    while (__hip_atomic_load(ctr, __ATOMIC_RELAXED, __HIP_MEMORY_SCOPE_AGENT) < target) {
      __builtin_amdgcn_s_sleep(1);
      if (++sp > (1u << 22)) break;
    }
    __builtin_amdgcn_fence(__ATOMIC_ACQUIRE, "agent");
    asm volatile("s_waitcnt vmcnt(0)" ::: "memory");
  }
  __syncthreads();
}

__global__ void __launch_bounds__(NTHR) fwd_kernel(Params pk) {
  __shared__ __attribute__((aligned(1024))) char shm[151552];
  cg::grid_group grid = cg::this_grid();
  const PP p0 = (PP)__builtin_amdgcn_kernarg_segment_ptr();
  const int ws = __builtin_amdgcn_readfirstlane(threadIdx.x >> 6);
  prep_phase(ws, launder_p(p0), shm);
  grid.sync();
  int gx = blockIdx.x & 7, gslot = blockIdx.x >> 3;
  bool loc = false;
  unsigned lep = 0;
  {
    int* cs_ = (int*)(shm + 150024);
    if (ws == 0 && lane_id_() == 0) {
      const unsigned xcc = (unsigned)__builtin_amdgcn_s_getreg((3 << 11) | 20) & 0xFu;
      cs_[0] = (int)xcc;
      cs_[1] = (int)__hip_atomic_fetch_add(p0->xcnt + xcc, 1u, __ATOMIC_RELAXED, __HIP_MEMORY_SCOPE_AGENT);
      unsigned sp = 0, sum = 0;
      bool ok = false;
      for (;;) {
        sum = 0;
        ok = true;
        for (int j = 0; j < 16; ++j) {
          const unsigned c = __hip_atomic_load(p0->xcnt + j, __ATOMIC_RELAXED, __HIP_MEMORY_SCOPE_AGENT);
          sum += c;
          if (j < 8 ? (c != 32u) : (c != 0u)) ok = false;
        }
        if (sum == gridDim.x || ++sp > (1u << 20)) break;
        __builtin_amdgcn_s_sleep(1);
      }
      cs_[2] = (ok && sum == gridDim.x && gridDim.x == 256) ? 1 : 0;
    }
    __syncthreads();
    if (cs_[2]) { gx = cs_[0]; gslot = cs_[1]; loc = true; }
    __syncthreads();
  }
  auto seam = [&]() {
    if (loc) { ++lep; local_barrier(p0->lbar + gx * 64, lep * (gridDim.x >> 3), ws); }
    else grid.sync();
  };
  auto half = [&](const int l, const int s) __attribute__((always_inline)) {
    {
      PP p = launder_p(p0);
      const float* modl = p->mod + (long)l * 4 * 9216;
      const float* xin = (l == 0 && s == 0) ? p->x : p->out;
      norm_phase(ws, gx, gslot, xin, p->h, p->norm_g + (l * 3 + (s == 0 ? 0 : 2)) * DM, modl + (s == 0 ? 0 : 6) * DM, modl + (s == 0 ? 1 : 7) * DM);
      seam();
      p = launder_p(p0);
      {
        const u16* W = p->wt1 + (long)(l * 2 + s) * 5632 * 1024;
        u16* act = p->big;
        auto desc = [&](int pm, int pn) { return TileDesc{p->h + (long)pm * 256 * DM, DM, 64, W + (long)pn * 256 * DM, DM, DM / 64}; };
        auto epi = [&](int pm, int pn, Acc8& acc, int wr, int wc, int fr, int fq) {
#pragma unroll
          for (int ai = 0; ai < 2; ++ai)
#pragma unroll
            for (int bj = 0; bj < 2; ++bj)
#pragma unroll
              for (int m = 0; m < 4; ++m)
                {
                  float v[4];
#pragma unroll
                  for (int j = 0; j < 4; ++j) {
                    float a = acc[ai][bj][m][0][j], b = acc[ai][bj][m][1][j];
                    v[j] = a * __builtin_amdgcn_rcpf(1.f + __expf(-a)) * b;
                  }
                  const long row0 = (long)pm * 256 + ai * 128 + wr * 64 + m * 16 + fq * 4;
                  const int cole = pn * 128 + (bj * 4 + wc) * 16 + (fr & ~1);
                  store_pair_bf16(act + row0 * DFF + cole, DFF, fr & 1, v[0], v[1], v[2], v[3]);
                }
        };
        gemm_phase(ws, gx, gslot, shm, NT / 256, 5632 / 256, desc, epi);
      }
      seam();
      p = launder_p(p0);
      modl = p->mod + (long)l * 4 * 9216;
      xin = (l == 0 && s == 0) ? p->x : p->out;
      {
        const u16* W = p->wt2 + (long)(l * 2 + s) * 1024 * DFF;
        const float* gate = modl + (s == 0 ? 2 : 8) * DM;
        float* xo = p->out;
        auto desc = [&](int pm, int pn) { return TileDesc{p->big + (long)pm * 256 * DFF, DFF, 64, W + (long)pn * 256 * DFF, DFF, DFF / 64}; };
        auto epi = [&](int pm, int pn, Acc8& acc, int wr, int wc, int fr, int fq) {
          const int b = (pm * 256) >> 13;
#pragma unroll
          for (int bj = 0; bj < 2; ++bj)
#pragma unroll
            for (int n = 0; n < 2; ++n) {
              const int col = pn * 256 + bj * 128 + wc * 32 + n * 16 + fr;
              const float gv = 0.5f * gate[(long)b * 9216 + col];
#pragma unroll
              for (int ai = 0; ai < 2; ++ai)
#pragma unroll
                for (int m = 0; m < 4; ++m) {
                  const long row0 = (long)pm * 256 + ai * 128 + wr * 64 + m * 16 + fq * 4;
                  const f32x4 a = acc[ai][bj][m][n];
                  rmw_pair_f32(xo + row0 * DM + (col & ~1), xin + row0 * DM + (col & ~1), DM, col & 1, gv * a[0], gv * a[1], gv * a[2], gv * a[3]);
                  asm volatile("" ::: "memory");
                }
            }
        };
        gemm_phase(ws, gx, gslot, shm, NT / 256, DM / 256, desc, epi);
      }
      seam();
      if (s == 0) {
        p = launder_p(p0);
        modl = p->mod + (long)l * 4 * 9216;
        norm_phase(ws, gx, gslot, p->out, p->h, p->norm_g + (l * 3 + 1) * DM, modl + 3 * DM, modl + 4 * DM);
        seam();
        if (l == 0) {
          p = launder_p(p0);
          {
            u16* uu = p->big;
            u16* vt = p->vt;
            auto desc = [&](int pm, int pn) { return TileDesc{p->h + (long)pm * 256 * DM, DM, 64, p->wtin0 + (long)pn * 256 * DM, DM, DM / 64}; };
            auto epi = [&](int pm, int pn, Acc8& acc, int wr, int wc, int fr, int fq) {
#pragma unroll
              for (int ai = 0; ai < 2; ++ai)
#pragma unroll
                for (int bj = 0; bj < 2; ++bj)
#pragma unroll
                  for (int m = 0; m < 4; ++m)
#pragma unroll
                    for (int n = 0; n < 2; ++n) {
                      const int col = pn * 256 + bj * 128 + wc * 32 + n * 16 + fr;
                      const long row0 = (long)pm * 256 + ai * 128 + wr * 64 + m * 16 + fq * 4;
                      const f32x4 v = acc[ai][bj][m][n];
                      if (col >= 2048) {
                        const int vc = col - 2048, bb = (int)(row0 >> 13), t = (int)(row0 & 8191);
                        u32x2 pk = {pack2(v[0], v[1]), pack2(v[2], v[3])};
                        wt64(vt + ((long)(bb * 8 + (vc >> 6)) * 64 + (vc & 63)) * SEQ + t, pk);
                      } else {
                        store_pair_bf16(uu + row0 * IN0 + (col & ~1), IN0, col & 1, v[0], v[1], v[2], v[3]);
                      }
                    }
            };
            gemm_phase(ws, gx, gslot, shm, NT / 256, IN0 / 256, desc, epi);
          }
          grid.sync();
          p = launder_p(p0);
          kprep0_phase(ws, p, shm);
          p = launder_p(p0);
#pragma unroll 1
          for (int it = grab(ws, p->ctr + 0, shm); it < 512;) {
            const int nx_ = grab_begin(ws, p->ctr + 0);
            lru_item<false>(ws, p, shm, it);
            it = grab_end(ws, nx_, shm);
          }
          grid.sync();
          p = launder_p(p0);
#pragma unroll 1
          for (int it = grab(ws, p->ctr + 1, shm); it < 1024;) {
            const int nx_ = grab_begin(ws, p->ctr + 1);
            moba_gate_item(ws, p, shm, it);
            it = grab_end(ws, nx_, shm);
          }
          grid.sync();
          p = launder_p(p0);
          moba_gather_phase(ws, p, shm);
          p = launder_p(p0);
#pragma unroll 1
          for (int it = grab(ws, p->ctr + 3, shm); it < 512;) {
            const int nx_ = grab_begin(ws, p->ctr + 3);
            lru_item<true>(ws, p, shm, it);
            it = grab_end(ws, nx_, shm);
          }
          grid.sync();
          p = launder_p(p0);
#pragma unroll 1
          for (int it = grab(ws, p->ctr + 4, shm); it < 1024;) {
            const int nx_ = grab_begin(ws, p->ctr + 4);
            moba_own_item(ws, p, shm, it);
            it = grab_end(ws, nx_, shm);
          }
          grid.sync();
        }
        if (l == 1) {
          p = launder_p(p0);
          {
            u16* uu = p->big;
            u16* vt = p->vt;
            auto desc = [&](int pm, int pn) { return TileDesc{p->h + (long)pm * 256 * DM, DM, 64, p->wtin1 + (long)pn * 256 * DM, DM, DM / 64}; };
            auto epi = [&](int pm, int pn, Acc8& acc, int wr, int wc, int fr, int fq) {
#pragma unroll
              for (int ai = 0; ai < 2; ++ai)
#pragma unroll
                for (int bj = 0; bj < 2; ++bj) {
                  const int c64 = (pn * 256 + bj * 128 + wc * 32) >> 6;
                  const bool isv = (c64 == 22 || c64 == 23 || c64 == 26 || c64 == 27);
#pragma unroll
                  for (int m = 0; m < 4; ++m)
#pragma unroll
                    for (int n = 0; n < 2; ++n) {
                      const int col = pn * 256 + bj * 128 + wc * 32 + n * 16 + fr;
                      const long row0 = (long)pm * 256 + ai * 128 + wr * 64 + m * 16 + fq * 4;
                      const f32x4 v = acc[ai][bj][m][n];
                      if (isv) {
                        const int bb = (int)(row0 >> 13), t = (int)(row0 & 8191);
                        const int which = c64 >= 26 ? 1 : 0, gg = c64 & 1;
                        u32x2 pk = {pack2(v[0], v[1]), pack2(v[2], v[3])};
                        wt64(vt + ((long)(which * 8 + bb * 2 + gg) * 64 + (col & 63)) * SEQ + t, pk);
                      } else if (col < IN1) {
                        store_pair_bf16(uu + row0 * IN1P + (col & ~1), IN1P, col & 1, v[0], v[1], v[2], v[3]);
                      }
                    }
                }
            };
            gemm_phase(ws, gx, gslot, shm, NT / 256, IN1P / 256, desc, epi);
          }
          grid.sync();
          p = launder_p(p0);
          rope1_phase(ws, p);
          p = launder_p(p0);
          {
            float* pq = p->pq;
            auto desc = [&](int pm, int pn) {
              const int kv = pm >> 4, rr = pm & 15, bg = rr >> 1, j0 = (rr & 1) * 256;
              return TileDesc{p->big + ((long)(bg >> 1) * SEQ + 16 * j0) * IN1P + 1024 + kv * 128 + (bg & 1) * 64, 16 * IN1P, IN1P,
                              p->wtcmp + (long)kv * 256 * 1024, 1024, 16};
            };
            auto epi = [&](int pm, int pn, Acc8& acc, int wr, int wc, int fr, int fq) {
#pragma unroll
              for (int ai = 0; ai < 2; ++ai)
#pragma unroll
                for (int bj = 0; bj < 2; ++bj)
#pragma unroll
                  for (int m = 0; m < 4; ++m)
#pragma unroll
                    for (int n = 0; n < 2; ++n)
#pragma unroll
                      for (int j = 0; j < 4; ++j)
                        wt32f(pq + ((long)pm * 256 + ai * 128 + wr * 64 + m * 16 + fq * 4 + j) * 256 + bj * 128 + wc * 32 + n * 16 + fr, acc[ai][bj][m][n][j]);
            };
            gemm_phase(ws, gx, gslot, shm, 32, 1, desc, epi);
          }
          seam();
          p = launder_p(p0);
          cmpfin_phase(ws, gx, gslot, p, shm);
          grid.sync();
          p = launder_p(p0);
#pragma unroll 1
          for (int it = grab(ws, p->ctr + 5, shm); it < 2048;) {
            const int nx_ = grab_begin(ws, p->ctr + 5);
            nsa_item(ws, p, shm, it);
            it = grab_end(ws, nx_, shm);
          }
          grid.sync();
        }
        {
          p = launder_p(p0);
          modl = p->mod + (long)l * 4 * 9216;
          const u16* W = l == 0 ? p->wtout0 : p->wtout1;
          const float* gate = modl + 5 * DM;
          float* xo = p->out;
          auto desc = [&](int pm, int pn) { return TileDesc{p->h + (long)pm * 256 * DM, DM, 64, W + (long)pn * 256 * DM, DM, DM / 64}; };
          auto epi = [&](int pm, int pn, Acc8& acc, int wr, int wc, int fr, int fq) {
            const int b = (pm * 256) >> 13;
#pragma unroll
            for (int bj = 0; bj < 2; ++bj)
#pragma unroll
              for (int n = 0; n < 2; ++n) {
                const int col = pn * 256 + bj * 128 + wc * 32 + n * 16 + fr;
                const float gv = gate[(long)b * 9216 + col];
#pragma unroll
                for (int ai = 0; ai < 2; ++ai)
#pragma unroll
                  for (int m = 0; m < 4; ++m) {
                    const long row0 = (long)pm * 256 + ai * 128 + wr * 64 + m * 16 + fq * 4;
                    const f32x4 a = acc[ai][bj][m][n];
                    rmw_pair_f32(xo + row0 * DM + (col & ~1), xo + row0 * DM + (col & ~1), DM, col & 1, gv * a[0], gv * a[1], gv * a[2], gv * a[3]);
                    asm volatile("" ::: "memory");
                  }
              }
          };
          gemm_phase(ws, gx, gslot, shm, NT / 256, DM / 256, desc, epi);
          seam();
        }
      }
    }
  };
  half(0, 0);
  half(0, 1);
  half(1, 0);
  half(1, 1);
  { PP p = launder_p(p0); final_norm_phase(ws, gx, gslot, p->out, p->fng); }
}

extern "C" void kernel_launch(void* const* d_in, const int* in_sizes, int n_in, void* d_out, int out_size, void* d_ws, size_t ws_size,
                              hipStream_t stream) {
  Params p;
  memset(&p, 0, sizeof(p));
  const float** fp = (const float**)&p.x;
  for (int i = 0; i < 22; ++i) fp[i] = (const float*)d_in[i];
  p.out = (float*)d_out;
  char* ws = (char*)d_ws;
  size_t off = 0;
  auto take = [&](size_t bytes) { char* r = ws + off; off += (bytes + 255) & ~(size_t)255; return r; };
  p.wt1 = (u16*)take((size_t)4 * 5632 * 1024 * 2);
  p.wt2 = (u16*)take((size_t)4 * 1024 * DFF * 2);
  p.wtin0 = (u16*)take((size_t)IN0 * 1024 * 2);
  p.wtout0 = (u16*)take((size_t)1024 * 1024 * 2);
  p.wtin1 = (u16*)take((size_t)IN1P * 1024 * 2);
  p.wtout1 = (u16*)take((size_t)1024 * 1024 * 2);
  p.wtcmp = (u16*)take((size_t)2 * 256 * 1024 * 2);
  p.wat = (u16*)take((size_t)2 * 8 * 64 * 64 * 2);
  p.mod = (float*)take((size_t)2 * 4 * 9216 * 4);
  p.rope = (float*)take((size_t)SEQ * 16 * 4);
  p.cvec = (float*)take(2 * 128 * 4);
  p.cent = (float*)take((size_t)4 * 8 * 32 * 64 * 4);
  p.lrusum = (float*)take((size_t)4 * 128 * 512 * 2 * 4);
  p.pq = (float*)take((size_t)2 * 4096 * 256 * 4);
  p.h = (u16*)take((size_t)NT * 1024 * 2);
  p.big = (u16*)take((size_t)NT * DFF * 2);
  p.vt = (u16*)take((size_t)NT * 512 * 2);
  p.kcmp = (u16*)take((size_t)8 * 512 * 64 * 2);
  p.vcmpT = (u16*)take((size_t)8 * 512 * 64 * 2);
  p.mcnt = (unsigned*)take(1024 * 4);
  p.ctr = (unsigned*)take(64 * 4);
  p.xcnt = (unsigned*)take(64 * 4);
  p.lbar = (unsigned*)take(8 * 64 * 4);
  p.mlist = (unsigned*)take((size_t)32 * 126976 * 4);
  p.part = (u16*)take((size_t)NT * 8 * 3 * 144);
  int nj = 0, t0 = 0;
  auto add = [&](const float* src, u16* dst, int K, int N, int ldn, int perm, int npad) {
    TJob& j = p.jobs[nj++];
    j.src = src; j.dst = dst; j.K = K; j.N = N; j.ldn = ldn; j.perm = perm; j.tile0 = t0; j.ntn = npad / 64;
    t0 += (K / 64) * ((npad / 64 + 3) / 4);
  };
  for (int i = 0; i < 4; ++i) add(p.ffn_w1 + (size_t)i * 1024 * 5632, p.wt1 + (size_t)i * 5632 * 1024, 1024, 5632, 5632, 1, 5632);
  for (int i = 0; i < 4; ++i) add(p.ffn_w2 + (size_t)i * DFF * 1024, p.wt2 + (size_t)i * 1024 * DFF, DFF, 1024, 1024, 0, 1024);
  add(p.mix0_in_w, p.wtin0, 1024, IN0, IN0, 0, IN0);
  add(p.mix0_out_w, p.wtout0, 1024, 1024, 1024, 0, 1024);
  add(p.mix1_in_w, p.wtin1, 1024, IN1, IN1, 0, IN1P);
  add(p.mix1_out_w, p.wtout1, 1024, 1024, 1024, 0, 1024);
  for (int kv = 0; kv < 2; ++kv)
    for (int hf = 0; hf < 2; ++hf)
      add(p.cmp_w1 + ((size_t)kv * 2048 + hf * 1024) * 128, p.wtcmp + ((size_t)kv * 256 + hf * 128) * 1024, 1024, 128, 128, 0, 128);
  for (int n = 0; n < 8; ++n) add(p.wa + (size_t)n * 4096, p.wat + (size_t)n * 4096, 64, 64, 64, 0, 64);
  for (int n = 0; n < 8; ++n) add(p.wx + (size_t)n * 4096, p.wat + (size_t)(8 + n) * 4096, 64, 64, 64, 0, 64);
  p.njobs = nj;
  p.ntr_tiles = t0;

  static int grid_blocks = 0;
  if (!grid_blocks) {
    int dev = 0, cus = 0, per_cu = 0;
    (void)hipGetDevice(&dev);
    (void)hipDeviceGetAttribute(&cus, hipDeviceAttributeMultiprocessorCount, dev);
    (void)hipOccupancyMaxActiveBlocksPerMultiprocessor(&per_cu, fwd_kernel, NTHR, 0);
    if (per_cu < 1) per_cu = 1;
    grid_blocks = cus * 1;
  }
  void* args[] = {&p};
  hipError_t e = hipLaunchCooperativeKernel((void*)fwd_kernel, dim3(grid_blocks), dim3(NTHR), args, 0, stream);
  if (e != hipSuccess) fprintf(stderr, "cooperative launch failed: %s (grid %d)\n", hipGetErrorString(e), grid_blocks);
}
```

```cpp
#include <hip/hip_runtime.h>
#include <hip/hip_cooperative_groups.h>
#include <stdint.h>
#include <stdio.h>
#include <string.h>
namespace cg = cooperative_groups;

typedef unsigned short u16;
typedef __attribute__((ext_vector_type(8))) short bf16x8;
typedef __attribute__((ext_vector_type(4))) short s16x4;
typedef __attribute__((ext_vector_type(4))) float f32x4;
typedef __attribute__((ext_vector_type(16))) float f32x16;
typedef __attribute__((ext_vector_type(4))) int i32x4;
typedef __attribute__((ext_vector_type(4))) unsigned u32x4;
typedef __attribute__((ext_vector_type(2))) unsigned u32x2;

#define DI __device__ __forceinline__
#define MFMA32(a, b, c) __builtin_amdgcn_mfma_f32_32x32x16_bf16((a), (b), (c), 0, 0, 0)
#define MFMA16(a, b, c) __builtin_amdgcn_mfma_f32_16x16x32_bf16((a), (b), (c), 0, 0, 0)

constexpr int NB = 4, SEQ = 8192, DM = 1024, NT = NB * SEQ, DFF = 2816;
constexpr int IN0 = 2560, IN1 = 1840, IN1P = 2048;
constexpr int NTHR = 512;
constexpr int NJOBS = 32;

struct TJob { const float* src; u16* dst; int K, N, ldn, perm, tile0, ntn; };

struct Params {
  const float *x, *c, *mod_w, *mod_b, *norm_g, *ffn_w1, *ffn_w2, *mix0_in_w, *conv_w, *conv_b, *wa, *ba, *wx, *bx, *lam,
      *mix0_out_w, *mix1_in_w, *cmp_pos, *cmp_w1, *cmp_w2, *mix1_out_w, *fng;
  float* out;
  u16 *wt1, *wt2, *wtin0, *wtout0, *wtin1, *wtout1, *wtcmp, *wat;
  float *mod, *rope, *cvec, *cent, *lrusum, *pq;
  u16 *h, *big, *vt, *kcmp, *vcmpT;
  unsigned *mcnt, *mlist, *ctr, *xcnt, *lbar;
  u16* part;
  TJob jobs[NJOBS];
  int njobs, ntr_tiles;
};

typedef const __attribute__((address_space(4))) Params* PP;
DI PP launder_p(PP p) { asm volatile("" : "+s"(p)); return p; }

typedef __attribute__((ext_vector_type(2))) float f32x2_;
typedef __attribute__((ext_vector_type(2))) __bf16 bf16x2_;
DI uint32_t pack2(float a, float b) {
  f32x2_ v = {a, b};
  return __builtin_bit_cast(uint32_t, __builtin_convertvector(v, bf16x2_));
}
DI u16 f2bf(float f) { return (u16)(pack2(f, 0.f) & 0xffffu); }
DI float bf2f(u16 h) { return __uint_as_float(((uint32_t)h) << 16); }
DI float bflo(uint32_t w) { return __uint_as_float(w << 16); }
DI float bfhi(uint32_t w) { return __uint_as_float(w & 0xffff0000u); }

DI void wt16(u16* p, u16 v) { *p = v; }
DI void wt32u(unsigned* p, unsigned v) { *p = v; }
DI void wt32f(float* p, float v) { *p = v; }
DI void wt64(void* p, u32x2 v) { *(u32x2*)p = v; }
DI void wt128(void* p, u32x4 v) { *(u32x4*)p = v; }
DI bf16x8 pack8(float a0, float a1, float a2, float a3, float a4, float a5, float a6, float a7) {
  u32x4 p;
  asm volatile("v_cvt_pk_bf16_f32 %0, %4, %5\n\tv_cvt_pk_bf16_f32 %1, %6, %7\n\tv_cvt_pk_bf16_f32 %2, %8, %9\n\tv_cvt_pk_bf16_f32 %3, %10, %11\n\ts_nop 1"
               : "=&v"(p[0]), "=&v"(p[1]), "=&v"(p[2]), "=&v"(p[3])
               : "v"(a0), "v"(a1), "v"(a2), "v"(a3), "v"(a4), "v"(a5), "v"(a6), "v"(a7));
  return __builtin_bit_cast(bf16x8, p);
}
DI int launder(int v) { asm volatile("" : "+v"(v)); return v; }
DI int lane_id_() { int l = __builtin_amdgcn_mbcnt_hi(-1, __builtin_amdgcn_mbcnt_lo(-1, 0)); asm volatile("" : "+v"(l)); return l; }
DI int grab_begin(int ws, unsigned* ctr) {
  int v = 0;
  if (ws == 0 && lane_id_() == 0) v = (int)atomicAdd(ctr, 1u);
  return v;
}
DI int grab_end(int ws, int v, char* shm) {
  int* slot = (int*)(shm + 150016);
  __syncthreads();
  if (ws == 0 && lane_id_() == 0) *slot = v;
  __syncthreads();
  return *slot;
}
DI int grab(int ws, unsigned* ctr, char* shm) { return grab_end(ws, grab_begin(ws, ctr), shm); }
DI int mytid(int ws) { return launder(ws * 64 + lane_id_()); }
template <int M> DI int shxi(int v) {
  if (M < 32) return __builtin_amdgcn_ds_swizzle(v, (M << 10) | 0x1f);
  auto r = __builtin_amdgcn_permlane32_swap((unsigned)v, (unsigned)v, false, false);
  return (int)(r[0] ^ r[1] ^ (unsigned)v);
}
DI float sum8(float v) {
  v += __int_as_float(__builtin_amdgcn_update_dpp(0, __float_as_int(v), 0xB1, 0xF, 0xF, true));
  v += __int_as_float(__builtin_amdgcn_update_dpp(0, __float_as_int(v), 0x4E, 0xF, 0xF, true));
  v += __int_as_float(__builtin_amdgcn_update_dpp(0, __float_as_int(v), 0x141, 0xF, 0xF, true));
  return v;
}
DI float dppx1(float v) { return __int_as_float(__builtin_amdgcn_update_dpp(0, __float_as_int(v), 0xB1, 0xF, 0xF, true)); }
DI void store_pair_bf16(u16* base_even, long ld, bool odd, float v0, float v1, float v2, float v3) {
  const float sx = odd ? v0 : v2, sy = odd ? v1 : v3;
  const float rx = dppx1(sx), ry = dppx1(sy);
  const uint32_t p0 = odd ? pack2(rx, v2) : pack2(v0, rx);
  const uint32_t p1 = odd ? pack2(ry, v3) : pack2(v1, ry);
  u16* q = base_even + (odd ? 2 * ld : 0);
  *(uint32_t*)q = p0;
  *(uint32_t*)(q + ld) = p1;
}
DI void rmw_pair_f32(float* xo_even, const float* xi_even, long ld, bool odd, float v0, float v1, float v2, float v3) {
  const float sx = odd ? v0 : v2, sy = odd ? v1 : v3;
  const float rx = dppx1(sx), ry = dppx1(sy);
  const long off = odd ? 2 * ld : 0;
  const float2 a0 = *(const float2*)(xi_even + off), a1 = *(const float2*)(xi_even + off + ld);
  float2 o0, o1;
  if (odd) { o0 = float2{a0.x + rx, a0.y + v2}; o1 = float2{a1.x + ry, a1.y + v3}; }
  else     { o0 = float2{a0.x + v0, a0.y + rx}; o1 = float2{a1.x + v1, a1.y + ry}; }
  *(float2*)(xo_even + off) = o0;
  *(float2*)(xo_even + off + ld) = o1;
}
DI float xmax32(float v) {
  auto r = __builtin_amdgcn_permlane32_swap(__float_as_uint(v), __float_as_uint(v), false, false);
  return fmaxf(__uint_as_float(r[0]), __uint_as_float(r[1]));
}
DI float xsum32(float v) {
  auto r = __builtin_amdgcn_permlane32_swap(__float_as_uint(v), __float_as_uint(v), false, false);
  return __uint_as_float(r[0]) + __uint_as_float(r[1]);
}
template <int M> DI float shxf(float v) { return __int_as_float(shxi<M>(__float_as_int(v))); }
DI float sigmoidf_(float x) { return __builtin_amdgcn_rcpf(1.f + __expf(-x)); }
DI float gelu_tanh(float x) {
  const float z = 0.7978845608028654f * (x + 0.044715f * x * x * x);
  const float th = 1.f - 2.f * __builtin_amdgcn_rcpf(1.f + __expf(2.f * z));
  return 0.5f * x * (1.f + th);
}

template <int KS> DI int lds_byte(int r, int c) {
  int st = (r >> 4) * KS + (c >> 5), ob = (r & 15) * 64 + (c & 31) * 2;
  return st * 1024 + (ob ^ (((ob >> 9) & 1) << 5));
}
template <int KS> DI void stage_rc(int b, int& R, int& C) {
  int st = b >> 10, sb = b & 1023, swz = sb ^ (((sb >> 9) & 1) << 5);
  R = (st / KS) * 16 + swz / 64;
  C = (st % KS) * 32 + (swz % 64) / 2;
}
#define WAIT_V(n) asm volatile("s_waitcnt vmcnt(%0)" ::"n"(n) : "memory")

struct TileDesc { const u16* a; long lda, kts; const u16* b; long ldb; int nt; };

typedef f32x4 Acc8[2][2][4][2];
template <class Epi>
DI void gemm_tile(int ws, char* shmc, const TileDesc& td, Epi& epi, int pm, int pn, bool first, bool has_next, const TileDesc& tdn) {
  constexpr int BK = 64, HALF = 128, HT = HALF * BK;
  u16* shm = (u16*)shmc;
  const int tid = mytid(ws), wid = tid >> 6, lane = tid & 63, wr = wid >> 2, wc = wid & 3, fr = lane & 15, fq = lane >> 4;
  const u16* ABASE = td.a;
  const u16* BBASE = td.b;
  const long lda = td.lda, kts = td.kts, ldb = td.ldb;
  const int nt = td.nt;
#define SA(b, h) (shm + ((b) * 2 + (h)) * HT)
#define SB(b, h) (shm + (4 + (b) * 2 + (h)) * HT)
  unsigned voffA, voffB;
  {
    int r0_, c0_;
    stage_rc<2>(tid * 16, r0_, c0_);
    voffA = (unsigned)(r0_ * (int)lda + c0_);
    voffB = (unsigned)(r0_ * (int)ldb + c0_);
  }
#define STAGE_A(P, hf, kt)                                                                                     \
  do {                                                                                                         \
    _Pragma("unroll") for (int _i = 0; _i < 2; ++_i)                                                           \
      __builtin_amdgcn_global_load_lds((const unsigned*)((ABASE + (long)((hf) * HALF + 64 * _i) * lda + (long)(kt) * kts) + voffA), \
                                       (__attribute__((address_space(3))) unsigned*)((char*)(P) + tid * 16 + _i * 8192), 16, 0, 0); \
  } while (0)
#define STAGE_B(P, hf, kt)                                                                                     \
  do {                                                                                                         \
    _Pragma("unroll") for (int _i = 0; _i < 2; ++_i)                                                           \
      __builtin_amdgcn_global_load_lds((const unsigned*)((BBASE + (long)((hf) * HALF + 64 * _i) * ldb + (long)(kt) * BK) + voffB), \
                                       (__attribute__((address_space(3))) unsigned*)((char*)(P) + tid * 16 + _i * 8192), 16, 0, 0); \
  } while (0)
#define LDA_(dst, b, h)                                    \
  _Pragma("unroll") for (int m = 0; m < 4; ++m)            \
  _Pragma("unroll") for (int k = 0; k < 2; ++k)            \
      dst[m][k] = *(const bf16x8*)((const char*)SA(b, h) + lds_byte<2>(wr * 64 + m * 16 + fr, k * 32 + fq * 8))
#define LDB_(dst, b, h)                                    \
  _Pragma("unroll") for (int n = 0; n < 2; ++n)            \
  _Pragma("unroll") for (int k = 0; k < 2; ++k)            \
      dst[n][k] = *(const bf16x8*)((const char*)SB(b, h) + lds_byte<2>(wc * 32 + n * 16 + fr, k * 32 + fq * 8))
#define MMA_(ai, bj, AT, BT)                                                           \
  do {                                                                                 \
    __builtin_amdgcn_s_setprio(1);                                                     \
    _Pragma("unroll") for (int m = 0; m < 4; ++m)                                      \
    _Pragma("unroll") for (int n = 0; n < 2; ++n)                                      \
    _Pragma("unroll") for (int k = 0; k < 2; ++k)                                      \
        acc[ai][bj][m][n] = MFMA16(AT[m][k], BT[n][k], acc[ai][bj][m][n]);             \
    __builtin_amdgcn_s_setprio(0);                                                     \
  } while (0)
#define WV(n) asm volatile("s_waitcnt vmcnt(" #n ")" ::: "memory")
#define WL(n) asm volatile("s_waitcnt lgkmcnt(" #n ")" ::: "memory")
#define BAR __builtin_amdgcn_s_barrier()
#define SCHED __builtin_amdgcn_sched_barrier(0)
  Acc8 acc;
#pragma unroll
  for (int a = 0; a < 2; ++a)
#pragma unroll
    for (int b = 0; b < 2; ++b)
#pragma unroll
      for (int m = 0; m < 4; ++m)
#pragma unroll
        for (int n = 0; n < 2; ++n) acc[a][b][m][n] = f32x4{0.f, 0.f, 0.f, 0.f};
  bf16x8 At[4][2], B0[2][2], B1[2][2];
  if (first) {
    STAGE_B(SB(0, 0), 0, 0); STAGE_A(SA(0, 0), 0, 0);
    STAGE_B(SB(0, 1), 1, 0); STAGE_A(SA(0, 1), 1, 0);
  }
  if (wr == 1) BAR;
  WV(4); BAR;
  STAGE_B(SB(1, 0), 0, 1); STAGE_A(SA(1, 0), 0, 1); STAGE_B(SB(1, 1), 1, 1);
  WV(6); BAR;
  for (int t = 0; t < nt - 2; t += 2) {
    LDB_(B0, 0, 0); SCHED; LDA_(At, 0, 0); STAGE_A(SA(1, 1), 1, t + 1);
    WL(8); BAR; WL(0); MMA_(0, 0, At, B0); BAR; SCHED;
    LDB_(B1, 0, 1); STAGE_B(SB(0, 0), 0, t + 2);
    BAR; WL(0); MMA_(0, 1, At, B1); BAR;
    LDA_(At, 0, 1); STAGE_A(SA(0, 0), 0, t + 2);
    BAR; WL(0); MMA_(1, 0, At, B0); BAR; SCHED;
    STAGE_B(SB(0, 1), 1, t + 2);
    WV(6); BAR; MMA_(1, 1, At, B1); BAR;
    LDB_(B0, 1, 0); SCHED; LDA_(At, 1, 0); STAGE_A(SA(0, 1), 1, t + 2);
    WL(8); BAR; WL(0); MMA_(0, 0, At, B0); BAR; SCHED;
    LDB_(B1, 1, 1); STAGE_B(SB(1, 0), 0, t + 3);
    BAR; WL(0); MMA_(0, 1, At, B1); BAR;
    LDA_(At, 1, 1); STAGE_A(SA(1, 0), 0, t + 3);
    BAR; WL(0); MMA_(1, 0, At, B0); BAR; SCHED;
    STAGE_B(SB(1, 1), 1, t + 3);
    WV(6); BAR; MMA_(1, 1, At, B1); BAR;
  }
  { LDB_(B0, 0, 0); LDA_(At, 0, 0); STAGE_A(SA(1, 1), 1, nt - 1);
    BAR; WL(0); MMA_(0, 0, At, B0); BAR;
    LDB_(B1, 0, 1); BAR; WL(0); MMA_(0, 1, At, B1); BAR;
    LDA_(At, 0, 1); WV(4); BAR; WL(0); MMA_(1, 0, At, B0); MMA_(1, 1, At, B1); BAR; }
  { LDB_(B0, 1, 0); LDA_(At, 1, 0); WV(2); BAR; WL(0); MMA_(0, 0, At, B0); BAR;
    LDB_(B1, 1, 1); WV(0); BAR; WL(0); MMA_(0, 1, At, B1); BAR;
    LDA_(At, 1, 1); BAR; WL(0); MMA_(1, 0, At, B0); MMA_(1, 1, At, B1); BAR; }
  if (wr == 0) BAR;
  if (has_next) {
    ABASE = tdn.a;
    BBASE = tdn.b;
    STAGE_B(SB(0, 0), 0, 0); STAGE_A(SA(0, 0), 0, 0);
    STAGE_B(SB(0, 1), 1, 0); STAGE_A(SA(0, 1), 1, 0);
  }
  epi(pm, pn, acc, wr, wc, fr, fq);
  asm volatile("s_waitcnt vmcnt(0)" ::: "memory");
  __syncthreads();
#undef SA
#undef SB
#undef STAGE_A
#undef STAGE_B
#undef LDA_
#undef LDB_
#undef MMA_
#undef WV
#undef WL
#undef BAR
#undef SCHED
}

template <class Desc, class Epi>
DI void gemm_phase(int ws, int gx, int gslot, char* shm, int nM, int nN, Desc desc, Epi epi) {
  const int ntiles = nM * nN;
  const int G = gridDim.x, bid = blockIdx.x;
  const bool xcdmap = (G % 8 == 0) && (ntiles % 8 == 0);
  const int per = ntiles / 8, slots = G / 8;
  auto tile_at = [&](int i, int& pm, int& pn) -> bool {
    int t;
    if (xcdmap) {
      int lt = gslot + slots * i;
      if (lt >= per) return false;
      t = gx * per + lt;
    } else {
      t = bid + G * i;
      if (t >= ntiles) return false;
    }
    const int WGM = 8;
    int nig = WGM * nN, gid = t / nig, fm = gid * WGM, gsz = min(nM - fm, WGM);
    pm = fm + ((t % nig) % gsz);
    pn = (t % nig) / gsz;
    return true;
  };
  __syncthreads();
  int pm, pn;
  if (!tile_at(0, pm, pn)) return;
  TileDesc td = desc(pm, pn);
  bool first = true;
  for (int i = 0;; ++i) {
    int pmn = 0, pnn = 0;
    const bool more = tile_at(i + 1, pmn, pnn);
    TileDesc tdn = td;
    if (more) tdn = desc(pmn, pnn);
    gemm_tile(ws, shm, td, epi, pm, pn, first, more, tdn);
    if (!more) break;
    td = tdn; pm = pmn; pn = pnn; first = false;
  }
}

DI float wave_sum(float v) {
  v += shxf<32>(v); v += shxf<16>(v); v += shxf<8>(v); v += shxf<4>(v); v += shxf<2>(v); v += shxf<1>(v);
  return v;
}

DI void norm_rows4(int ws, int gx, int gslot, const float* x, u16* __restrict__ h, float* xout, const float* __restrict__ g,
                   const float* __restrict__ shift, const float* __restrict__ scale, bool fin) {
  const int tid_ = mytid(ws), wid = tid_ >> 6, lane = tid_ & 63;
  const int rbase = gx * (NT / 8) + gslot * (NT / 8 / (gridDim.x / 8)) + wid * (NT / 8 / (gridDim.x / 8) / 8);
  const int rcnt = NT / 8 / (gridDim.x / 8) / 8;
  const int b = rbase >> 13;
  float4 mul[4], add[4];
#pragma unroll
  for (int i = 0; i < 4; ++i) {
    const int c4 = lane + 64 * i;
    const float4 gg = ((const float4*)g)[c4];
    if (fin) {
      mul[i] = gg;
      add[i] = float4{0.f, 0.f, 0.f, 0.f};
    } else {
      const float4 sc = ((const float4*)(scale + (long)b * 9216))[c4];
      mul[i] = float4{gg.x * (1.f + sc.x), gg.y * (1.f + sc.y), gg.z * (1.f + sc.z), gg.w * (1.f + sc.w)};
      add[i] = ((const float4*)(shift + (long)b * 9216))[c4];
    }
  }
#pragma unroll 1
  for (int r = 0; r < rcnt; r += 4) {
    float4 v[4][4];
    float rs[4];
#pragma unroll
    for (int q = 0; q < 4; ++q) {
      const float4* xr = (const float4*)(x + (long)(rbase + r + q) * DM);
#pragma unroll
      for (int i = 0; i < 4; ++i) v[q][i] = xr[lane + 64 * i];
    }
#pragma unroll
    for (int q = 0; q < 4; ++q) {
      float a = 0.f;
#pragma unroll
      for (int i = 0; i < 4; ++i) a += v[q][i].x * v[q][i].x + v[q][i].y * v[q][i].y + v[q][i].z * v[q][i].z + v[q][i].w * v[q][i].w;
      rs[q] = rsqrtf(wave_sum(a) * (1.f / DM) + 1e-6f);
    }
#pragma unroll
    for (int q = 0; q < 4; ++q) {
      const long row = rbase + r + q;
#pragma unroll
      for (int i = 0; i < 4; ++i) {
        const int c4 = lane + 64 * i;
        const float y0 = v[q][i].x * rs[q] * mul[i].x + add[i].x, y1 = v[q][i].y * rs[q] * mul[i].y + add[i].y;
        const float y2 = v[q][i].z * rs[q] * mul[i].z + add[i].z, y3 = v[q][i].w * rs[q] * mul[i].w + add[i].w;
        if (fin) {
          ((float4*)(xout + row * DM))[c4] = float4{y0, y1, y2, y3};
        } else {
          u32x2 pk = {pack2(y0, y1), pack2(y2, y3)};
          wt64(h + row * DM + c4 * 4, pk);
        }
      }
    }
  }
}
DI void norm_phase(int ws, int gx, int gslot, const float* __restrict__ x, u16* __restrict__ h, const float* __restrict__ g, const float* __restrict__ shift,
                   const float* __restrict__ scale  ) {
  norm_rows4(ws, gx, gslot, x, h, nullptr, g, shift, scale, false);
}
DI void final_norm_phase(int ws, int gx, int gslot, float* __restrict__ x, const float* __restrict__ g) {
  norm_rows4(ws, gx, gslot, x, nullptr, x, g, g, g, true);
}

DI void prep_phase(int ws, PP p, char* shm) {
  const int tid = mytid(ws);
  float* fs = (float*)shm;
  const int n_tr = p->ntr_tiles;
  const int n_mod = 2 * 144;
  const int n_cv = 8;
  const int n_rope = 128;
  const int n_misc = 1;
  const int total = n_tr + n_mod + n_cv + n_rope + n_misc;
  for (int it = blockIdx.x; it < total; it += gridDim.x) {
    if (it < n_tr) {
      int j = 0;
      for (int q = 1; q < p->njobs; ++q)
        if (it >= p->jobs[q].tile0) j = q;
      TJob jb;
      jb.src = p->jobs[j].src; jb.dst = p->jobs[j].dst; jb.K = p->jobs[j].K; jb.N = p->jobs[j].N; jb.ldn = p->jobs[j].ldn; jb.perm = p->jobs[j].perm; jb.tile0 = p->jobs[j].tile0; jb.ntn = p->jobs[j].ntn;
      const int lt = it - jb.tile0;
      const int ngn = (jb.ntn + 3) >> 2;
      const int tk = lt / ngn, tg4 = lt % ngn;
      const int k0 = tk * 64;
      float4 v[4][2];
#pragma unroll
      for (int u = 0; u < 4; ++u)
#pragma unroll
        for (int rep = 0; rep < 2; ++rep) {
          const int idx = tid + rep * 512, r = idx >> 4, c4 = idx & 15;
          const int n = (tg4 * 4 + u) * 64 + c4 * 4;
          v[u][rep] = float4{0.f, 0.f, 0.f, 0.f};
          if (tg4 * 4 + u < jb.ntn && n < jb.N) v[u][rep] = *(const float4*)(jb.src + (long)(k0 + r) * jb.ldn + n);
        }
#pragma unroll
      for (int u = 0; u < 4; ++u)
#pragma unroll
        for (int rep = 0; rep < 2; ++rep) {
          const int idx = tid + rep * 512, r = idx >> 4, c4 = idx & 15;
          float* f = fs + u * (64 * 65) + r * 65 + c4 * 4;
          f[0] = v[u][rep].x; f[1] = v[u][rep].y; f[2] = v[u][rep].z; f[3] = v[u][rep].w;
        }
      __syncthreads();
#pragma unroll
      for (int u = 0; u < 4; ++u) {
        if (tg4 * 4 + u < jb.ntn) {
          const int n = tid >> 3, ks = tid & 7;
          float e[8];
#pragma unroll
          for (int q = 0; q < 8; ++q) e[q] = fs[u * (64 * 65) + (ks * 8 + q) * 65 + n];
          int ng = (tg4 * 4 + u) * 64 + n, drow = ng;
          if (jb.perm == 1) {
            int isb = ng >= DFF ? 1 : 0, jj = ng - isb * DFF;
            drow = (jj >> 4) * 32 + isb * 16 + (jj & 15);
          }
          u32x4 pk = {pack2(e[0], e[1]), pack2(e[2], e[3]), pack2(e[4], e[5]), pack2(e[6], e[7])};
          wt128(jb.dst + (long)drow * jb.K + k0 + ks * 8, pk);
        }
      }
      __syncthreads();
    } else if (it < n_tr + n_mod) {
      const int q = it - n_tr, l = q / 144, cg0 = (q % 144) * 64;
      for (int i = tid; i < 4096; i += NTHR) {
        float cv = p->c[i];
        fs[i] = cv / (1.f + __expf(-cv));
      }
      __syncthreads();
      const int col = tid & 63, kg = tid >> 6;
      const float* w = p->mod_w + (long)l * DM * 9216 + cg0 + col;
      float a0 = 0.f, a1 = 0.f, a2 = 0.f, a3 = 0.f;
#pragma unroll 16
      for (int k = kg * 128; k < kg * 128 + 128; ++k) {
        float wv = w[(long)k * 9216];
        a0 += fs[k] * wv;
        a1 += fs[1024 + k] * wv;
        a2 += fs[2048 + k] * wv;
        a3 += fs[3072 + k] * wv;
      }
      __syncthreads();
      float* red = fs;
      red[(kg * 4 + 0) * 64 + col] = a0;
      red[(kg * 4 + 1) * 64 + col] = a1;
      red[(kg * 4 + 2) * 64 + col] = a2;
      red[(kg * 4 + 3) * 64 + col] = a3;
      __syncthreads();
      if (tid < 256) {
        int b = tid >> 6;
        float s = 0.f;
#pragma unroll
        for (int g = 0; g < 8; ++g) s += red[(g * 4 + b) * 64 + col];
        wt32f(p->mod + ((long)l * 4 + b) * 9216 + cg0 + col, s + p->mod_b[(long)l * 9216 + cg0 + col]);
      }
      __syncthreads();
    } else if (it < n_tr + n_mod + n_cv) {
      const int q = it - n_tr - n_mod, kv = q >> 2, n = (q & 3) * 32 + (tid & 31), kg = tid >> 5;
      const float* w1 = p->cmp_w1 + (long)kv * 2048 * 128;
      const float* pe = p->cmp_pos + (long)kv * 2048;
      float a = 0.f;
      for (int k = kg * 128; k < kg * 128 + 128; ++k) a += pe[k] * w1[(long)k * 128 + n];
      fs[kg * 32 + (tid & 31)] = a;
      __syncthreads();
      if (tid < 32) {
        float s = 0.f;
        for (int g = 0; g < 16; ++g) s += fs[g * 32 + tid];
        p->cvec[kv * 128 + (q & 3) * 32 + tid] = s;
      }
      __syncthreads();
    } else if (it < n_tr + n_mod + n_cv + n_rope) {
      const int q = it - n_tr - n_mod - n_cv;
      const int e = q * 512 + tid, pos = e >> 3, i = e & 7;
      const float freq = powf(500000.f, -(float)i * 0.125f);
      const float angf = (float)pos * freq;
      const double ang = (double)angf;
      const double n = rint(ang * 0.15915494309189535);
      double r = fma(-n, 6.283185307179586, ang);
      r = fma(-n, 2.4492935982947064e-16, r);
      const float rf = (float)r;
      p->rope[pos * 16 + i] = cosf(rf);
      p->rope[pos * 16 + 8 + i] = sinf(rf);
    } else {
      if (tid < 512) {
        int bg = tid >> 6, d = tid & 63;
        p->kcmp[((long)bg * 512 + 511) * 64 + d] = 0;
        p->vcmpT[((long)bg * 64 + d) * 512 + 511] = 0;
        p->mcnt[tid] = 0u;
        p->mcnt[512 + tid] = 0u;
        if (tid < 64) { p->ctr[tid] = 0u; p->xcnt[tid] = 0u; }
        p->lbar[tid] = 0u;
      }
    }
  }
}

constexpr int KVS = 72;
constexpr int KVT = 64 * KVS;
constexpr float SCL2 = 0.125f * 1.4426950408889634f;

DI void qk_tile(const u16* Ks, const bf16x8* qf, f32x16* s, int rl, int hh) {
#pragma unroll
  for (int kb = 0; kb < 2; ++kb) {
#pragma unroll
    for (int i = 0; i < 16; ++i) s[kb][i] = 0.f;
#pragma unroll
    for (int ks = 0; ks < 4; ++ks) {
      bf16x8 a = *(const bf16x8*)(Ks + (kb * 32 + rl) * KVS + ks * 16 + hh * 8);
      s[kb] = MFMA32(a, qf[ks], s[kb]);
    }
  }
}
DI void pv_tile(const u16* Vs, const f32x16* s, f32x16* o, int rl, int hh) {
#pragma unroll
  for (int kk = 0; kk < 4; ++kk) {
    const int kb = kk >> 1, i0 = 8 * (kk & 1);
    bf16x8 pf = pack8(s[kb][i0], s[kb][i0 + 1], s[kb][i0 + 2], s[kb][i0 + 3], s[kb][i0 + 4], s[kb][i0 + 5], s[kb][i0 + 6], s[kb][i0 + 7]);
#pragma unroll
    for (int db = 0; db < 2; ++db) {
      const u16* vp = Vs + (db * 32 + rl) * KVS + kk * 16 + hh * 4;
      s16x4 lo = *(const s16x4*)vp, hi = *(const s16x4*)(vp + 8);
      bf16x8 a = __builtin_shufflevector(lo, hi, 0, 1, 2, 3, 4, 5, 6, 7);
      o[db] = MFMA32(a, pf, o[db]);
    }
  }
}
DI float fexp2(float x) { return __builtin_amdgcn_exp2f(x); }
template <int MODE>
DI void osm(f32x16* s, uint32_t vm, float& m, float& l, f32x16* o) {
  float mx = -1e30f;
#pragma unroll
  for (int kb = 0; kb < 2; ++kb)
#pragma unroll
    for (int i = 0; i < 16; ++i) {
      if (MODE == 2) s[kb][i] = ((vm >> (kb * 16 + i)) & 1u) ? s[kb][i] : -1e30f;
      mx = fmaxf(mx, s[kb][i]);
    }
  mx *= SCL2;
  if (MODE == 1) mx = vm ? mx : -1e30f;
  mx = xmax32(mx);
  const float mn = fmaxf(m, mx);
  const float alpha = fexp2(m - mn);
  const bool rowok = (MODE == 1) ? (vm != 0u) : true;
  const float mu = (rowok && mn > -1e29f) ? mn : 1e30f;
  float rs = 0.f;
#pragma unroll
  for (int kb = 0; kb < 2; ++kb)
#pragma unroll
    for (int i = 0; i < 16; ++i) {
      const float pv = fexp2(__builtin_fmaf(s[kb][i], SCL2, -mu));
      s[kb][i] = pv;
      rs += pv;
    }
  rs = xsum32(rs);
  l = l * alpha + rs;
  if (__ballot(mn > m) != 0ull) {
#pragma unroll
    for (int db = 0; db < 2; ++db)
#pragma unroll
      for (int i = 0; i < 16; ++i) o[db][i] *= alpha;
  }
  m = mn;
}
DI void online_softmax(f32x16* s, uint32_t vm, float& m, float& l, f32x16* o) {
  const unsigned long long ball = __ballot(vm == 0xffffffffu), bnone = __ballot(vm == 0u);
  if (ball == ~0ull) osm<0>(s, vm, m, l, o);
  else if ((ball | bnone) == ~0ull) osm<1>(s, vm, m, l, o);
  else osm<2>(s, vm, m, l, o);
}
DI uint32_t range_mask(int kpos0, int lo, int hi, int hh) {
  if (kpos0 >= lo && kpos0 + 63 <= hi) return 0xffffffffu;
  if (kpos0 > hi || kpos0 + 63 < lo) return 0u;
  uint32_t vm = 0;
#pragma unroll
  for (int kb = 0; kb < 2; ++kb)
#pragma unroll
    for (int i = 0; i < 16; ++i) {
      int kp = kpos0 + kb * 32 + hh * 4 + (i & 3) + 8 * (i >> 2);
      vm |= (kp >= lo && kp <= hi) ? (1u << (kb * 16 + i)) : 0u;
    }
  return vm;
}

struct KVRegs { u32x4 k, v; };
DI void kv_issue(KVRegs& r, const u16* kptr, long ldk, const u16* vptr, long ldv, int tid) {
  const int row = tid >> 3, seg = tid & 7;
  r.k = *(const u32x4*)(kptr + (long)row * ldk + seg * 8);
  r.v = *(const u32x4*)(vptr + (long)row * ldv + seg * 8);
}
DI void kv_write(const KVRegs& r, u16* Ks, u16* Vs, int tid) {
  const int row = tid >> 3, seg = tid & 7;
  *(u32x4*)(Ks + row * KVS + seg * 8) = r.k;
  *(u32x4*)(Vs + row * KVS + seg * 8) = r.v;
}
template <class TF, class BODY>
DI void kv_loop(u16* kvb, int ntiles, int tid, TF tf, BODY body) {
  KVRegs r;
  const u16 *kp, *vp;
  long ldk, ldv;
  __syncthreads();
  if (ntiles > 0) {
    tf(0, kp, ldk, vp, ldv);
    kv_issue(r, kp, ldk, vp, ldv, tid);
    kv_write(r, kvb, kvb + KVT, tid);
  }
  __syncthreads();
  for (int i = 0; i < ntiles; ++i) {
    const int cur = i & 1;
    if (i + 1 < ntiles) {
      tf(i + 1, kp, ldk, vp, ldv);
      kv_issue(r, kp, ldk, vp, ldv, tid);
    }
    body(i, kvb + cur * 2 * KVT, kvb + cur * 2 * KVT + KVT);
    if (i + 1 < ntiles) kv_write(r, kvb + (cur ^ 1) * 2 * KVT, kvb + (cur ^ 1) * 2 * KVT + KVT, tid);
    __syncthreads();
  }
}
DI void load_qf(bf16x8* qf, const u16* qrow, int hh) {
#pragma unroll
  for (int ks = 0; ks < 4; ++ks) qf[ks] = *(const bf16x8*)(qrow + ks * 16 + hh * 8);
}
DI bf16x8 rope_frag(bf16x8 f, const float* cs  , int hh) {
  u32x4 w = __builtin_bit_cast(u32x4, f), ow;
#pragma unroll
  for (int q = 0; q < 4; ++q) ow[q] = shxi<32>((int)w[q]);
  float mine[8], oth[8], res[8];
#pragma unroll
  for (int q = 0; q < 4; ++q) {
    mine[2 * q] = bflo(w[q]); mine[2 * q + 1] = bfhi(w[q]);
    oth[2 * q] = bflo(ow[q]); oth[2 * q + 1] = bfhi(ow[q]);
  }
  const float sg = hh ? 1.f : -1.f;
#pragma unroll
  for (int i = 0; i < 8; ++i) res[i] = mine[i] * cs[i] + sg * oth[i] * cs[8 + i];
  u32x4 r = {pack2(res[0], res[1]), pack2(res[2], res[3]), pack2(res[4], res[5]), pack2(res[6], res[7])};
  return __builtin_bit_cast(bf16x8, r);
}
DI void store_o(u16* yrow, const f32x16* o, float scale, int hh) {
#pragma unroll
  for (int db = 0; db < 2; ++db)
#pragma unroll
    for (int q = 0; q < 4; ++q) {
      u32x2 pk = {pack2(o[db][4 * q] * scale, o[db][4 * q + 1] * scale), pack2(o[db][4 * q + 2] * scale, o[db][4 * q + 3] * scale)};
      wt64(yrow + db * 32 + 8 * q + 4 * hh, pk);
    }
}

DI void kprep0_phase(int ws, PP p, char* shm) {
  const int tid = mytid(ws);
  float* fs = (float*)shm;
  u16* u = p->big;
  for (int item = blockIdx.x; item < 256; item += gridDim.x) {
    const int b = item >> 6, n = (item >> 1) & 31, hg = item & 1;
    const int cc = tid & 31, tg = tid >> 5, head = hg * 4 + (cc >> 3), dch = cc & 7;
    float sum[8];
#pragma unroll
    for (int e = 0; e < 8; ++e) sum[e] = 0.f;
#pragma unroll 1
    for (int tb = 0; tb < 16; tb += 8) {
    u32x4 wv[8];
#pragma unroll
    for (int t8 = 0; t8 < 8; ++t8) wv[t8] = *(const u32x4*)(u + ((long)b * SEQ + n * 256 + tg * 16 + tb + t8) * IN0 + 1536 + head * 64 + dch * 8);
#pragma unroll
    for (int t8 = 0; t8 < 8; ++t8) {
      const int tt = tb + t8;
      const int tok = n * 256 + tg * 16 + tt;
      u16* ptr = u + ((long)b * SEQ + tok) * IN0 + 1536 + head * 64 + dch * 8;
      u32x4 w = wv[t8], ow;
#pragma unroll
      for (int q = 0; q < 4; ++q) ow[q] = shxi<1>((int)w[q]);
      float mine[8], oth[8];
#pragma unroll
      for (int q = 0; q < 4; ++q) {
        mine[2 * q] = bflo(w[q]); mine[2 * q + 1] = bfhi(w[q]);
        oth[2 * q] = bflo(ow[q]); oth[2 * q + 1] = bfhi(ow[q]);
      }
      if (dch < 2) {
        const float* cs = p->rope + tok * 16;
        const float sg = dch ? 1.f : -1.f;
        float res[8];
#pragma unroll
        for (int i = 0; i < 8; ++i) res[i] = mine[i] * cs[i] + sg * oth[i] * cs[8 + i];
        u32x4 r = {pack2(res[0], res[1]), pack2(res[2], res[3]), pack2(res[4], res[5]), pack2(res[6], res[7])};
        wt128(ptr, r);
#pragma unroll
        for (int q = 0; q < 4; ++q) { mine[2 * q] = bflo(r[q]); mine[2 * q + 1] = bfhi(r[q]); }
      }
#pragma unroll
      for (int e = 0; e < 8; ++e) sum[e] += mine[e];
    }
    }
    __syncthreads();
#pragma unroll
    for (int e = 0; e < 8; ++e) fs[tg * 256 + cc * 8 + e] = sum[e];
    __syncthreads();
    if (tid < 256) {
      float t = 0.f;
#pragma unroll
      for (int g = 0; g < 16; ++g) t += fs[g * 256 + tid];
      wt32f(p->cent + (((long)b * 8 + hg * 4 + (tid >> 6)) * 32 + n) * 64 + (tid & 63), t * (1.f / 256.f));
    }
    __syncthreads();
  }
}

template <bool FINAL>
DI void lru_item(int ws, PP p, char* shm, int item) {
  const int tid = mytid(ws), wid = tid >> 6, lane = tid & 63, rl = lane & 31, hh = lane >> 5;
  const int b = item & 3, c = 127 - (item >> 2), t0 = c * 64;
  const u16* u = p->big;
  u16* XC = (u16*)shm + wid * KVT;
  {
    const int ch = wid * 64 + lane;
    const float w0 = p->conv_w[ch], w1 = p->conv_w[512 + ch], w2 = p->conv_w[1024 + ch], w3 = p->conv_w[1536 + ch], cb = p->conv_b[ch];
    const u16* up = u + ((long)b * SEQ + t0) * IN0 + ch;
    float xm3 = 0.f, xm2 = 0.f, xm1 = 0.f;
    if (t0 > 0) { xm3 = bf2f(up[-3 * IN0]); xm2 = bf2f(up[-2 * IN0]); xm1 = bf2f(up[-1 * IN0]); }
    for (int t = 0; t < 64; ++t) {
      float xv = bf2f(up[(long)t * IN0]);
      float xc = w0 * xm3 + w1 * xm2 + w2 * xm1 + w3 * xv + cb;
      XC[t * KVS + lane] = f2bf(xc);
      xm3 = xm2; xm2 = xm1; xm1 = xv;
    }
  }
  __syncthreads();
  const u16* wat = p->wat + (long)wid * 4096;
  const u16* wxt = p->wat + (long)(8 + wid) * 4096;
#pragma unroll 1
  for (int nb = 0; nb < 2; ++nb) {
    f32x16 ar[2], ai[2];
#pragma unroll
    for (int mb = 0; mb < 2; ++mb)
#pragma unroll
      for (int i = 0; i < 16; ++i) { ar[mb][i] = 0.f; ai[mb][i] = 0.f; }
#pragma unroll
    for (int ks = 0; ks < 4; ++ks) {
      bf16x8 ba_ = *(const bf16x8*)(wat + (nb * 32 + rl) * 64 + ks * 16 + hh * 8);
      bf16x8 bx_ = *(const bf16x8*)(wxt + (nb * 32 + rl) * 64 + ks * 16 + hh * 8);
#pragma unroll
      for (int mb = 0; mb < 2; ++mb) {
        bf16x8 a = *(const bf16x8*)(XC + (mb * 32 + rl) * KVS + ks * 16 + hh * 8);
        ar[mb] = MFMA32(a, ba_, ar[mb]);
        ai[mb] = MFMA32(a, bx_, ai[mb]);
      }
    }
    const int j = nb * 32 + rl, chj = wid * 64 + j;
    const float baj = p->ba[chj], bxj = p->bx[chj];
    const float la = -8.f * log1pf(__expf(-p->lam[chj]));
#pragma unroll
    for (int mb = 0; mb < 2; ++mb)
#pragma unroll
      for (int i = 0; i < 16; ++i) {
        const int tok = mb * 32 + hh * 4 + (i & 3) + 8 * (i >> 2);
        const float xc = bf2f(XC[tok * KVS + j]);
        const float r = sigmoidf_(ar[mb][i] + baj), ig = sigmoidf_(ai[mb][i] + bxj);
        const float aa = __expf(r * la);
        ar[mb][i] = aa;
        ai[mb][i] = __builtin_amdgcn_sqrtf(__builtin_fmaf(-aa, aa, 1.f)) * ig * xc;
      }
    float carry = 0.f, atot = 1.f;
    if (FINAL) {
      const float* sm = p->lrusum + ((long)b * 128 * 512 + chj) * 2;
#pragma unroll 8
      for (int cp = 0; cp < c; ++cp) {
        float2 ab = *(const float2*)(sm + (long)cp * 1024);
        carry = ab.y + ab.x * carry;
      }
    }
#pragma unroll
    for (int mb = 0; mb < 2; ++mb)
#pragma unroll
      for (int q = 0; q < 4; ++q) {
        float P = 1.f, H = 0.f;
#pragma unroll
        for (int e = 0; e < 4; ++e) {
          const int idx = 4 * q + e;
          H = ar[mb][idx] * H + ai[mb][idx];
          P *= ar[mb][idx];
          ar[mb][idx] = P;
          ai[mb][idx] = H;
        }
        const float Po = shxf<32>(P), Ho = shxf<32>(H);
        const float A0 = hh ? Po : P, B0 = hh ? Ho : H, A1 = hh ? P : Po, B1 = hh ? H : Ho;
        const float mid = B0 + A0 * carry;
        const float cin = hh ? mid : carry;
        carry = B1 + A1 * mid;
        atot *= A0 * A1;
        if (FINAL) {
          const int tl0 = launder(hh * 4);
#pragma unroll
          for (int e = 0; e < 4; ++e) {
            const int idx = 4 * q + e;
            const int tok = mb * 32 + tl0 + e + 8 * q;
            const float hv = ai[mb][idx] + ar[mb][idx] * cin;
            const long trow = (long)b * SEQ + t0 + tok;
            const float g = bf2f(u[trow * IN0 + 512 + chj]);
            wt16(p->h + trow * DM + chj, f2bf(hv * gelu_tanh(g)));
          }
        }
      }
    if (!FINAL && hh == 0) {
      float2 ab = {atot, carry};
      wt64(p->lrusum + (((long)b * 128 + c) * 512 + chj) * 2, __builtin_bit_cast(u32x2, ab));
    }
  }
  __syncthreads();
}

DI int moba_off(int n) { return 256 * (31 * n - (n * (n - 1)) / 2); }

DI void moba_gate_item(int ws, PP p, char* shm, int item) {
  const int tid = mytid(ws);
  const int qb = 31 - (item >> 5), b = (item >> 3) & 3, h = item & 7;
  if (qb == 0) return;
  const int t0 = qb * 256;
  const u16* u = p->big;
  float* cs = (float*)shm;
  float* tv = (float*)(shm + 8192);
  int* ti = (int*)(shm + 11264);
  __syncthreads();
  for (int i = tid; i < qb * 64; i += NTHR) cs[i] = p->cent[((long)(b * 8 + h) * 32) * 64 + i];
  __syncthreads();
  const int ql = tid & 255, half = tid >> 8, tq = t0 + ql;
  const u16* qp = u + ((long)b * SEQ + tq) * IN0 + 1024 + h * 64;
  float q[64];
#pragma unroll
  for (int s8 = 0; s8 < 8; ++s8) {
    u32x4 w = *(const u32x4*)(qp + s8 * 8);
#pragma unroll
    for (int e = 0; e < 4; ++e) { q[s8 * 8 + 2 * e] = bflo(w[e]); q[s8 * 8 + 2 * e + 1] = bfhi(w[e]); }
  }
  {
    const float* rc = p->rope + tq * 16;
#pragma unroll
    for (int i = 0; i < 8; ++i) {
      float x1 = q[i], x2 = q[8 + i], cc = rc[i], sn = rc[8 + i];
      q[i] = bf2f(f2bf(x1 * cc - x2 * sn));
      q[8 + i] = bf2f(f2bf(x2 * cc + x1 * sn));
    }
  }
  float v0 = -INFINITY, v1 = -INFINITY, v2 = -INFINITY;
  int i0 = -1, i1 = -1, i2 = -1;
  for (int n = half; n < qb; n += 2) {
    const float4* cr = (const float4*)(cs + n * 64);
    float d = 0.f;
#pragma unroll
    for (int e = 0; e < 16; ++e) {
      float4 cv = cr[e];
      d += q[4 * e] * cv.x + q[4 * e + 1] * cv.y + q[4 * e + 2] * cv.z + q[4 * e + 3] * cv.w;
    }
    if (d > v0) { v2 = v1; i2 = i1; v1 = v0; i1 = i0; v0 = d; i0 = n; }
    else if (d > v1) { v2 = v1; i2 = i1; v1 = d; i1 = n; }
    else if (d > v2) { v2 = d; i2 = n; }
  }
  if (half == 1) {
    tv[ql * 3] = v0; tv[ql * 3 + 1] = v1; tv[ql * 3 + 2] = v2;
    ti[ql * 3] = i0; ti[ql * 3 + 1] = i1; ti[ql * 3 + 2] = i2;
  }
  __syncthreads();
  if (half == 0) {
#pragma unroll
    for (int e = 0; e < 3; ++e) {
      const float d = tv[ql * 3 + e];
      const int n = ti[ql * 3 + e];
      if (n >= 0) {
        if (d > v0 || (d == v0 && n < i0)) { v2 = v1; i2 = i1; v1 = v0; i1 = i0; v0 = d; i0 = n; }
        else if (d > v1 || (d == v1 && n < i1)) { v2 = v1; i2 = i1; v1 = d; i1 = n; }
        else if (d > v2 || (d == v2 && n < i2)) { v2 = d; i2 = n; }
      }
    }
  }
  int* lcnt = (int*)(shm + 14336);
  if (tid < 64) lcnt[tid] = 0;
  __syncthreads();
  int r0 = 0, r1 = 0, r2 = 0;
  if (half == 0) {
    if (i0 >= 0) r0 = atomicAdd(&lcnt[i0], 1);
    if (i1 >= 0) r1 = atomicAdd(&lcnt[i1], 1);
    if (i2 >= 0) r2 = atomicAdd(&lcnt[i2], 1);
  }
  __syncthreads();
  const int bh = b * 8 + h;
  if (tid < 32 && lcnt[tid] > 0) lcnt[32 + tid] = (int)atomicAdd(&p->mcnt[bh * 32 + tid], (unsigned)lcnt[tid]);
  __syncthreads();
  if (half == 0) {
    unsigned* lst = p->mlist + (long)bh * 126976;
    if (i0 >= 0) wt32u(lst + moba_off(i0) + lcnt[32 + i0] + r0, ((unsigned)tq << 2) | 0u);
    if (i1 >= 0) wt32u(lst + moba_off(i1) + lcnt[32 + i1] + r1, ((unsigned)tq << 2) | 1u);
    if (i2 >= 0) wt32u(lst + moba_off(i2) + lcnt[32 + i2] + r2, ((unsigned)tq << 2) | 2u);
  }
}

DI void moba_gather_phase(int ws, PP p, char* shm) {
  const int tid = mytid(ws), wid = tid >> 6, lane = tid & 63, rl = lane & 31, hh = lane >> 5;
  const u16* u = p->big;
  u16* kvb = (u16*)shm;
  int* pre = (int*)(shm + 120000);
  __syncthreads();
  {
    const int c0 = (int)((p->mcnt[2 * tid] + 255u) >> 8), c1 = (int)((p->mcnt[2 * tid + 1] + 255u) >> 8);
    int sc = c0 + c1;
#pragma unroll
    for (int d = 1; d < 64; d <<= 1) {
      const int o = __shfl_up(sc, d);
      if (lane >= d) sc += o;
    }
    int* wtot = pre + 1032;
    if (lane == 63) wtot[wid] = sc;
    __syncthreads();
    int base = 0;
    for (int w = 0; w < wid; ++w) base += wtot[w];
    const int excl = base + sc - (c0 + c1);
    if (tid == 0) pre[0] = 0;
    pre[2 * tid + 1] = excl + c0;
    pre[2 * tid + 2] = excl + c0 + c1;
  }
  __syncthreads();
  const int total = pre[1024];
  const int row = tid >> 3, seg = tid & 7;
  u32x4 kr[4], vr[4];
  auto locate = [&](int it, int& li, int& chunk) {
    int lo = 0, hi = 1024;
    while (hi - lo > 1) {
      const int mid = (lo + hi) >> 1;
      if (pre[mid] <= it) lo = mid; else hi = mid;
    }
    li = lo;
    chunk = it - pre[lo];
  };
  auto issue = [&](int li) {
    const int bh = li >> 5, n = li & 31, b = bh >> 3, h = bh & 7;
    const u16* kbase = u + ((long)b * SEQ + n * 256) * IN0 + 1536 + h * 64;
    const u16* vbase = p->vt + ((long)bh * 64) * SEQ + n * 256;
#pragma unroll
    for (int st = 0; st < 4; ++st) {
      kr[st] = *(const u32x4*)(kbase + (long)(st * 64 + row) * IN0 + seg * 8);
      vr[st] = *(const u32x4*)(vbase + (long)row * SEQ + st * 64 + seg * 8);
    }
  };
  int li = 0, chunk = 0;
  int* gslot = (int*)(shm + 150016);
  int it = grab(ws, p->ctr + 2, shm);
  if (it < total) { locate(it, li, chunk); issue(li); }
#pragma unroll 1
  while (it < total) {
    const int bh = li >> 5, n = li & 31, b = bh >> 3, h = bh & 7;
    const int cnt = (int)p->mcnt[li];
    __syncthreads();
#pragma unroll
    for (int st = 0; st < 4; ++st) {
      *(u32x4*)(kvb + st * 2 * KVT + row * KVS + seg * 8) = kr[st];
      *(u32x4*)(kvb + st * 2 * KVT + KVT + row * KVS + seg * 8) = vr[st];
    }
    const int e = chunk * 256 + wid * 32 + rl;
    const bool valid = e < cnt;
    const unsigned ent = p->mlist[(long)bh * 126976 + moba_off(n) + (valid ? e : 0)];
    const int tq = (int)(ent >> 2), slot = (int)(ent & 3u);
    bf16x8 qf[4];
    load_qf(qf, u + ((long)b * SEQ + tq) * IN0 + 1024 + h * 64, hh);
    qf[0] = rope_frag(qf[0], p->rope + tq * 16, hh);
    if (tid == 0) *gslot = (int)atomicAdd(p->ctr + 2, 1u);
    f32x16 o[2];
#pragma unroll
    for (int db = 0; db < 2; ++db)
#pragma unroll
      for (int i = 0; i < 16; ++i) o[db][i] = 0.f;
    float m = -1e30f, l = 0.f;
    __syncthreads();
    const int itn = *gslot;
    int lin = 0, chunkn = 0;
    if (itn < total) { locate(itn, lin, chunkn); issue(lin); }
#pragma unroll
    for (int st = 0; st < 4; ++st) {
      f32x16 s[2];
      qk_tile(kvb + st * 2 * KVT, qf, s, rl, hh);
      osm<0>(s, 0xffffffffu, m, l, o);
      pv_tile(kvb + st * 2 * KVT + KVT, s, o, rl, hh);
    }
    if (valid) {
      u16* pe = p->part + (((long)bh * SEQ + tq) * 3 + slot) * 72;
      store_o(pe + 8, o, 1.f / l, hh);
      if (hh == 0) { wt32f((float*)pe, m); wt32f((float*)pe + 1, l); }
    }
    li = lin; chunk = chunkn; it = itn;
  }
  __syncthreads();
}

DI void moba_own_item(int ws, PP p, char* shm, int item) {
  const int tid = mytid(ws), wid = tid >> 6, lane = tid & 63, rl = lane & 31, hh = lane >> 5;
  const int qb = 31 - (item >> 5), b = (item >> 3) & 3, h = item & 7;
  const int t0 = qb * 256;
  const u16* u = p->big;
  u16* kvb = (u16*)shm;
  const int tq = t0 + wid * 32 + rl;
  bf16x8 qf[4];
  load_qf(qf, u + ((long)b * SEQ + tq) * IN0 + 1024 + h * 64, hh);
  qf[0] = rope_frag(qf[0], p->rope + tq * 16, hh);
  f32x16 o[2];
#pragma unroll
  for (int db = 0; db < 2; ++db)
#pragma unroll
    for (int i = 0; i < 16; ++i) o[db][i] = 0.f;
  float m = -1e30f, l = 0.f;
  const u16* kbase = u + ((long)b * SEQ + t0) * IN0 + 1536 + h * 64;
  const u16* vbase = p->vt + ((long)(b * 8 + h) * 64) * SEQ + t0;
  auto tf = [&](int i, const u16*& kp, long& ldk, const u16*& vp, long& ldv) {
    kp = kbase + (long)i * 64 * IN0; ldk = IN0;
    vp = vbase + i * 64; ldv = SEQ;
  };
  auto body = [&](int i, const u16* Ks, const u16* Vs) {
    const uint32_t vm = range_mask(i * 64, 0, wid * 32 + rl, hh);
    if (__ballot(vm != 0) != 0ull) {
      f32x16 s[2];
      qk_tile(Ks, qf, s, rl, hh);
      online_softmax(s, vm, m, l, o);
      pv_tile(Vs, s, o, rl, hh);
    }
  };
  kv_loop(kvb, 4, tid, tf, body);
  const int nsl = qb < 3 ? qb : 3;
#pragma unroll 1
  for (int sl = 0; sl < nsl; ++sl) {
    const u16* pe = p->part + (((long)(b * 8 + h) * SEQ + tq) * 3 + sl) * 72;
    const float ms = ((const float*)pe)[0], ls = ((const float*)pe)[1];
    const float mn = fmaxf(m, ms);
    const float a = fexp2(m - mn), c = fexp2(ms - mn) * ls;
#pragma unroll
    for (int db = 0; db < 2; ++db)
#pragma unroll
      for (int q = 0; q < 4; ++q) {
        const u32x2 w = *(const u32x2*)(pe + 8 + db * 32 + 8 * q + 4 * hh);
        o[db][4 * q] = o[db][4 * q] * a + c * bflo(w[0]);
        o[db][4 * q + 1] = o[db][4 * q + 1] * a + c * bfhi(w[0]);
        o[db][4 * q + 2] = o[db][4 * q + 2] * a + c * bflo(w[1]);
        o[db][4 * q + 3] = o[db][4 * q + 3] * a + c * bfhi(w[1]);
      }
    l = l * a + c;
    m = mn;
  }
  store_o(p->h + ((long)b * SEQ + tq) * DM + 512 + h * 64, o, 1.f / l, hh);
}

DI void rope1_phase(int ws, PP p) {
  const int tid = mytid(ws);
  u16* u = p->big;
  for (int e = blockIdx.x * NTHR + tid; e < NT * 4; e += gridDim.x * NTHR) {
    const int trow = e >> 2, w = e & 3, pos = trow & (SEQ - 1);
    u16* ptr = u + (long)trow * IN1P + ((w & 2) ? 1536 : 1280) + (w & 1) * 64;
    u32x4 a = *(const u32x4*)ptr, bq = *(const u32x4*)(ptr + 8);
    const float* cs = p->rope + pos * 16;
    float x1[8], x2[8], r1[8], r2[8];
#pragma unroll
    for (int q = 0; q < 4; ++q) { x1[2 * q] = bflo(a[q]); x1[2 * q + 1] = bfhi(a[q]); x2[2 * q] = bflo(bq[q]); x2[2 * q + 1] = bfhi(bq[q]); }
#pragma unroll
    for (int i = 0; i < 8; ++i) { r1[i] = x1[i] * cs[i] - x2[i] * cs[8 + i]; r2[i] = x2[i] * cs[i] + x1[i] * cs[8 + i]; }
    u32x4 oa = {pack2(r1[0], r1[1]), pack2(r1[2], r1[3]), pack2(r1[4], r1[5]), pack2(r1[6], r1[7])};
    u32x4 ob = {pack2(r2[0], r2[1]), pack2(r2[2], r2[3]), pack2(r2[4], r2[5]), pack2(r2[6], r2[7])};
    wt128(ptr, oa);
    wt128(ptr + 8, ob);
  }
}
DI void cmpfin_phase(int ws, int gx, int gslot, PP p, char* shm) {
  const int tid = mytid(ws);
  float* hid = (float*)shm;
  float* w2s = (float*)(shm + 4096);
  int kvl = -1;
  const int slots = gridDim.x >> 3;
  for (int li = gslot; li < 128; li += slots) {
    const int kv = gx >> 2, bg = 2 * (gx & 3) + (li >> 6), i0 = (li & 63) * 8;
    const int row = tid >> 6, n = tid & 63, i = i0 + row;
    const float* pq = p->pq + ((long)kv * 4096 + bg * 512) * 256;
    __syncthreads();
    if (kv != kvl) {
      const float* w2 = p->cmp_w2 + (long)kv * 128 * 64;
      for (int e = tid; e < 128 * 64; e += NTHR) w2s[e] = w2[e];
      kvl = kv;
    }
#pragma unroll
    for (int hf = 0; hf < 2; ++hf) {
      const int nn = n + hf * 64;
      float v = 0.f;
      if (i < 511) v = gelu_tanh(pq[(long)i * 256 + nn] + pq[(long)(i + 1) * 256 + 128 + nn] + p->cvec[kv * 128 + nn]);
      hid[row * 128 + nn] = v;
    }
    __syncthreads();
    float acc = 0.f;
#pragma unroll 8
    for (int k = 0; k < 128; ++k) acc += hid[row * 128 + k] * w2s[k * 64 + n];
    if (i < 511) {
      if (kv == 0) wt16(p->kcmp + ((long)bg * 512 + i) * 64 + n, f2bf(acc));
      else wt16(p->vcmpT + ((long)bg * 64 + n) * 512 + i, f2bf(acc));
    }
  }
  __syncthreads();
}

DI void nsa_item(int ws, PP p, char* shm, int item) {
  const int tid = mytid(ws), wid = tid >> 6, lane = tid & 63, rl = lane & 31, hh = lane >> 5;
  const int tt = 255 - (item >> 3), bg = item & 7, b = bg >> 1, g = bg & 1;
  const int t0 = tt * 32, tokl = wid * 4 + (rl >> 3), tok = t0 + tokl, r = rl & 7, hq = g * 8 + r;
  const u16* u = p->big;
  u16* kvb = (u16*)shm;
  float* impm = (float*)(shm + 36864);
  float* imps = (float*)(shm + 53760);
  float* vals = (float*)(shm + 70656);
  unsigned char* selb = (unsigned char*)(shm + 147456);
  uint32_t* un = (uint32_t*)(shm + 147968);
  int* tl = (int*)(shm + 148032);
  __syncthreads();
  for (int i = tid; i < 2 * 32 * 132; i += NTHR) impm[i] = 0.f;
  if (tid < 8) un[tid] = 0;
  const u16* qrow = u + ((long)b * SEQ + tok) * IN1P + hq * 64;
  bf16x8 qn[4], qr[4];
  load_qf(qn, qrow, hh);
  qr[0] = rope_frag(qn[0], p->rope + tok * 16, hh);
  qr[1] = qn[1]; qr[2] = qn[2]; qr[3] = qn[3];
  float gt[3];
#pragma unroll
  for (int br = 0; br < 3; ++br) gt[br] = sigmoidf_(bf2f(qrow[1792 - hq * 64 + hq * 3 + br]));
  f32x16 yacc[2], o[2];
#pragma unroll
  for (int db = 0; db < 2; ++db)
#pragma unroll
    for (int i = 0; i < 16; ++i) { yacc[db][i] = 0.f; o[db][i] = 0.f; }
  {
    const int nct = (t0 >> 10) + 1;
    const int cmax = (tok - 31) >> 4;
    const u16* kc = p->kcmp + (long)bg * 512 * 64;
    const u16* vc = p->vcmpT + (long)bg * 64 * 512;
    auto tf = [&](int i, const u16*& kp, long& ldk, const u16*& vp, long& ldv) {
      kp = kc + (long)i * 64 * 64; ldk = 64;
      vp = vc + i * 64; ldv = 512;
    };
    float m = -1e30f, l = 0.f;
    auto body1 = [&](int i, const u16* Ks, const u16* Vs) {
      const uint32_t vm = range_mask(i * 64, 0, cmax, hh);
      f32x16 s[2];
      qk_tile(Ks, qn, s, rl, hh);
      float mx = -1e30f;
#pragma unroll
      for (int kb = 0; kb < 2; ++kb)
#pragma unroll
        for (int ii = 0; ii < 16; ++ii) {
          float v = s[kb][ii] * SCL2;
          v = ((vm >> (kb * 16 + ii)) & 1u) ? v : -1e30f;
          s[kb][ii] = v;
          mx = fmaxf(mx, v);
        }
      mx = xmax32(mx);
      const float mn = fmaxf(m, mx);
      float rs = 0.f;
#pragma unroll
      for (int kb = 0; kb < 2; ++kb)
#pragma unroll
        for (int ii = 0; ii < 16; ++ii) rs += ((vm >> (kb * 16 + ii)) & 1u) ? fexp2(s[kb][ii] - mn) : 0.f;
      rs = xsum32(rs);
      l = l * fexp2(m - mn) + rs;
      m = mn;
    };
    kv_loop(kvb, nct, tid, tf, body1);
    const float invl = l > 0.f ? 1.f / l : 0.f;
    auto body2 = [&](int i, const u16* Ks, const u16* Vs) {
      const uint32_t vm = range_mask(i * 64, 0, cmax, hh);
      f32x16 s[2];
      qk_tile(Ks, qn, s, rl, hh);
#pragma unroll
      for (int kb = 0; kb < 2; ++kb)
#pragma unroll
        for (int ii = 0; ii < 16; ++ii) s[kb][ii] = ((vm >> (kb * 16 + ii)) & 1u) ? fexp2(__builtin_fmaf(s[kb][ii], SCL2, -m)) * invl : 0.f;
      pv_tile(Vs, s, o, rl, hh);
#pragma unroll
      for (int kb = 0; kb < 2; ++kb)
#pragma unroll
        for (int q4 = 0; q4 < 4; ++q4) {
          float mainv = s[kb][4 * q4] + s[kb][4 * q4 + 1] + s[kb][4 * q4 + 2] + 0.5f * s[kb][4 * q4 + 3];
          float sp = 0.5f * s[kb][4 * q4 + 3];
          mainv = sum8(mainv);
          sp = sum8(sp);
          if (r == 0) {
            const int j = 16 * i + 8 * kb + 2 * q4 + hh;
            impm[tokl * 132 + j] = mainv;
            imps[tokl * 132 + j + 1] = sp;
          }
        }
    };
    kv_loop(kvb, nct, tid, tf, body2);
#pragma unroll
    for (int db = 0; db < 2; ++db)
#pragma unroll
      for (int i = 0; i < 16; ++i) { yacc[db][i] = gt[0] * o[db][i]; o[db][i] = 0.f; }
  }
  __syncthreads();
  {
    const int tk = tid >> 4, jg = tid & 15, blk = (t0 + tk) >> 6;
    float v[8];
#pragma unroll
    for (int e = 0; e < 8; ++e) {
      const int j = jg * 8 + e;
      float x = impm[tk * 132 + j] + imps[tk * 132 + j];
      if (j == 0 || j == blk || j == blk - 1) x = 1e30f;
      if (j > blk) x = -INFINITY;
      v[e] = x;
      vals[tk * 132 + j] = x;
    }
    uint32_t key[8];
#pragma unroll
    for (int e = 0; e < 8; ++e) {
      const uint32_t uu = __float_as_uint(v[e]);
      key[e] = (uu & 0x80000000u) ? ~uu : (uu | 0x80000000u);
    }
    auto rowsum = [](int c) {
      c += __builtin_amdgcn_update_dpp(0, c, 0x128, 0xF, 0xF, true);
      c += __builtin_amdgcn_update_dpp(0, c, 0x124, 0xF, 0xF, true);
      c += __builtin_amdgcn_update_dpp(0, c, 0x122, 0xF, 0xF, true);
      c += __builtin_amdgcn_update_dpp(0, c, 0x121, 0xF, 0xF, true);
      return c;
    };
    uint32_t pfx = 0;
#pragma unroll 1
    for (int b = 31; b >= 0; --b) {
      const uint32_t cand = pfx | (1u << b);
      int c = 0;
#pragma unroll
      for (int e = 0; e < 8; ++e) c += (key[e] >= cand) ? 1 : 0;
      c = rowsum(c);
      if (c >= 16) pfx = cand;
    }
    int cgt = 0, teq = 0;
#pragma unroll
    for (int e = 0; e < 8; ++e) { cgt += (key[e] > pfx) ? 1 : 0; teq += (key[e] == pfx) ? 1 : 0; }
    cgt = rowsum(cgt);
    int tin = teq;
    tin += __builtin_amdgcn_update_dpp(0, tin, 0x111, 0xF, 0xF, true);
    tin += __builtin_amdgcn_update_dpp(0, tin, 0x112, 0xF, 0xF, true);
    tin += __builtin_amdgcn_update_dpp(0, tin, 0x114, 0xF, 0xF, true);
    tin += __builtin_amdgcn_update_dpp(0, tin, 0x118, 0xF, 0xF, true);
    int run = cgt + tin - teq;
    uint32_t bits = 0;
#pragma unroll
    for (int e = 0; e < 8; ++e) {
      const bool eq = key[e] == pfx;
      const bool sel = (key[e] > pfx) || (eq && run < 16);
      run += eq ? 1 : 0;
      bits |= (sel && (jg * 8 + e) <= blk) ? (1u << e) : 0u;
    }
    selb[tk * 16 + jg] = (unsigned char)bits;
    __syncthreads();
    if (tid < 32) {
      const uint32_t* w = (const uint32_t*)(selb + tid * 16);
      atomicOr(&un[0], w[0]); atomicOr(&un[1], w[1]); atomicOr(&un[2], w[2]); atomicOr(&un[3], w[3]);
    }
    __syncthreads();
    if (tid < 128) {
      const uint32_t u0 = un[0], u1 = un[1], u2 = un[2], u3 = un[3];
      const int w = tid >> 5, bpos = tid & 31;
      const uint32_t uw = w == 0 ? u0 : w == 1 ? u1 : w == 2 ? u2 : u3;
      const int below = (w > 0 ? __popc(u0) : 0) + (w > 1 ? __popc(u1) : 0) + (w > 2 ? __popc(u2) : 0);
      if ((uw >> bpos) & 1u) tl[below + __popc(uw & ((1u << bpos) - 1u))] = tid;
      if (tid == 0) un[4] = __popc(u0) + __popc(u1) + __popc(u2) + __popc(u3);
    }
    __syncthreads();
  }
  {
    const int ntl = (int)un[4];
    const u32x4 ms = *(const u32x4*)(selb + tokl * 16);
    const u16* kb_ = u + (long)b * SEQ * IN1P + 1280 + g * 64;
    const u16* vb_ = p->vt + (long)bg * 64 * SEQ;
    auto tf = [&](int i, const u16*& kp, long& ldk, const u16*& vp, long& ldv) {
      const int j = tl[i];
      kp = kb_ + (long)j * 64 * IN1P; ldk = IN1P;
      vp = vb_ + j * 64; ldv = SEQ;
    };
    float m = -1e30f, l = 0.f;
    auto body = [&](int i, const u16* Ks, const u16* Vs) {
      const int j = tl[i];
      const uint32_t w = j < 32 ? ms[0] : j < 64 ? ms[1] : j < 96 ? ms[2] : ms[3];
      uint32_t vm = ((w >> (j & 31)) & 1u) ? range_mask(j * 64, 0, tok, hh) : 0u;
      if (__ballot(vm != 0) != 0ull) {
        f32x16 s[2];
        qk_tile(Ks, qr, s, rl, hh);
        online_softmax(s, vm, m, l, o);
        pv_tile(Vs, s, o, rl, hh);
      }
    };
    {
      const int ng = (ntl + 3) >> 2;
      const int row = tid >> 3, seg = tid & 7;
      u32x4 kr[4], vr[4];
      auto issue = [&](int g4) {
#pragma unroll
        for (int t = 0; t < 4; ++t) {
          const int idx = g4 * 4 + t;
          if (idx < ntl) {
            const int j = tl[idx];
            kr[t] = *(const u32x4*)(kb_ + ((long)j * 64 + row) * IN1P + seg * 8);
            vr[t] = *(const u32x4*)(vb_ + (long)row * SEQ + j * 64 + seg * 8);
          }
        }
      };
      auto wr = [&](int g4, int buf) {
#pragma unroll
        for (int t = 0; t < 4; ++t) {
          if (g4 * 4 + t < ntl) {
            u16* kd = kvb + (buf * 4 + t) * 2 * KVT;
            *(u32x4*)(kd + row * KVS + seg * 8) = kr[t];
            *(u32x4*)(kd + KVT + row * KVS + seg * 8) = vr[t];
          }
        }
      };
      __syncthreads();
      issue(0);
      wr(0, 0);
      __syncthreads();
#pragma unroll 1
      for (int g4 = 0; g4 < ng; ++g4) {
        if (g4 + 1 < ng) issue(g4 + 1);
#pragma unroll 1
        for (int t = 0; t < 4; ++t) {
          const int idx = g4 * 4 + t;
          if (idx < ntl) {
            const u16* kd = kvb + ((g4 & 1) * 4 + t) * 2 * KVT;
            body(idx, kd, kd + KVT);
          }
        }
        if (g4 + 1 < ng) wr(g4 + 1, (g4 + 1) & 1);
        __syncthreads();
      }
    }
    const float sc = gt[1] / l;
#pragma unroll
    for (int db = 0; db < 2; ++db)
#pragma unroll
      for (int i = 0; i < 16; ++i) { yacc[db][i] += sc * o[db][i]; o[db][i] = 0.f; }
  }
  {
    const int jlo = (t0 > 511 ? t0 - 511 : 0) >> 6, jhi = (t0 + 31) >> 6;
    const u16* kb_ = u + (long)b * SEQ * IN1P + 1536 + g * 64;
    const u16* vb_ = p->vt + (long)(8 + bg) * 64 * SEQ;
    auto tf = [&](int i, const u16*& kp, long& ldk, const u16*& vp, long& ldv) {
      const int j = jlo + i;
      kp = kb_ + (long)j * 64 * IN1P; ldk = IN1P;
      vp = vb_ + j * 64; ldv = SEQ;
    };
    float m = -1e30f, l = 0.f;
    auto body = [&](int i, const u16* Ks, const u16* Vs) {
      const int j = jlo + i;
      const uint32_t vm = range_mask(j * 64, tok - 511, tok, hh);
      if (__ballot(vm != 0) != 0ull) {
        f32x16 s[2];
        qk_tile(Ks, qr, s, rl, hh);
        online_softmax(s, vm, m, l, o);
        pv_tile(Vs, s, o, rl, hh);
      }
    };
    kv_loop(kvb, jhi - jlo + 1, tid, tf, body);
    const float sc = gt[2] / l;
#pragma unroll
    for (int db = 0; db < 2; ++db)
#pragma unroll
      for (int i = 0; i < 16; ++i) yacc[db][i] += sc * o[db][i];
  }
  store_o(p->h + ((long)b * SEQ + tok) * DM + hq * 64, yacc, 1.f, hh);
}

DI void local_barrier(unsigned* ctr, unsigned target, int ws) {
  asm volatile("s_waitcnt vmcnt(0)" ::: "memory");
  __syncthreads();
  if (ws == 0 && lane_id_() == 0) {
    __hip_atomic_fetch_add(ctr, 1u, __ATOMIC_RELAXED, __HIP_MEMORY_SCOPE_AGENT);
    unsigned sp = 0;
    while (__hip_atomic_load(ctr, __ATOMIC_RELAXED, __HIP_MEMORY_SCOPE_AGENT) < target) {
      __builtin_amdgcn_s_sleep(1);
      if (++sp > (1u << 22)) break;
    }
    __builtin_amdgcn_fence(__ATOMIC_ACQUIRE, "agent");
    asm volatile("s_waitcnt vmcnt(0)" ::: "memory");
  }
  __syncthreads();
}

DI void phase_signal(unsigned* ctr, int ws) {
  asm volatile("s_waitcnt vmcnt(0)" ::: "memory");
  __syncthreads();
  if (ws == 0 && lane_id_() == 0) {
    __builtin_amdgcn_fence(__ATOMIC_RELEASE, "agent");
    asm volatile("s_waitcnt vmcnt(0)" ::: "memory");
    __hip_atomic_fetch_add(ctr, 1u, __ATOMIC_RELAXED, __HIP_MEMORY_SCOPE_AGENT);
  }
}
DI void phase_wait(unsigned* ctr, unsigned target, int ws) {
  if (ws == 0 && lane_id_() == 0) {
    unsigned sp = 0;
    while (__hip_atomic_load(ctr, __ATOMIC_RELAXED, __HIP_MEMORY_SCOPE_AGENT) < target) {
      __builtin_amdgcn_s_sleep(1);
      if (++sp > (1u << 22)) break;
    }
    __builtin_amdgcn_fence(__ATOMIC_ACQUIRE, "agent");
    asm volatile("s_waitcnt vmcnt(0)" ::: "memory");
  }
  __syncthreads();
}

__global__ void __launch_bounds__(NTHR) fwd_kernel(Params pk) {
  __shared__ __attribute__((aligned(1024))) char shm[151552];
  cg::grid_group grid = cg::this_grid();
  const PP p0 = (PP)__builtin_amdgcn_kernarg_segment_ptr();
  const int ws = __builtin_amdgcn_readfirstlane(threadIdx.x >> 6);
  prep_phase(ws, launder_p(p0), shm);
  grid.sync();
  int gx = blockIdx.x & 7, gslot = blockIdx.x >> 3;
  bool loc = false;
  unsigned lep = 0;
  {
    int* cs_ = (int*)(shm + 150024);
    if (ws == 0 && lane_id_() == 0) {
      const unsigned xcc = (unsigned)__builtin_amdgcn_s_getreg((3 << 11) | 20) & 0xFu;
      cs_[0] = (int)xcc;
      cs_[1] = (int)__hip_atomic_fetch_add(p0->xcnt + xcc, 1u, __ATOMIC_RELAXED, __HIP_MEMORY_SCOPE_AGENT);
      unsigned sp = 0, sum = 0;
      bool ok = false;
      for (;;) {
        sum = 0;
        ok = true;
        for (int j = 0; j < 16; ++j) {
          const unsigned c = __hip_atomic_load(p0->xcnt + j, __ATOMIC_RELAXED, __HIP_MEMORY_SCOPE_AGENT);
          sum += c;
          if (j < 8 ? (c != 32u) : (c != 0u)) ok = false;
        }
        if (sum == gridDim.x || ++sp > (1u << 20)) break;
        __builtin_amdgcn_s_sleep(1);
      }
      cs_[2] = (ok && sum == gridDim.x && gridDim.x == 256) ? 1 : 0;
    }
    __syncthreads();
    if (cs_[2]) { gx = cs_[0]; gslot = cs_[1]; loc = true; }
    __syncthreads();
  }
  auto seam = [&]() {
    if (loc) { ++lep; local_barrier(p0->lbar + gx * 64, lep * (gridDim.x >> 3), ws); }
    else grid.sync();
  };
  auto half = [&](const int l, const int s) __attribute__((always_inline)) {
    {
      PP p = launder_p(p0);
      const float* modl = p->mod + (long)l * 4 * 9216;
      const float* xin = (l == 0 && s == 0) ? p->x : p->out;
      norm_phase(ws, gx, gslot, xin, p->h, p->norm_g + (l * 3 + (s == 0 ? 0 : 2)) * DM, modl + (s == 0 ? 0 : 6) * DM, modl + (s == 0 ? 1 : 7) * DM);
      seam();
      p = launder_p(p0);
      {
        const u16* W = p->wt1 + (long)(l * 2 + s) * 5632 * 1024;
        u16* act = p->big;
        auto desc = [&](int pm, int pn) { return TileDesc{p->h + (long)pm * 256 * DM, DM, 64, W + (long)pn * 256 * DM, DM, DM / 64}; };
        auto epi = [&](int pm, int pn, Acc8& acc, int wr, int wc, int fr, int fq) {
#pragma unroll
          for (int ai = 0; ai < 2; ++ai)
#pragma unroll
            for (int bj = 0; bj < 2; ++bj)
#pragma unroll
              for (int m = 0; m < 4; ++m)
                {
                  float v[4];
#pragma unroll
                  for (int j = 0; j < 4; ++j) {
                    float a = acc[ai][bj][m][0][j], b = acc[ai][bj][m][1][j];
                    v[j] = a * __builtin_amdgcn_rcpf(1.f + __expf(-a)) * b;
                  }
                  const long row0 = (long)pm * 256 + ai * 128 + wr * 64 + m * 16 + fq * 4;
                  const int cole = pn * 128 + (bj * 4 + wc) * 16 + (fr & ~1);
                  store_pair_bf16(act + row0 * DFF + cole, DFF, fr & 1, v[0], v[1], v[2], v[3]);
                }
        };
        gemm_phase(ws, gx, gslot, shm, NT / 256, 5632 / 256, desc, epi);
      }
      seam();
      p = launder_p(p0);
      modl = p->mod + (long)l * 4 * 9216;
      xin = (l == 0 && s == 0) ? p->x : p->out;
      {
        const u16* W = p->wt2 + (long)(l * 2 + s) * 1024 * DFF;
        const float* gate = modl + (s == 0 ? 2 : 8) * DM;
        float* xo = p->out;
        auto desc = [&](int pm, int pn) { return TileDesc{p->big + (long)pm * 256 * DFF, DFF, 64, W + (long)pn * 256 * DFF, DFF, DFF / 64}; };
        auto epi = [&](int pm, int pn, Acc8& acc, int wr, int wc, int fr, int fq) {
          const int b = (pm * 256) >> 13;
#pragma unroll
          for (int bj = 0; bj < 2; ++bj)
#pragma unroll
            for (int n = 0; n < 2; ++n) {
              const int col = pn * 256 + bj * 128 + wc * 32 + n * 16 + fr;
              const float gv = 0.5f * gate[(long)b * 9216 + col];
#pragma unroll
              for (int ai = 0; ai < 2; ++ai)
#pragma unroll
                for (int m = 0; m < 4; ++m) {
                  const long row0 = (long)pm * 256 + ai * 128 + wr * 64 + m * 16 + fq * 4;
                  const f32x4 a = acc[ai][bj][m][n];
                  rmw_pair_f32(xo + row0 * DM + (col & ~1), xin + row0 * DM + (col & ~1), DM, col & 1, gv * a[0], gv * a[1], gv * a[2], gv * a[3]);
                  asm volatile("" ::: "memory");
                }
            }
        };
        gemm_phase(ws, gx, gslot, shm, NT / 256, DM / 256, desc, epi);
      }
      seam();
      if (s == 0) {
        p = launder_p(p0);
        modl = p->mod + (long)l * 4 * 9216;
        norm_phase(ws, gx, gslot, p->out, p->h, p->norm_g + (l * 3 + 1) * DM, modl + 3 * DM, modl + 4 * DM);
        seam();
        if (l == 0) {
          p = launder_p(p0);
          {
            u16* uu = p->big;
            u16* vt = p->vt;
            auto desc = [&](int pm, int pn) { return TileDesc{p->h + (long)pm * 256 * DM, DM, 64, p->wtin0 + (long)pn * 256 * DM, DM, DM / 64}; };
            auto epi = [&](int pm, int pn, Acc8& acc, int wr, int wc, int fr, int fq) {
#pragma unroll
              for (int ai = 0; ai < 2; ++ai)
#pragma unroll
                for (int bj = 0; bj < 2; ++bj)
#pragma unroll
                  for (int m = 0; m < 4; ++m)
#pragma unroll
                    for (int n = 0; n < 2; ++n) {
                      const int col = pn * 256 + bj * 128 + wc * 32 + n * 16 + fr;
                      const long row0 = (long)pm * 256 + ai * 128 + wr * 64 + m * 16 + fq * 4;
                      const f32x4 v = acc[ai][bj][m][n];
                      if (col >= 2048) {
                        const int vc = col - 2048, bb = (int)(row0 >> 13), t = (int)(row0 & 8191);
                        u32x2 pk = {pack2(v[0], v[1]), pack2(v[2], v[3])};
                        wt64(vt + ((long)(bb * 8 + (vc >> 6)) * 64 + (vc & 63)) * SEQ + t, pk);
                      } else {
                        store_pair_bf16(uu + row0 * IN0 + (col & ~1), IN0, col & 1, v[0], v[1], v[2], v[3]);
                      }
                    }
            };
            gemm_phase(ws, gx, gslot, shm, NT / 256, IN0 / 256, desc, epi);
          }
          grid.sync();
          p = launder_p(p0);
          kprep0_phase(ws, p, shm);
          phase_signal(p0->ctr + 16, ws);
          p = launder_p(p0);
#pragma unroll 1
          for (int it = grab(ws, p->ctr + 0, shm); it < 512;) {
            const int nx_ = grab_begin(ws, p->ctr + 0);
            lru_item<false>(ws, p, shm, it);
            it = grab_end(ws, nx_, shm);
          }
          phase_signal(p0->ctr + 17, ws);
          phase_wait(p0->ctr + 16, gridDim.x, ws);
          p = launder_p(p0);
#pragma unroll 1
          for (int it = grab(ws, p->ctr + 1, shm); it < 1024;) {
            const int nx_ = grab_begin(ws, p->ctr + 1);
            moba_gate_item(ws, p, shm, it);
            it = grab_end(ws, nx_, shm);
          }
          phase_signal(p0->ctr + 18, ws);
          phase_wait(p0->ctr + 17, gridDim.x, ws);
          p = launder_p(p0);
#pragma unroll 1
          for (int it = grab(ws, p->ctr + 3, shm); it < 512;) {
            const int nx_ = grab_begin(ws, p->ctr + 3);
            lru_item<true>(ws, p, shm, it);
            it = grab_end(ws, nx_, shm);
          }
          phase_wait(p0->ctr + 18, gridDim.x, ws);
          p = launder_p(p0);
          moba_gather_phase(ws, p, shm);
          phase_signal(p0->ctr + 19, ws);
          phase_wait(p0->ctr + 19, gridDim.x, ws);
          p = launder_p(p0);
#pragma unroll 1
          for (int it = grab(ws, p->ctr + 4, shm); it < 1024;) {
            const int nx_ = grab_begin(ws, p->ctr + 4);
            moba_own_item(ws, p, shm, it);
            it = grab_end(ws, nx_, shm);
          }
          grid.sync();
        }
        if (l == 1) {
          p = launder_p(p0);
          {
            u16* uu = p->big;
            u16* vt = p->vt;
            auto desc = [&](int pm, int pn) { return TileDesc{p->h + (long)pm * 256 * DM, DM, 64, p->wtin1 + (long)pn * 256 * DM, DM, DM / 64}; };
            auto epi = [&](int pm, int pn, Acc8& acc, int wr, int wc, int fr, int fq) {
#pragma unroll
              for (int ai = 0; ai < 2; ++ai)
#pragma unroll
                for (int bj = 0; bj < 2; ++bj) {
                  const int c64 = (pn * 256 + bj * 128 + wc * 32) >> 6;
                  const bool isv = (c64 == 22 || c64 == 23 || c64 == 26 || c64 == 27);
#pragma unroll
                  for (int m = 0; m < 4; ++m)
#pragma unroll
                    for (int n = 0; n < 2; ++n) {
                      const int col = pn * 256 + bj * 128 + wc * 32 + n * 16 + fr;
                      const long row0 = (long)pm * 256 + ai * 128 + wr * 64 + m * 16 + fq * 4;
                      const f32x4 v = acc[ai][bj][m][n];
                      if (isv) {
                        const int bb = (int)(row0 >> 13), t = (int)(row0 & 8191);
                        const int which = c64 >= 26 ? 1 : 0, gg = c64 & 1;
                        u32x2 pk = {pack2(v[0], v[1]), pack2(v[2], v[3])};
                        wt64(vt + ((long)(which * 8 + bb * 2 + gg) * 64 + (col & 63)) * SEQ + t, pk);
                      } else if (col < IN1) {
                        store_pair_bf16(uu + row0 * IN1P + (col & ~1), IN1P, col & 1, v[0], v[1], v[2], v[3]);
                      }
                    }
                }
            };
            gemm_phase(ws, gx, gslot, shm, NT / 256, IN1P / 256, desc, epi);
          }
          grid.sync();
          p = launder_p(p0);
          rope1_phase(ws, p);
          p = launder_p(p0);
          {
            float* pq = p->pq;
            auto desc = [&](int pm, int pn) {
              const int kv = pm >> 4, rr = pm & 15, bg = rr >> 1, j0 = (rr & 1) * 256;
              return TileDesc{p->big + ((long)(bg >> 1) * SEQ + 16 * j0) * IN1P + 1024 + kv * 128 + (bg & 1) * 64, 16 * IN1P, IN1P,
                              p->wtcmp + (long)kv * 256 * 1024, 1024, 16};
            };
            auto epi = [&](int pm, int pn, Acc8& acc, int wr, int wc, int fr, int fq) {
#pragma unroll
              for (int ai = 0; ai < 2; ++ai)
#pragma unroll
                for (int bj = 0; bj < 2; ++bj)
#pragma unroll
                  for (int m = 0; m < 4; ++m)
#pragma unroll
                    for (int n = 0; n < 2; ++n)
#pragma unroll
                      for (int j = 0; j < 4; ++j)
                        wt32f(pq + ((long)pm * 256 + ai * 128 + wr * 64 + m * 16 + fq * 4 + j) * 256 + bj * 128 + wc * 32 + n * 16 + fr, acc[ai][bj][m][n][j]);
            };
            gemm_phase(ws, gx, gslot, shm, 32, 1, desc, epi);
          }
          seam();
          p = launder_p(p0);
          cmpfin_phase(ws, gx, gslot, p, shm);
          grid.sync();
          p = launder_p(p0);
#pragma unroll 1
          for (int it = grab(ws, p->ctr + 5, shm); it < 2048;) {
            const int nx_ = grab_begin(ws, p->ctr + 5);
            nsa_item(ws, p, shm, it);
            it = grab_end(ws, nx_, shm);
          }
          grid.sync();
        }
        {
          p = launder_p(p0);
          modl = p->mod + (long)l * 4 * 9216;
          const u16* W = l == 0 ? p->wtout0 : p->wtout1;
          const float* gate = modl + 5 * DM;
          float* xo = p->out;
          auto desc = [&](int pm, int pn) { return TileDesc{p->h + (long)pm * 256 * DM, DM, 64, W + (long)pn * 256 * DM, DM, DM / 64}; };
          auto epi = [&](int pm, int pn, Acc8& acc, int wr, int wc, int fr, int fq) {
            const int b = (pm * 256) >> 13;
#pragma unroll
            for (int bj = 0; bj < 2; ++bj)
#pragma unroll
              for (int n = 0; n < 2; ++n) {
                const int col = pn * 256 + bj * 128 + wc * 32 + n * 16 + fr;
                const float gv = gate[(long)b * 9216 + col];
#pragma unroll
                for (int ai = 0; ai < 2; ++ai)
#pragma unroll
                  for (int m = 0; m < 4; ++m) {
                    const long row0 = (long)pm * 256 + ai * 128 + wr * 64 + m * 16 + fq * 4;
                    const f32x4 a = acc[ai][bj][m][n];
                    rmw_pair_f32(xo + row0 * DM + (col & ~1), xo + row0 * DM + (col & ~1), DM, col & 1, gv * a[0], gv * a[1], gv * a[2], gv * a[3]);
                    asm volatile("" ::: "memory");
                  }
              }
          };
          gemm_phase(ws, gx, gslot, shm, NT / 256, DM / 256, desc, epi);
          seam();
        }
      }
    }
  };
  half(0, 0);
  half(0, 1);
  half(1, 0);
  half(1, 1);
  { PP p = launder_p(p0); final_norm_phase(ws, gx, gslot, p->out, p->fng); }
}

extern "C" void kernel_launch(void* const* d_in, const int* in_sizes, int n_in, void* d_out, int out_size, void* d_ws, size_t ws_size,
                              hipStream_t stream) {
  Params p;
  memset(&p, 0, sizeof(p));
  const float** fp = (const float**)&p.x;
  for (int i = 0; i < 22; ++i) fp[i] = (const float*)d_in[i];
  p.out = (float*)d_out;
  char* ws = (char*)d_ws;
  size_t off = 0;
  auto take = [&](size_t bytes) { char* r = ws + off; off += (bytes + 255) & ~(size_t)255; return r; };
  p.wt1 = (u16*)take((size_t)4 * 5632 * 1024 * 2);
  p.wt2 = (u16*)take((size_t)4 * 1024 * DFF * 2);
  p.wtin0 = (u16*)take((size_t)IN0 * 1024 * 2);
  p.wtout0 = (u16*)take((size_t)1024 * 1024 * 2);
  p.wtin1 = (u16*)take((size_t)IN1P * 1024 * 2);
  p.wtout1 = (u16*)take((size_t)1024 * 1024 * 2);
  p.wtcmp = (u16*)take((size_t)2 * 256 * 1024 * 2);
  p.wat = (u16*)take((size_t)2 * 8 * 64 * 64 * 2);
  p.mod = (float*)take((size_t)2 * 4 * 9216 * 4);
  p.rope = (float*)take((size_t)SEQ * 16 * 4);
  p.cvec = (float*)take(2 * 128 * 4);
  p.cent = (float*)take((size_t)4 * 8 * 32 * 64 * 4);
  p.lrusum = (float*)take((size_t)4 * 128 * 512 * 2 * 4);
  p.pq = (float*)take((size_t)2 * 4096 * 256 * 4);
  p.h = (u16*)take((size_t)NT * 1024 * 2);
  p.big = (u16*)take((size_t)NT * DFF * 2);
  p.vt = (u16*)take((size_t)NT * 512 * 2);
  p.kcmp = (u16*)take((size_t)8 * 512 * 64 * 2);
  p.vcmpT = (u16*)take((size_t)8 * 512 * 64 * 2);
  p.mcnt = (unsigned*)take(1024 * 4);
  p.ctr = (unsigned*)take(64 * 4);
  p.xcnt = (unsigned*)take(64 * 4);
  p.lbar = (unsigned*)take(8 * 64 * 4);
  p.mlist = (unsigned*)take((size_t)32 * 126976 * 4);
  p.part = (u16*)take((size_t)NT * 8 * 3 * 144);
  int nj = 0, t0 = 0;
  auto add = [&](const float* src, u16* dst, int K, int N, int ldn, int perm, int npad) {
    TJob& j = p.jobs[nj++];
    j.src = src; j.dst = dst; j.K = K; j.N = N; j.ldn = ldn; j.perm = perm; j.tile0 = t0; j.ntn = npad / 64;
    t0 += (K / 64) * ((npad / 64 + 3) / 4);
  };
  for (int i = 0; i < 4; ++i) add(p.ffn_w1 + (size_t)i * 1024 * 5632, p.wt1 + (size_t)i * 5632 * 1024, 1024, 5632, 5632, 1, 5632);
  for (int i = 0; i < 4; ++i) add(p.ffn_w2 + (size_t)i * DFF * 1024, p.wt2 + (size_t)i * 1024 * DFF, DFF, 1024, 1024, 0, 1024);
  add(p.mix0_in_w, p.wtin0, 1024, IN0, IN0, 0, IN0);
  add(p.mix0_out_w, p.wtout0, 1024, 1024, 1024, 0, 1024);
  add(p.mix1_in_w, p.wtin1, 1024, IN1, IN1, 0, IN1P);
  add(p.mix1_out_w, p.wtout1, 1024, 1024, 1024, 0, 1024);
  for (int kv = 0; kv < 2; ++kv)
    for (int hf = 0; hf < 2; ++hf)
      add(p.cmp_w1 + ((size_t)kv * 2048 + hf * 1024) * 128, p.wtcmp + ((size_t)kv * 256 + hf * 128) * 1024, 1024, 128, 128, 0, 128);
  for (int n = 0; n < 8; ++n) add(p.wa + (size_t)n * 4096, p.wat + (size_t)n * 4096, 64, 64, 64, 0, 64);
  for (int n = 0; n < 8; ++n) add(p.wx + (size_t)n * 4096, p.wat + (size_t)(8 + n) * 4096, 64, 64, 64, 0, 64);
  p.njobs = nj;
  p.ntr_tiles = t0;

  static int grid_blocks = 0;
  if (!grid_blocks) {
    int dev = 0, cus = 0, per_cu = 0;
    (void)hipGetDevice(&dev);
    (void)hipDeviceGetAttribute(&cus, hipDeviceAttributeMultiprocessorCount, dev);
    (void)hipOccupancyMaxActiveBlocksPerMultiprocessor(&per_cu, fwd_kernel, NTHR, 0);
    if (per_cu < 1) per_cu = 1;
    grid_blocks = cus * 1;
  }
  void* args[] = {&p};
  hipError_t e = hipLaunchCooperativeKernel((void*)fwd_kernel, dim3(grid_blocks), dim3(NTHR), args, 0, stream);
  if (e != hipSuccess) fprintf(stderr, "cooperative launch failed: %s (grid %d)\n", hipGetErrorString(e), grid_blocks);
}
```

```cpp
#include <hip/hip_runtime.h>
#include <hip/hip_cooperative_groups.h>
#include <stdint.h>
#include <stdio.h>
#include <string.h>
namespace cg = cooperative_groups;

typedef unsigned short u16;
typedef __attribute__((ext_vector_type(8))) short bf16x8;
typedef __attribute__((ext_vector_type(4))) short s16x4;
typedef __attribute__((ext_vector_type(4))) float f32x4;
typedef __attribute__((ext_vector_type(16))) float f32x16;
typedef __attribute__((ext_vector_type(4))) int i32x4;
typedef __attribute__((ext_vector_type(4))) unsigned u32x4;
typedef __attribute__((ext_vector_type(2))) unsigned u32x2;

#define DI __device__ __forceinline__
#define MFMA32(a, b, c) __builtin_amdgcn_mfma_f32_32x32x16_bf16((a), (b), (c), 0, 0, 0)
#define MFMA16(a, b, c) __builtin_amdgcn_mfma_f32_16x16x32_bf16((a), (b), (c), 0, 0, 0)

constexpr int NB = 4, SEQ = 8192, DM = 1024, NT = NB * SEQ, DFF = 2816;
constexpr int IN0 = 2560, IN1 = 1840, IN1P = 2048;
constexpr int NTHR = 512;
constexpr int NJOBS = 32;

struct TJob { const float* src; u16* dst; int K, N, ldn, perm, tile0, ntn; };

struct Params {
  const float *x, *c, *mod_w, *mod_b, *norm_g, *ffn_w1, *ffn_w2, *mix0_in_w, *conv_w, *conv_b, *wa, *ba, *wx, *bx, *lam,
      *mix0_out_w, *mix1_in_w, *cmp_pos, *cmp_w1, *cmp_w2, *mix1_out_w, *fng;
  float* out;
  u16 *wt1, *wt2, *wtin0, *wtout0, *wtin1, *wtout1, *wtcmp, *wat;
  float *mod, *rope, *cvec, *cent, *lrusum, *pq;
  u16 *h, *big, *vt, *kcmp, *vcmpT;
  unsigned *mcnt, *mlist, *ctr, *xcnt, *lbar;
  u16* part;
  TJob jobs[NJOBS];
  int njobs, ntr_tiles;
};

typedef const __attribute__((address_space(4))) Params* PP;
DI PP launder_p(PP p) { asm volatile("" : "+s"(p)); return p; }

typedef __attribute__((ext_vector_type(2))) float f32x2_;
typedef __attribute__((ext_vector_type(2))) __bf16 bf16x2_;
DI uint32_t pack2(float a, float b) {
  f32x2_ v = {a, b};
  return __builtin_bit_cast(uint32_t, __builtin_convertvector(v, bf16x2_));
}
DI u16 f2bf(float f) { return (u16)(pack2(f, 0.f) & 0xffffu); }
DI float bf2f(u16 h) { return __uint_as_float(((uint32_t)h) << 16); }
DI float bflo(uint32_t w) { return __uint_as_float(w << 16); }
DI float bfhi(uint32_t w) { return __uint_as_float(w & 0xffff0000u); }

DI void wt16(u16* p, u16 v) { *p = v; }
DI void wt32u(unsigned* p, unsigned v) { *p = v; }
DI void wt32f(float* p, float v) { *p = v; }
DI void wt64(void* p, u32x2 v) { *(u32x2*)p = v; }
DI void wt128(void* p, u32x4 v) { *(u32x4*)p = v; }
DI bf16x8 pack8(float a0, float a1, float a2, float a3, float a4, float a5, float a6, float a7) {
  u32x4 p;
  asm volatile("v_cvt_pk_bf16_f32 %0, %4, %5\n\tv_cvt_pk_bf16_f32 %1, %6, %7\n\tv_cvt_pk_bf16_f32 %2, %8, %9\n\tv_cvt_pk_bf16_f32 %3, %10, %11\n\ts_nop 1"
               : "=&v"(p[0]), "=&v"(p[1]), "=&v"(p[2]), "=&v"(p[3])
               : "v"(a0), "v"(a1), "v"(a2), "v"(a3), "v"(a4), "v"(a5), "v"(a6), "v"(a7));
  return __builtin_bit_cast(bf16x8, p);
}
DI int launder(int v) { asm volatile("" : "+v"(v)); return v; }
DI int lane_id_() { int l = __builtin_amdgcn_mbcnt_hi(-1, __builtin_amdgcn_mbcnt_lo(-1, 0)); asm volatile("" : "+v"(l)); return l; }
DI int grab_begin(int ws, unsigned* ctr) {
  int v = 0;
  if (ws == 0 && lane_id_() == 0) v = (int)atomicAdd(ctr, 1u);
  return v;
}
DI int grab_end(int ws, int v, char* shm) {
  int* slot = (int*)(shm + 150016);
  __syncthreads();
  if (ws == 0 && lane_id_() == 0) *slot = v;
  __syncthreads();
  return *slot;
}
DI int grab(int ws, unsigned* ctr, char* shm) { return grab_end(ws, grab_begin(ws, ctr), shm); }
DI int mytid(int ws) { return launder(ws * 64 + lane_id_()); }
template <int M> DI int shxi(int v) {
  if (M < 32) return __builtin_amdgcn_ds_swizzle(v, (M << 10) | 0x1f);
  auto r = __builtin_amdgcn_permlane32_swap((unsigned)v, (unsigned)v, false, false);
  return (int)(r[0] ^ r[1] ^ (unsigned)v);
}
DI float sum8(float v) {
  v += __int_as_float(__builtin_amdgcn_update_dpp(0, __float_as_int(v), 0xB1, 0xF, 0xF, true));
  v += __int_as_float(__builtin_amdgcn_update_dpp(0, __float_as_int(v), 0x4E, 0xF, 0xF, true));
  v += __int_as_float(__builtin_amdgcn_update_dpp(0, __float_as_int(v), 0x141, 0xF, 0xF, true));
  return v;
}
DI float dppx1(float v) { return __int_as_float(__builtin_amdgcn_update_dpp(0, __float_as_int(v), 0xB1, 0xF, 0xF, true)); }
DI void store_pair_bf16(u16* base_even, long ld, bool odd, float v0, float v1, float v2, float v3) {
  const float sx = odd ? v0 : v2, sy = odd ? v1 : v3;
  const float rx = dppx1(sx), ry = dppx1(sy);
  const uint32_t p0 = odd ? pack2(rx, v2) : pack2(v0, rx);
  const uint32_t p1 = odd ? pack2(ry, v3) : pack2(v1, ry);
  u16* q = base_even + (odd ? 2 * ld : 0);
  *(uint32_t*)q = p0;
  *(uint32_t*)(q + ld) = p1;
}
DI void rmw_pair_f32(float* xo_even, const float* xi_even, long ld, bool odd, float v0, float v1, float v2, float v3) {
  const float sx = odd ? v0 : v2, sy = odd ? v1 : v3;
  const float rx = dppx1(sx), ry = dppx1(sy);
  const long off = odd ? 2 * ld : 0;
  const float2 a0 = *(const float2*)(xi_even + off), a1 = *(const float2*)(xi_even + off + ld);
  float2 o0, o1;
  if (odd) { o0 = float2{a0.x + rx, a0.y + v2}; o1 = float2{a1.x + ry, a1.y + v3}; }
  else     { o0 = float2{a0.x + v0, a0.y + rx}; o1 = float2{a1.x + v1, a1.y + ry}; }
  *(float2*)(xo_even + off) = o0;
  *(float2*)(xo_even + off + ld) = o1;
}
DI float xmax32(float v) {
  auto r = __builtin_amdgcn_permlane32_swap(__float_as_uint(v), __float_as_uint(v), false, false);
  return fmaxf(__uint_as_float(r[0]), __uint_as_float(r[1]));
}
DI float xsum32(float v) {
  auto r = __builtin_amdgcn_permlane32_swap(__float_as_uint(v), __float_as_uint(v), false, false);
  return __uint_as_float(r[0]) + __uint_as_float(r[1]);
}
template <int M> DI float shxf(float v) { return __int_as_float(shxi<M>(__float_as_int(v))); }
DI float sigmoidf_(float x) { return __builtin_amdgcn_rcpf(1.f + __expf(-x)); }
DI float gelu_tanh(float x) {
  const float z = 0.7978845608028654f * (x + 0.044715f * x * x * x);
  const float th = 1.f - 2.f * __builtin_amdgcn_rcpf(1.f + __expf(2.f * z));
  return 0.5f * x * (1.f + th);
}

template <int KS> DI int lds_byte(int r, int c) {
  int st = (r >> 4) * KS + (c >> 5), ob = (r & 15) * 64 + (c & 31) * 2;
  return st * 1024 + (ob ^ (((ob >> 9) & 1) << 5));
}
template <int KS> DI void stage_rc(int b, int& R, int& C) {
  int st = b >> 10, sb = b & 1023, swz = sb ^ (((sb >> 9) & 1) << 5);
  R = (st / KS) * 16 + swz / 64;
  C = (st % KS) * 32 + (swz % 64) / 2;
}
#define WAIT_V(n) asm volatile("s_waitcnt vmcnt(%0)" ::"n"(n) : "memory")

struct TileDesc { const u16* a; long lda, kts; const u16* b; long ldb; int nt; };

typedef f32x4 Acc8[2][2][4][2];
template <class Epi>
DI void gemm_tile(int ws, char* shmc, const TileDesc& td, Epi& epi, int pm, int pn, bool first, bool has_next, const TileDesc& tdn) {
  constexpr int BK = 64, HALF = 128, HT = HALF * BK;
  u16* shm = (u16*)shmc;
  const int tid = mytid(ws), wid = tid >> 6, lane = tid & 63, wr = wid >> 2, wc = wid & 3, fr = lane & 15, fq = lane >> 4;
  const u16* ABASE = td.a;
  const u16* BBASE = td.b;
  const long lda = td.lda, kts = td.kts, ldb = td.ldb;
  const int nt = td.nt;
#define SA(b, h) (shm + ((b) * 2 + (h)) * HT)
#define SB(b, h) (shm + (4 + (b) * 2 + (h)) * HT)
  unsigned voffA, voffB;
  {
    int r0_, c0_;
    stage_rc<2>(tid * 16, r0_, c0_);
    voffA = (unsigned)(r0_ * (int)lda + c0_);
    voffB = (unsigned)(r0_ * (int)ldb + c0_);
  }
#define STAGE_A(P, hf, kt)                                                                                     \
  do {                                                                                                         \
    _Pragma("unroll") for (int _i = 0; _i < 2; ++_i)                                                           \
      __builtin_amdgcn_global_load_lds((const unsigned*)((ABASE + (long)((hf) * HALF + 64 * _i) * lda + (long)(kt) * kts) + voffA), \
                                       (__attribute__((address_space(3))) unsigned*)((char*)(P) + tid * 16 + _i * 8192), 16, 0, 0); \
  } while (0)
#define STAGE_B(P, hf, kt)                                                                                     \
  do {                                                                                                         \
    _Pragma("unroll") for (int _i = 0; _i < 2; ++_i)                                                           \
      __builtin_amdgcn_global_load_lds((const unsigned*)((BBASE + (long)((hf) * HALF + 64 * _i) * ldb + (long)(kt) * BK) + voffB), \
                                       (__attribute__((address_space(3))) unsigned*)((char*)(P) + tid * 16 + _i * 8192), 16, 0, 0); \
  } while (0)
#define LDA_(dst, b, h)                                    \
  _Pragma("unroll") for (int m = 0; m < 4; ++m)            \
  _Pragma("unroll") for (int k = 0; k < 2; ++k)            \
      dst[m][k] = *(const bf16x8*)((const char*)SA(b, h) + lds_byte<2>(wr * 64 + m * 16 + fr, k * 32 + fq * 8))
#define LDB_(dst, b, h)                                    \
  _Pragma("unroll") for (int n = 0; n < 2; ++n)            \
  _Pragma("unroll") for (int k = 0; k < 2; ++k)            \
      dst[n][k] = *(const bf16x8*)((const char*)SB(b, h) + lds_byte<2>(wc * 32 + n * 16 + fr, k * 32 + fq * 8))
#define MMA_(ai, bj, AT, BT)                                                           \
  do {                                                                                 \
    __builtin_amdgcn_s_setprio(1);                                                     \
    _Pragma("unroll") for (int m = 0; m < 4; ++m)                                      \
    _Pragma("unroll") for (int n = 0; n < 2; ++n)                                      \
    _Pragma("unroll") for (int k = 0; k < 2; ++k)                                      \
        acc[ai][bj][m][n] = MFMA16(AT[m][k], BT[n][k], acc[ai][bj][m][n]);             \
    __builtin_amdgcn_s_setprio(0);                                                     \
  } while (0)
#define WV(n) asm volatile("s_waitcnt vmcnt(" #n ")" ::: "memory")
#define WL(n) asm volatile("s_waitcnt lgkmcnt(" #n ")" ::: "memory")
#define BAR __builtin_amdgcn_s_barrier()
#define SCHED __builtin_amdgcn_sched_barrier(0)
  Acc8 acc;
#pragma unroll
  for (int a = 0; a < 2; ++a)
#pragma unroll
    for (int b = 0; b < 2; ++b)
#pragma unroll
      for (int m = 0; m < 4; ++m)
#pragma unroll
        for (int n = 0; n < 2; ++n) acc[a][b][m][n] = f32x4{0.f, 0.f, 0.f, 0.f};
  bf16x8 At[4][2], B0[2][2], B1[2][2];
  if (first) {
    STAGE_B(SB(0, 0), 0, 0); STAGE_A(SA(0, 0), 0, 0);
    STAGE_B(SB(0, 1), 1, 0); STAGE_A(SA(0, 1), 1, 0);
  }
  if (wr == 1) BAR;
  WV(4); BAR;
  STAGE_B(SB(1, 0), 0, 1); STAGE_A(SA(1, 0), 0, 1); STAGE_B(SB(1, 1), 1, 1);
  WV(6); BAR;
  for (int t = 0; t < nt - 2; t += 2) {
    LDB_(B0, 0, 0); SCHED; LDA_(At, 0, 0); STAGE_A(SA(1, 1), 1, t + 1);
    WL(8); BAR; WL(0); MMA_(0, 0, At, B0); BAR; SCHED;
    LDB_(B1, 0, 1); STAGE_B(SB(0, 0), 0, t + 2);
    BAR; WL(0); MMA_(0, 1, At, B1); BAR;
    LDA_(At, 0, 1); STAGE_A(SA(0, 0), 0, t + 2);
    BAR; WL(0); MMA_(1, 0, At, B0); BAR; SCHED;
    STAGE_B(SB(0, 1), 1, t + 2);
    WV(6); BAR; MMA_(1, 1, At, B1); BAR;
    LDB_(B0, 1, 0); SCHED; LDA_(At, 1, 0); STAGE_A(SA(0, 1), 1, t + 2);
    WL(8); BAR; WL(0); MMA_(0, 0, At, B0); BAR; SCHED;
    LDB_(B1, 1, 1); STAGE_B(SB(1, 0), 0, t + 3);
    BAR; WL(0); MMA_(0, 1, At, B1); BAR;
    LDA_(At, 1, 1); STAGE_A(SA(1, 0), 0, t + 3);
    BAR; WL(0); MMA_(1, 0, At, B0); BAR; SCHED;
    STAGE_B(SB(1, 1), 1, t + 3);
    WV(6); BAR; MMA_(1, 1, At, B1); BAR;
  }
  { LDB_(B0, 0, 0); LDA_(At, 0, 0); STAGE_A(SA(1, 1), 1, nt - 1);
    BAR; WL(0); MMA_(0, 0, At, B0); BAR;
    LDB_(B1, 0, 1); BAR; WL(0); MMA_(0, 1, At, B1); BAR;
    LDA_(At, 0, 1); WV(4); BAR; WL(0); MMA_(1, 0, At, B0); MMA_(1, 1, At, B1); BAR; }
  { LDB_(B0, 1, 0); LDA_(At, 1, 0); WV(2); BAR; WL(0); MMA_(0, 0, At, B0); BAR;
    LDB_(B1, 1, 1); WV(0); BAR; WL(0); MMA_(0, 1, At, B1); BAR;
    LDA_(At, 1, 1); BAR; WL(0); MMA_(1, 0, At, B0); MMA_(1, 1, At, B1); BAR; }
  if (wr == 0) BAR;
  if (has_next) {
    ABASE = tdn.a;
    BBASE = tdn.b;
    STAGE_B(SB(0, 0), 0, 0); STAGE_A(SA(0, 0), 0, 0);
    STAGE_B(SB(0, 1), 1, 0); STAGE_A(SA(0, 1), 1, 0);
  }
  epi(pm, pn, acc, wr, wc, fr, fq);
  asm volatile("s_waitcnt vmcnt(0)" ::: "memory");
  __syncthreads();
#undef SA
#undef SB
#undef STAGE_A
#undef STAGE_B
#undef LDA_
#undef LDB_
#undef MMA_
#undef WV
#undef WL
#undef BAR
#undef SCHED
}

template <class Desc, class Epi>
DI void gemm_phase(int ws, int gx, int gslot, char* shm, int nM, int nN, Desc desc, Epi epi) {
  const int ntiles = nM * nN;
  const int G = gridDim.x, bid = blockIdx.x;
  const bool xcdmap = (G % 8 == 0) && (ntiles % 8 == 0);
  const int per = ntiles / 8, slots = G / 8;
  auto tile_at = [&](int i, int& pm, int& pn) -> bool {
    int t;
    if (xcdmap) {
      int lt = gslot + slots * i;
      if (lt >= per) return false;
      t = gx * per + lt;
    } else {
      t = bid + G * i;
      if (t >= ntiles) return false;
    }
    const int WGM = 8;
    int nig = WGM * nN, gid = t / nig, fm = gid * WGM, gsz = min(nM - fm, WGM);
    pm = fm + ((t % nig) % gsz);
    pn = (t % nig) / gsz;
    return true;
  };
  __syncthreads();
  int pm, pn;
  if (!tile_at(0, pm, pn)) return;
  TileDesc td = desc(pm, pn);
  bool first = true;
  for (int i = 0;; ++i) {
    int pmn = 0, pnn = 0;
    const bool more = tile_at(i + 1, pmn, pnn);
    TileDesc tdn = td;
    if (more) tdn = desc(pmn, pnn);
    gemm_tile(ws, shm, td, epi, pm, pn, first, more, tdn);
    if (!more) break;
    td = tdn; pm = pmn; pn = pnn; first = false;
  }
}

DI float wave_sum(float v) {
  v += shxf<32>(v); v += shxf<16>(v); v += shxf<8>(v); v += shxf<4>(v); v += shxf<2>(v); v += shxf<1>(v);
  return v;
}

DI void norm_rows4(int ws, int gx, int gslot, const float* x, u16* __restrict__ h, float* xout, const float* __restrict__ g,
                   const float* __restrict__ shift, const float* __restrict__ scale, bool fin) {
  const int tid_ = mytid(ws), wid = tid_ >> 6, lane = tid_ & 63;
  const int rbase = gx * (NT / 8) + gslot * (NT / 8 / (gridDim.x / 8)) + wid * (NT / 8 / (gridDim.x / 8) / 8);
  const int rcnt = NT / 8 / (gridDim.x / 8) / 8;
  const int b = rbase >> 13;
  float4 mul[4], add[4];
#pragma unroll
  for (int i = 0; i < 4; ++i) {
    const int c4 = lane + 64 * i;
    const float4 gg = ((const float4*)g)[c4];
    if (fin) {
      mul[i] = gg;
      add[i] = float4{0.f, 0.f, 0.f, 0.f};
    } else {
      const float4 sc = ((const float4*)(scale + (long)b * 9216))[c4];
      mul[i] = float4{gg.x * (1.f + sc.x), gg.y * (1.f + sc.y), gg.z * (1.f + sc.z), gg.w * (1.f + sc.w)};
      add[i] = ((const float4*)(shift + (long)b * 9216))[c4];
    }
  }
#pragma unroll 1
  for (int r = 0; r < rcnt; r += 4) {
    float4 v[4][4];
    float rs[4];
#pragma unroll
    for (int q = 0; q < 4; ++q) {
      const float4* xr = (const float4*)(x + (long)(rbase + r + q) * DM);
#pragma unroll
      for (int i = 0; i < 4; ++i) v[q][i] = xr[lane + 64 * i];
    }
#pragma unroll
    for (int q = 0; q < 4; ++q) {
      float a = 0.f;
#pragma unroll
      for (int i = 0; i < 4; ++i) a += v[q][i].x * v[q][i].x + v[q][i].y * v[q][i].y + v[q][i].z * v[q][i].z + v[q][i].w * v[q][i].w;
      rs[q] = rsqrtf(wave_sum(a) * (1.f / DM) + 1e-6f);
    }
#pragma unroll
    for (int q = 0; q < 4; ++q) {
      const long row = rbase + r + q;
#pragma unroll
      for (int i = 0; i < 4; ++i) {
        const int c4 = lane + 64 * i;
        const float y0 = v[q][i].x * rs[q] * mul[i].x + add[i].x, y1 = v[q][i].y * rs[q] * mul[i].y + add[i].y;
        const float y2 = v[q][i].z * rs[q] * mul[i].z + add[i].z, y3 = v[q][i].w * rs[q] * mul[i].w + add[i].w;
        if (fin) {
          ((float4*)(xout + row * DM))[c4] = float4{y0, y1, y2, y3};
        } else {
          u32x2 pk = {pack2(y0, y1), pack2(y2, y3)};
          wt64(h + row * DM + c4 * 4, pk);
        }
      }
    }
  }
}
DI void norm_phase(int ws, int gx, int gslot, const float* __restrict__ x, u16* __restrict__ h, const float* __restrict__ g, const float* __restrict__ shift,
                   const float* __restrict__ scale  ) {
  norm_rows4(ws, gx, gslot, x, h, nullptr, g, shift, scale, false);
}
DI void final_norm_phase(int ws, int gx, int gslot, float* __restrict__ x, const float* __restrict__ g) {
  norm_rows4(ws, gx, gslot, x, nullptr, x, g, g, g, true);
}

DI void prep_phase(int ws, PP p, char* shm) {
  const int tid = mytid(ws);
  float* fs = (float*)shm;
  const int n_tr = p->ntr_tiles;
  const int n_mod = 2 * 144;
  const int n_cv = 8;
  const int n_rope = 128;
  const int n_misc = 1;
  const int total = n_tr + n_mod + n_cv + n_rope + n_misc;
  for (int it = blockIdx.x; it < total; it += gridDim.x) {
    if (it < n_tr) {
      int j = 0;
      for (int q = 1; q < p->njobs; ++q)
        if (it >= p->jobs[q].tile0) j = q;
      TJob jb;
      jb.src = p->jobs[j].src; jb.dst = p->jobs[j].dst; jb.K = p->jobs[j].K; jb.N = p->jobs[j].N; jb.ldn = p->jobs[j].ldn; jb.perm = p->jobs[j].perm; jb.tile0 = p->jobs[j].tile0; jb.ntn = p->jobs[j].ntn;
      const int lt = it - jb.tile0;
      const int ngn = (jb.ntn + 3) >> 2;
      const int tk = lt / ngn, tg4 = lt % ngn;
      const int k0 = tk * 64;
      float4 v[4][2];
#pragma unroll
      for (int u = 0; u < 4; ++u)
#pragma unroll
        for (int rep = 0; rep < 2; ++rep) {
          const int idx = tid + rep * 512, r = idx >> 4, c4 = idx & 15;
          const int n = (tg4 * 4 + u) * 64 + c4 * 4;
          v[u][rep] = float4{0.f, 0.f, 0.f, 0.f};
          if (tg4 * 4 + u < jb.ntn && n < jb.N) v[u][rep] = *(const float4*)(jb.src + (long)(k0 + r) * jb.ldn + n);
        }
#pragma unroll
      for (int u = 0; u < 4; ++u)
#pragma unroll
        for (int rep = 0; rep < 2; ++rep) {
          const int idx = tid + rep * 512, r = idx >> 4, c4 = idx & 15;
          float* f = fs + u * (64 * 65) + r * 65 + c4 * 4;
          f[0] = v[u][rep].x; f[1] = v[u][rep].y; f[2] = v[u][rep].z; f[3] = v[u][rep].w;
        }
      __syncthreads();
#pragma unroll
      for (int u = 0; u < 4; ++u) {
        if (tg4 * 4 + u < jb.ntn) {
          const int n = tid >> 3, ks = tid & 7;
          float e[8];
#pragma unroll
          for (int q = 0; q < 8; ++q) e[q] = fs[u * (64 * 65) + (ks * 8 + q) * 65 + n];
          int ng = (tg4 * 4 + u) * 64 + n, drow = ng;
          if (jb.perm == 1) {
            int isb = ng >= DFF ? 1 : 0, jj = ng - isb * DFF;
            drow = (jj >> 4) * 32 + isb * 16 + (jj & 15);
          }
          u32x4 pk = {pack2(e[0], e[1]), pack2(e[2], e[3]), pack2(e[4], e[5]), pack2(e[6], e[7])};
          wt128(jb.dst + (long)drow * jb.K + k0 + ks * 8, pk);
        }
      }
      __syncthreads();
    } else if (it < n_tr + n_mod) {
      const int q = it - n_tr, l = q / 144, cg0 = (q % 144) * 64;
      for (int i = tid; i < 4096; i += NTHR) {
        float cv = p->c[i];
        fs[i] = cv / (1.f + __expf(-cv));
      }
      __syncthreads();
      const int col = tid & 63, kg = tid >> 6;
      const float* w = p->mod_w + (long)l * DM * 9216 + cg0 + col;
      float a0 = 0.f, a1 = 0.f, a2 = 0.f, a3 = 0.f;
#pragma unroll 16
      for (int k = kg * 128; k < kg * 128 + 128; ++k) {
        float wv = w[(long)k * 9216];
        a0 += fs[k] * wv;
        a1 += fs[1024 + k] * wv;
        a2 += fs[2048 + k] * wv;
        a3 += fs[3072 + k] * wv;
      }
      __syncthreads();
      float* red = fs;
      red[(kg * 4 + 0) * 64 + col] = a0;
      red[(kg * 4 + 1) * 64 + col] = a1;
      red[(kg * 4 + 2) * 64 + col] = a2;
      red[(kg * 4 + 3) * 64 + col] = a3;
      __syncthreads();
      if (tid < 256) {
        int b = tid >> 6;
        float s = 0.f;
#pragma unroll
        for (int g = 0; g < 8; ++g) s += red[(g * 4 + b) * 64 + col];
        wt32f(p->mod + ((long)l * 4 + b) * 9216 + cg0 + col, s + p->mod_b[(long)l * 9216 + cg0 + col]);
      }
      __syncthreads();
    } else if (it < n_tr + n_mod + n_cv) {
      const int q = it - n_tr - n_mod, kv = q >> 2, n = (q & 3) * 32 + (tid & 31), kg = tid >> 5;
      const float* w1 = p->cmp_w1 + (long)kv * 2048 * 128;
      const float* pe = p->cmp_pos + (long)kv * 2048;
      float a = 0.f;
      for (int k = kg * 128; k < kg * 128 + 128; ++k) a += pe[k] * w1[(long)k * 128 + n];
      fs[kg * 32 + (tid & 31)] = a;
      __syncthreads();
      if (tid < 32) {
        float s = 0.f;
        for (int g = 0; g < 16; ++g) s += fs[g * 32 + tid];
        p->cvec[kv * 128 + (q & 3) * 32 + tid] = s;
      }
      __syncthreads();
    } else if (it < n_tr + n_mod + n_cv + n_rope) {
      const int q = it - n_tr - n_mod - n_cv;
      const int e = q * 512 + tid, pos = e >> 3, i = e & 7;
      const float freq = powf(500000.f, -(float)i * 0.125f);
      const float angf = (float)pos * freq;
      const double ang = (double)angf;
      const double n = rint(ang * 0.15915494309189535);
      double r = fma(-n, 6.283185307179586, ang);
      r = fma(-n, 2.4492935982947064e-16, r);
      const float rf = (float)r;
      p->rope[pos * 16 + i] = cosf(rf);
      p->rope[pos * 16 + 8 + i] = sinf(rf);
    } else {
      if (tid < 512) {
        int bg = tid >> 6, d = tid & 63;
        p->kcmp[((long)bg * 512 + 511) * 64 + d] = 0;
        p->vcmpT[((long)bg * 64 + d) * 512 + 511] = 0;
        p->mcnt[tid] = 0u;
        p->mcnt[512 + tid] = 0u;
        if (tid < 64) { p->ctr[tid] = 0u; p->xcnt[tid] = 0u; }
        p->lbar[tid] = 0u;
      }
    }
  }
}

constexpr int KVS = 72;
constexpr int KVT = 64 * KVS;
constexpr float SCL2 = 0.125f * 1.4426950408889634f;

DI void qk_tile(const u16* Ks, const bf16x8* qf, f32x16* s, int rl, int hh) {
#pragma unroll
  for (int kb = 0; kb < 2; ++kb) {
#pragma unroll
    for (int i = 0; i < 16; ++i) s[kb][i] = 0.f;
#pragma unroll
    for (int ks = 0; ks < 4; ++ks) {
      bf16x8 a = *(const bf16x8*)(Ks + (kb * 32 + rl) * KVS + ks * 16 + hh * 8);
      s[kb] = MFMA32(a, qf[ks], s[kb]);
    }
  }
}
DI void pv_tile(const u16* Vs, const f32x16* s, f32x16* o, int rl, int hh) {
#pragma unroll
  for (int kk = 0; kk < 4; ++kk) {
    const int kb = kk >> 1, i0 = 8 * (kk & 1);
    bf16x8 pf = pack8(s[kb][i0], s[kb][i0 + 1], s[kb][i0 + 2], s[kb][i0 + 3], s[kb][i0 + 4], s[kb][i0 + 5], s[kb][i0 + 6], s[kb][i0 + 7]);
#pragma unroll
    for (int db = 0; db < 2; ++db) {
      const u16* vp = Vs + (db * 32 + rl) * KVS + kk * 16 + hh * 4;
      s16x4 lo = *(const s16x4*)vp, hi = *(const s16x4*)(vp + 8);
      bf16x8 a = __builtin_shufflevector(lo, hi, 0, 1, 2, 3, 4, 5, 6, 7);
      o[db] = MFMA32(a, pf, o[db]);
    }
  }
}
DI float fexp2(float x) { return __builtin_amdgcn_exp2f(x); }
template <int MODE>
DI void osm(f32x16* s, uint32_t vm, float& m, float& l, f32x16* o) {
  float mx = -1e30f;
#pragma unroll
  for (int kb = 0; kb < 2; ++kb)
#pragma unroll
    for (int i = 0; i < 16; ++i) {
      if (MODE == 2) s[kb][i] = ((vm >> (kb * 16 + i)) & 1u) ? s[kb][i] : -1e30f;
      mx = fmaxf(mx, s[kb][i]);
    }
  mx *= SCL2;
  if (MODE == 1) mx = vm ? mx : -1e30f;
  mx = xmax32(mx);
  const float mn = fmaxf(m, mx);
  const float alpha = fexp2(m - mn);
  const bool rowok = (MODE == 1) ? (vm != 0u) : true;
  const float mu = (rowok && mn > -1e29f) ? mn : 1e30f;
  float rs = 0.f;
#pragma unroll
  for (int kb = 0; kb < 2; ++kb)
#pragma unroll
    for (int i = 0; i < 16; ++i) {
      const float pv = fexp2(__builtin_fmaf(s[kb][i], SCL2, -mu));
      s[kb][i] = pv;
      rs += pv;
    }
  rs = xsum32(rs);
  l = l * alpha + rs;
  if (__ballot(mn > m) != 0ull) {
#pragma unroll
    for (int db = 0; db < 2; ++db)
#pragma unroll
      for (int i = 0; i < 16; ++i) o[db][i] *= alpha;
  }
  m = mn;
}
DI void online_softmax(f32x16* s, uint32_t vm, float& m, float& l, f32x16* o) {
  const unsigned long long ball = __ballot(vm == 0xffffffffu), bnone = __ballot(vm == 0u);
  if (ball == ~0ull) osm<0>(s, vm, m, l, o);
  else if ((ball | bnone) == ~0ull) osm<1>(s, vm, m, l, o);
  else osm<2>(s, vm, m, l, o);
}
DI uint32_t range_mask(int kpos0, int lo, int hi, int hh) {
  if (kpos0 >= lo && kpos0 + 63 <= hi) return 0xffffffffu;
  if (kpos0 > hi || kpos0 + 63 < lo) return 0u;
  uint32_t vm = 0;
#pragma unroll
  for (int kb = 0; kb < 2; ++kb)
#pragma unroll
    for (int i = 0; i < 16; ++i) {
      int kp = kpos0 + kb * 32 + hh * 4 + (i & 3) + 8 * (i >> 2);
      vm |= (kp >= lo && kp <= hi) ? (1u << (kb * 16 + i)) : 0u;
    }
  return vm;
}

struct KVRegs { u32x4 k, v; };
DI void kv_issue(KVRegs& r, const u16* kptr, long ldk, const u16* vptr, long ldv, int tid) {
  const int row = tid >> 3, seg = tid & 7;
  r.k = *(const u32x4*)(kptr + (long)row * ldk + seg * 8);
  r.v = *(const u32x4*)(vptr + (long)row * ldv + seg * 8);
}
DI void kv_write(const KVRegs& r, u16* Ks, u16* Vs, int tid) {
  const int row = tid >> 3, seg = tid & 7;
  *(u32x4*)(Ks + row * KVS + seg * 8) = r.k;
  *(u32x4*)(Vs + row * KVS + seg * 8) = r.v;
}
template <class TF, class BODY>
DI void kv_loop(u16* kvb, int ntiles, int tid, TF tf, BODY body) {
  KVRegs r;
  const u16 *kp, *vp;
  long ldk, ldv;
  __syncthreads();
  if (ntiles > 0) {
    tf(0, kp, ldk, vp, ldv);
    kv_issue(r, kp, ldk, vp, ldv, tid);
    kv_write(r, kvb, kvb + KVT, tid);
  }
  __syncthreads();
  for (int i = 0; i < ntiles; ++i) {
    const int cur = i & 1;
    if (i + 1 < ntiles) {
      tf(i + 1, kp, ldk, vp, ldv);
      kv_issue(r, kp, ldk, vp, ldv, tid);
    }
    body(i, kvb + cur * 2 * KVT, kvb + cur * 2 * KVT + KVT);
    if (i + 1 < ntiles) kv_write(r, kvb + (cur ^ 1) * 2 * KVT, kvb + (cur ^ 1) * 2 * KVT + KVT, tid);
    __syncthreads();
  }
}
DI void load_qf(bf16x8* qf, const u16* qrow, int hh) {
#pragma unroll
  for (int ks = 0; ks < 4; ++ks) qf[ks] = *(const bf16x8*)(qrow + ks * 16 + hh * 8);
}
DI bf16x8 rope_frag(bf16x8 f, const float* cs  , int hh) {
  u32x4 w = __builtin_bit_cast(u32x4, f), ow;
#pragma unroll
  for (int q = 0; q < 4; ++q) ow[q] = shxi<32>((int)w[q]);
  float mine[8], oth[8], res[8];
#pragma unroll
  for (int q = 0; q < 4; ++q) {
    mine[2 * q] = bflo(w[q]); mine[2 * q + 1] = bfhi(w[q]);
    oth[2 * q] = bflo(ow[q]); oth[2 * q + 1] = bfhi(ow[q]);
  }
  const float sg = hh ? 1.f : -1.f;
#pragma unroll
  for (int i = 0; i < 8; ++i) res[i] = mine[i] * cs[i] + sg * oth[i] * cs[8 + i];
  u32x4 r = {pack2(res[0], res[1]), pack2(res[2], res[3]), pack2(res[4], res[5]), pack2(res[6], res[7])};
  return __builtin_bit_cast(bf16x8, r);
}
DI void store_o(u16* yrow, const f32x16* o, float scale, int hh) {
#pragma unroll
  for (int db = 0; db < 2; ++db)
#pragma unroll
    for (int q = 0; q < 4; ++q) {
      u32x2 pk = {pack2(o[db][4 * q] * scale, o[db][4 * q + 1] * scale), pack2(o[db][4 * q + 2] * scale, o[db][4 * q + 3] * scale)};
      wt64(yrow + db * 32 + 8 * q + 4 * hh, pk);
    }
}

DI void kprep0_phase(int ws, PP p, char* shm) {
  const int tid = mytid(ws);
  float* fs = (float*)shm;
  u16* u = p->big;
  for (int item = blockIdx.x; item < 256; item += gridDim.x) {
    const int b = item >> 6, n = (item >> 1) & 31, hg = item & 1;
    const int cc = tid & 31, tg = tid >> 5, head = hg * 4 + (cc >> 3), dch = cc & 7;
    float sum[8];
#pragma unroll
    for (int e = 0; e < 8; ++e) sum[e] = 0.f;
#pragma unroll 1
    for (int tb = 0; tb < 16; tb += 8) {
    u32x4 wv[8];
#pragma unroll
    for (int t8 = 0; t8 < 8; ++t8) wv[t8] = *(const u32x4*)(u + ((long)b * SEQ + n * 256 + tg * 16 + tb + t8) * IN0 + 1536 + head * 64 + dch * 8);
#pragma unroll
    for (int t8 = 0; t8 < 8; ++t8) {
      const int tt = tb + t8;
      const int tok = n * 256 + tg * 16 + tt;
      u16* ptr = u + ((long)b * SEQ + tok) * IN0 + 1536 + head * 64 + dch * 8;
      u32x4 w = wv[t8], ow;
#pragma unroll
      for (int q = 0; q < 4; ++q) ow[q] = shxi<1>((int)w[q]);
      float mine[8], oth[8];
#pragma unroll
      for (int q = 0; q < 4; ++q) {
        mine[2 * q] = bflo(w[q]); mine[2 * q + 1] = bfhi(w[q]);
        oth[2 * q] = bflo(ow[q]); oth[2 * q + 1] = bfhi(ow[q]);
      }
      if (dch < 2) {
        const float* cs = p->rope + tok * 16;
        const float sg = dch ? 1.f : -1.f;
        float res[8];
#pragma unroll
        for (int i = 0; i < 8; ++i) res[i] = mine[i] * cs[i] + sg * oth[i] * cs[8 + i];
        u32x4 r = {pack2(res[0], res[1]), pack2(res[2], res[3]), pack2(res[4], res[5]), pack2(res[6], res[7])};
        wt128(ptr, r);
#pragma unroll
        for (int q = 0; q < 4; ++q) { mine[2 * q] = bflo(r[q]); mine[2 * q + 1] = bfhi(r[q]); }
      }
#pragma unroll
      for (int e = 0; e < 8; ++e) sum[e] += mine[e];
    }
    }
    __syncthreads();
#pragma unroll
    for (int e = 0; e < 8; ++e) fs[tg * 256 + cc * 8 + e] = sum[e];
    __syncthreads();
    if (tid < 256) {
      float t = 0.f;
#pragma unroll
      for (int g = 0; g < 16; ++g) t += fs[g * 256 + tid];
      wt32f(p->cent + (((long)b * 8 + hg * 4 + (tid >> 6)) * 32 + n) * 64 + (tid & 63), t * (1.f / 256.f));
    }
    __syncthreads();
  }
}

template <bool FINAL>
DI void lru_item(int ws, PP p, char* shm, int item) {
  const int tid = mytid(ws), wid = tid >> 6, lane = tid & 63, rl = lane & 31, hh = lane >> 5;
  const int b = item & 3, c = 127 - (item >> 2), t0 = c * 64;
  const u16* u = p->big;
  u16* XC = (u16*)shm + wid * KVT;
  {
    const int ch = wid * 64 + lane;
    const float w0 = p->conv_w[ch], w1 = p->conv_w[512 + ch], w2 = p->conv_w[1024 + ch], w3 = p->conv_w[1536 + ch], cb = p->conv_b[ch];
    const u16* up = u + ((long)b * SEQ + t0) * IN0 + ch;
    float xm3 = 0.f, xm2 = 0.f, xm1 = 0.f;
    if (t0 > 0) { xm3 = bf2f(up[-3 * IN0]); xm2 = bf2f(up[-2 * IN0]); xm1 = bf2f(up[-1 * IN0]); }
    for (int t = 0; t < 64; ++t) {
      float xv = bf2f(up[(long)t * IN0]);
      float xc = w0 * xm3 + w1 * xm2 + w2 * xm1 + w3 * xv + cb;
      XC[t * KVS + lane] = f2bf(xc);
      xm3 = xm2; xm2 = xm1; xm1 = xv;
    }
  }
  __syncthreads();
  const u16* wat = p->wat + (long)wid * 4096;
  const u16* wxt = p->wat + (long)(8 + wid) * 4096;
#pragma unroll 1
  for (int nb = 0; nb < 2; ++nb) {
    f32x16 ar[2], ai[2];
#pragma unroll
    for (int mb = 0; mb < 2; ++mb)
#pragma unroll
      for (int i = 0; i < 16; ++i) { ar[mb][i] = 0.f; ai[mb][i] = 0.f; }
#pragma unroll
    for (int ks = 0; ks < 4; ++ks) {
      bf16x8 ba_ = *(const bf16x8*)(wat + (nb * 32 + rl) * 64 + ks * 16 + hh * 8);
      bf16x8 bx_ = *(const bf16x8*)(wxt + (nb * 32 + rl) * 64 + ks * 16 + hh * 8);
#pragma unroll
      for (int mb = 0; mb < 2; ++mb) {
        bf16x8 a = *(const bf16x8*)(XC + (mb * 32 + rl) * KVS + ks * 16 + hh * 8);
        ar[mb] = MFMA32(a, ba_, ar[mb]);
        ai[mb] = MFMA32(a, bx_, ai[mb]);
      }
    }
    const int j = nb * 32 + rl, chj = wid * 64 + j;
    const float baj = p->ba[chj], bxj = p->bx[chj];
    const float la = -8.f * log1pf(__expf(-p->lam[chj]));
#pragma unroll
    for (int mb = 0; mb < 2; ++mb)
#pragma unroll
      for (int i = 0; i < 16; ++i) {
        const int tok = mb * 32 + hh * 4 + (i & 3) + 8 * (i >> 2);
        const float xc = bf2f(XC[tok * KVS + j]);
        const float r = sigmoidf_(ar[mb][i] + baj), ig = sigmoidf_(ai[mb][i] + bxj);
        const float aa = __expf(r * la);
        ar[mb][i] = aa;
        ai[mb][i] = __builtin_amdgcn_sqrtf(__builtin_fmaf(-aa, aa, 1.f)) * ig * xc;
      }
    float carry = 0.f, atot = 1.f;
    if (FINAL) {
      const float* sm = p->lrusum + ((long)b * 128 * 512 + chj) * 2;
#pragma unroll 8
      for (int cp = 0; cp < c; ++cp) {
        float2 ab = *(const float2*)(sm + (long)cp * 1024);
        carry = ab.y + ab.x * carry;
      }
    }
#pragma unroll
    for (int mb = 0; mb < 2; ++mb)
#pragma unroll
      for (int q = 0; q < 4; ++q) {
        float P = 1.f, H = 0.f;
#pragma unroll
        for (int e = 0; e < 4; ++e) {
          const int idx = 4 * q + e;
          H = ar[mb][idx] * H + ai[mb][idx];
          P *= ar[mb][idx];
          ar[mb][idx] = P;
          ai[mb][idx] = H;
        }
        const float Po = shxf<32>(P), Ho = shxf<32>(H);
        const float A0 = hh ? Po : P, B0 = hh ? Ho : H, A1 = hh ? P : Po, B1 = hh ? H : Ho;
        const float mid = B0 + A0 * carry;
        const float cin = hh ? mid : carry;
        carry = B1 + A1 * mid;
        atot *= A0 * A1;
        if (FINAL) {
          const int tl0 = launder(hh * 4);
#pragma unroll
          for (int e = 0; e < 4; ++e) {
            const int idx = 4 * q + e;
            const int tok = mb * 32 + tl0 + e + 8 * q;
            const float hv = ai[mb][idx] + ar[mb][idx] * cin;
            const long trow = (long)b * SEQ + t0 + tok;
            const float g = bf2f(u[trow * IN0 + 512 + chj]);
            wt16(p->h + trow * DM + chj, f2bf(hv * gelu_tanh(g)));
          }
        }
      }
    if (!FINAL && hh == 0) {
      float2 ab = {atot, carry};
      wt64(p->lrusum + (((long)b * 128 + c) * 512 + chj) * 2, __builtin_bit_cast(u32x2, ab));
    }
  }
  __syncthreads();
}

DI int moba_off(int n) { return 256 * (31 * n - (n * (n - 1)) / 2); }

DI void moba_gate_item(int ws, PP p, char* shm, int item) {
  const int tid = mytid(ws);
  const int qb = 31 - (item >> 5), b = (item >> 3) & 3, h = item & 7;
  if (qb == 0) return;
  const int t0 = qb * 256;
  const u16* u = p->big;
  float* cs = (float*)shm;
  float* tv = (float*)(shm + 8192);
  int* ti = (int*)(shm + 11264);
  __syncthreads();
  for (int i = tid; i < qb * 64; i += NTHR) cs[i] = p->cent[((long)(b * 8 + h) * 32) * 64 + i];
  __syncthreads();
  const int ql = tid & 255, half = tid >> 8, tq = t0 + ql;
  const u16* qp = u + ((long)b * SEQ + tq) * IN0 + 1024 + h * 64;
  float q[64];
#pragma unroll
  for (int s8 = 0; s8 < 8; ++s8) {
    u32x4 w = *(const u32x4*)(qp + s8 * 8);
#pragma unroll
    for (int e = 0; e < 4; ++e) { q[s8 * 8 + 2 * e] = bflo(w[e]); q[s8 * 8 + 2 * e + 1] = bfhi(w[e]); }
  }
  {
    const float* rc = p->rope + tq * 16;
#pragma unroll
    for (int i = 0; i < 8; ++i) {
      float x1 = q[i], x2 = q[8 + i], cc = rc[i], sn = rc[8 + i];
      q[i] = bf2f(f2bf(x1 * cc - x2 * sn));
      q[8 + i] = bf2f(f2bf(x2 * cc + x1 * sn));
    }
  }
  float v0 = -INFINITY, v1 = -INFINITY, v2 = -INFINITY;
  int i0 = -1, i1 = -1, i2 = -1;
  for (int n = half; n < qb; n += 2) {
    const float4* cr = (const float4*)(cs + n * 64);
    float d = 0.f;
#pragma unroll
    for (int e = 0; e < 16; ++e) {
      float4 cv = cr[e];
      d += q[4 * e] * cv.x + q[4 * e + 1] * cv.y + q[4 * e + 2] * cv.z + q[4 * e + 3] * cv.w;
    }
    if (d > v0) { v2 = v1; i2 = i1; v1 = v0; i1 = i0; v0 = d; i0 = n; }
    else if (d > v1) { v2 = v1; i2 = i1; v1 = d; i1 = n; }
    else if (d > v2) { v2 = d; i2 = n; }
  }
  if (half == 1) {
    tv[ql * 3] = v0; tv[ql * 3 + 1] = v1; tv[ql * 3 + 2] = v2;
    ti[ql * 3] = i0; ti[ql * 3 + 1] = i1; ti[ql * 3 + 2] = i2;
  }
  __syncthreads();
  if (half == 0) {
#pragma unroll
    for (int e = 0; e < 3; ++e) {
      const float d = tv[ql * 3 + e];
      const int n = ti[ql * 3 + e];
      if (n >= 0) {
        if (d > v0 || (d == v0 && n < i0)) { v2 = v1; i2 = i1; v1 = v0; i1 = i0; v0 = d; i0 = n; }
        else if (d > v1 || (d == v1 && n < i1)) { v2 = v1; i2 = i1; v1 = d; i1 = n; }
        else if (d > v2 || (d == v2 && n < i2)) { v2 = d; i2 = n; }
      }
    }
  }
  int* lcnt = (int*)(shm + 14336);
  if (tid < 64) lcnt[tid] = 0;
  __syncthreads();
  int r0 = 0, r1 = 0, r2 = 0;
  if (half == 0) {
    if (i0 >= 0) r0 = atomicAdd(&lcnt[i0], 1);
    if (i1 >= 0) r1 = atomicAdd(&lcnt[i1], 1);
    if (i2 >= 0) r2 = atomicAdd(&lcnt[i2], 1);
  }
  __syncthreads();
  const int bh = b * 8 + h;
  if (tid < 32 && lcnt[tid] > 0) lcnt[32 + tid] = (int)atomicAdd(&p->mcnt[bh * 32 + tid], (unsigned)lcnt[tid]);
  __syncthreads();
  if (half == 0) {
    unsigned* lst = p->mlist + (long)bh * 126976;
    if (i0 >= 0) wt32u(lst + moba_off(i0) + lcnt[32 + i0] + r0, ((unsigned)tq << 2) | 0u);
    if (i1 >= 0) wt32u(lst + moba_off(i1) + lcnt[32 + i1] + r1, ((unsigned)tq << 2) | 1u);
    if (i2 >= 0) wt32u(lst + moba_off(i2) + lcnt[32 + i2] + r2, ((unsigned)tq << 2) | 2u);
  }
}

DI void moba_gather_phase(int ws, PP p, char* shm) {
  const int tid = mytid(ws), wid = tid >> 6, lane = tid & 63, rl = lane & 31, hh = lane >> 5;
  const u16* u = p->big;
  u16* kvb = (u16*)shm;
  int* pre = (int*)(shm + 120000);
  __syncthreads();
  {
    const int c0 = (int)((p->mcnt[2 * tid] + 255u) >> 8), c1 = (int)((p->mcnt[2 * tid + 1] + 255u) >> 8);
    int sc = c0 + c1;
#pragma unroll
    for (int d = 1; d < 64; d <<= 1) {
      const int o = __shfl_up(sc, d);
      if (lane >= d) sc += o;
    }
    int* wtot = pre + 1032;
    if (lane == 63) wtot[wid] = sc;
    __syncthreads();
    int base = 0;
    for (int w = 0; w < wid; ++w) base += wtot[w];
    const int excl = base + sc - (c0 + c1);
    if (tid == 0) pre[0] = 0;
    pre[2 * tid + 1] = excl + c0;
    pre[2 * tid + 2] = excl + c0 + c1;
  }
  __syncthreads();
  const int total = pre[1024];
  const int row = tid >> 3, seg = tid & 7;
  u32x4 kr[4], vr[4];
  auto locate = [&](int it, int& li, int& chunk) {
    int lo = 0, hi = 1024;
    while (hi - lo > 1) {
      const int mid = (lo + hi) >> 1;
      if (pre[mid] <= it) lo = mid; else hi = mid;
    }
    li = lo;
    chunk = it - pre[lo];
  };
  auto issue = [&](int li) {
    const int bh = li >> 5, n = li & 31, b = bh >> 3, h = bh & 7;
    const u16* kbase = u + ((long)b * SEQ + n * 256) * IN0 + 1536 + h * 64;
    const u16* vbase = p->vt + ((long)bh * 64) * SEQ + n * 256;
#pragma unroll
    for (int st = 0; st < 4; ++st) {
      kr[st] = *(const u32x4*)(kbase + (long)(st * 64 + row) * IN0 + seg * 8);
      vr[st] = *(const u32x4*)(vbase + (long)row * SEQ + st * 64 + seg * 8);
    }
  };
  int li = 0, chunk = 0;
  int* gslot = (int*)(shm + 150016);
  auto fetch_ent = [&](int li_, int chunk_, bool& valid_) -> unsigned {
    const int bh_ = li_ >> 5, n_ = li_ & 31;
    const int e_ = chunk_ * 256 + wid * 32 + rl;
    valid_ = e_ < (int)p->mcnt[li_];
    return p->mlist[(long)bh_ * 126976 + moba_off(n_) + (valid_ ? e_ : 0)];
  };
  int it = grab(ws, p->ctr + 2, shm);
  bool valid = false;
  unsigned ent = 0;
  if (it < total) { locate(it, li, chunk); issue(li); ent = fetch_ent(li, chunk, valid); }
  bf16x8 qfn[4];
  bool have_qn = false;
#pragma unroll 1
  while (it < total) {
    const int bh = li >> 5, n = li & 31, b = bh >> 3, h = bh & 7;
    __syncthreads();
#pragma unroll
    for (int st = 0; st < 4; ++st) {
      *(u32x4*)(kvb + st * 2 * KVT + row * KVS + seg * 8) = kr[st];
      *(u32x4*)(kvb + st * 2 * KVT + KVT + row * KVS + seg * 8) = vr[st];
    }
    const int tq = (int)(ent >> 2), slot = (int)(ent & 3u);
    bf16x8 qf[4];
    if (have_qn) { qf[0] = qfn[0]; qf[1] = qfn[1]; qf[2] = qfn[2]; qf[3] = qfn[3]; }
    else load_qf(qf, u + ((long)b * SEQ + tq) * IN0 + 1024 + h * 64, hh);
    qf[0] = rope_frag(qf[0], p->rope + tq * 16, hh);
    if (tid == 0) *gslot = (int)atomicAdd(p->ctr + 2, 1u);
    f32x16 o[2];
#pragma unroll
    for (int db = 0; db < 2; ++db)
#pragma unroll
      for (int i = 0; i < 16; ++i) o[db][i] = 0.f;
    float m = -1e30f, l = 0.f;
    __syncthreads();
    const int itn = *gslot;
    int lin = 0, chunkn = 0;
    bool validn = false;
    unsigned entn = 0;
    if (itn < total) { locate(itn, lin, chunkn); issue(lin); entn = fetch_ent(lin, chunkn, validn); }
#pragma unroll
    for (int st = 0; st < 4; ++st) {
      f32x16 s[2];
      qk_tile(kvb + st * 2 * KVT, qf, s, rl, hh);
      osm<0>(s, 0xffffffffu, m, l, o);
      pv_tile(kvb + st * 2 * KVT + KVT, s, o, rl, hh);
      if (st == 1) {
        have_qn = itn < total;
        if (have_qn) {
          const int bhn = lin >> 5;
          load_qf(qfn, u + ((long)(bhn >> 3) * SEQ + (int)(entn >> 2)) * IN0 + 1024 + (bhn & 7) * 64, hh);
        }
      }
    }
    if (valid) {
      u16* pe = p->part + (((long)bh * SEQ + tq) * 3 + slot) * 72;
      store_o(pe + 8, o, 1.f / l, hh);
      if (hh == 0) { wt32f((float*)pe, m); wt32f((float*)pe + 1, l); }
    }
    li = lin; chunk = chunkn; it = itn; ent = entn; valid = validn;
  }
  __syncthreads();
}

DI void moba_own_item(int ws, PP p, char* shm, int item) {
  const int tid = mytid(ws), wid = tid >> 6, lane = tid & 63, rl = lane & 31, hh = lane >> 5;
  const int qb = 31 - (item >> 5), b = (item >> 3) & 3, h = item & 7;
  const int t0 = qb * 256;
  const u16* u = p->big;
  u16* kvb = (u16*)shm;
  const int tq = t0 + wid * 32 + rl;
  bf16x8 qf[4];
  load_qf(qf, u + ((long)b * SEQ + tq) * IN0 + 1024 + h * 64, hh);
  qf[0] = rope_frag(qf[0], p->rope + tq * 16, hh);
  f32x16 o[2];
#pragma unroll
  for (int db = 0; db < 2; ++db)
#pragma unroll
    for (int i = 0; i < 16; ++i) o[db][i] = 0.f;
  float m = -1e30f, l = 0.f;
  const u16* kbase = u + ((long)b * SEQ + t0) * IN0 + 1536 + h * 64;
  const u16* vbase = p->vt + ((long)(b * 8 + h) * 64) * SEQ + t0;
  auto tf = [&](int i, const u16*& kp, long& ldk, const u16*& vp, long& ldv) {
    kp = kbase + (long)i * 64 * IN0; ldk = IN0;
    vp = vbase + i * 64; ldv = SEQ;
  };
  auto body = [&](int i, const u16* Ks, const u16* Vs) {
    const uint32_t vm = range_mask(i * 64, 0, wid * 32 + rl, hh);
    if (__ballot(vm != 0) != 0ull) {
      f32x16 s[2];
      qk_tile(Ks, qf, s, rl, hh);
      online_softmax(s, vm, m, l, o);
      pv_tile(Vs, s, o, rl, hh);
    }
  };
  kv_loop(kvb, 4, tid, tf, body);
  const int nsl = qb < 3 ? qb : 3;
#pragma unroll
  for (int sl = 0; sl < 3; ++sl) {
    if (sl >= nsl) break;
    const u16* pe = p->part + (((long)(b * 8 + h) * SEQ + tq) * 3 + sl) * 72;
    const float ms = ((const float*)pe)[0], ls = ((const float*)pe)[1];
    const float mn = fmaxf(m, ms);
    const float a = fexp2(m - mn), c = fexp2(ms - mn) * ls;
#pragma unroll
    for (int db = 0; db < 2; ++db)
#pragma unroll
      for (int q = 0; q < 4; ++q) {
        const u32x2 w = *(const u32x2*)(pe + 8 + db * 32 + 8 * q + 4 * hh);
        o[db][4 * q] = o[db][4 * q] * a + c * bflo(w[0]);
        o[db][4 * q + 1] = o[db][4 * q + 1] * a + c * bfhi(w[0]);
        o[db][4 * q + 2] = o[db][4 * q + 2] * a + c * bflo(w[1]);
        o[db][4 * q + 3] = o[db][4 * q + 3] * a + c * bfhi(w[1]);
      }
    l = l * a + c;
    m = mn;
  }
  store_o(p->h + ((long)b * SEQ + tq) * DM + 512 + h * 64, o, 1.f / l, hh);
}

DI void rope1_phase(int ws, PP p) {
  const int tid = mytid(ws);
  u16* u = p->big;
  for (int e = blockIdx.x * NTHR + tid; e < NT * 4; e += gridDim.x * NTHR) {
    const int trow = e >> 2, w = e & 3, pos = trow & (SEQ - 1);
    u16* ptr = u + (long)trow * IN1P + ((w & 2) ? 1536 : 1280) + (w & 1) * 64;
    u32x4 a = *(const u32x4*)ptr, bq = *(const u32x4*)(ptr + 8);
    const float* cs = p->rope + pos * 16;
    float x1[8], x2[8], r1[8], r2[8];
#pragma unroll
    for (int q = 0; q < 4; ++q) { x1[2 * q] = bflo(a[q]); x1[2 * q + 1] = bfhi(a[q]); x2[2 * q] = bflo(bq[q]); x2[2 * q + 1] = bfhi(bq[q]); }
#pragma unroll
    for (int i = 0; i < 8; ++i) { r1[i] = x1[i] * cs[i] - x2[i] * cs[8 + i]; r2[i] = x2[i] * cs[i] + x1[i] * cs[8 + i]; }
    u32x4 oa = {pack2(r1[0], r1[1]), pack2(r1[2], r1[3]), pack2(r1[4], r1[5]), pack2(r1[6], r1[7])};
    u32x4 ob = {pack2(r2[0], r2[1]), pack2(r2[2], r2[3]), pack2(r2[4], r2[5]), pack2(r2[6], r2[7])};
    wt128(ptr, oa);
    wt128(ptr + 8, ob);
  }
}
DI void cmpfin_phase(int ws, int gx, int gslot, PP p, char* shm) {
  const int tid = mytid(ws);
  float* hid = (float*)shm;
  float* w2s = (float*)(shm + 4096);
  int kvl = -1;
  const int slots = gridDim.x >> 3;
  for (int li = gslot; li < 128; li += slots) {
    const int kv = gx >> 2, bg = 2 * (gx & 3) + (li >> 6), i0 = (li & 63) * 8;
    const int row = tid >> 6, n = tid & 63, i = i0 + row;
    const float* pq = p->pq + ((long)kv * 4096 + bg * 512) * 256;
    __syncthreads();
    if (kv != kvl) {
      const float* w2 = p->cmp_w2 + (long)kv * 128 * 64;
      for (int e = tid; e < 128 * 64; e += NTHR) w2s[e] = w2[e];
      kvl = kv;
    }
#pragma unroll
    for (int hf = 0; hf < 2; ++hf) {
      const int nn = n + hf * 64;
      float v = 0.f;
      if (i < 511) v = gelu_tanh(pq[(long)i * 256 + nn] + pq[(long)(i + 1) * 256 + 128 + nn] + p->cvec[kv * 128 + nn]);
      hid[row * 128 + nn] = v;
    }
    __syncthreads();
    float acc = 0.f;
#pragma unroll 8
    for (int k = 0; k < 128; ++k) acc += hid[row * 128 + k] * w2s[k * 64 + n];
    if (i < 511) {
      if (kv == 0) wt16(p->kcmp + ((long)bg * 512 + i) * 64 + n, f2bf(acc));
      else wt16(p->vcmpT + ((long)bg * 64 + n) * 512 + i, f2bf(acc));
    }
  }
  __syncthreads();
}

DI void nsa_item(int ws, PP p, char* shm, int item) {
  const int tid = mytid(ws), wid = tid >> 6, lane = tid & 63, rl = lane & 31, hh = lane >> 5;
  const int tt = 255 - (item >> 3), bg = item & 7, b = bg >> 1, g = bg & 1;
  const int t0 = tt * 32, tokl = wid * 4 + (rl >> 3), tok = t0 + tokl, r = rl & 7, hq = g * 8 + r;
  const u16* u = p->big;
  u16* kvb = (u16*)shm;
  float* impm = (float*)(shm + 36864);
  float* imps = (float*)(shm + 53760);
  float* vals = (float*)(shm + 70656);
  unsigned char* selb = (unsigned char*)(shm + 147456);
  uint32_t* un = (uint32_t*)(shm + 147968);
  int* tl = (int*)(shm + 148032);
  __syncthreads();
  for (int i = tid; i < 2 * 32 * 132; i += NTHR) impm[i] = 0.f;
  if (tid < 8) un[tid] = 0;
  const u16* qrow = u + ((long)b * SEQ + tok) * IN1P + hq * 64;
  bf16x8 qn[4], qr[4];
  load_qf(qn, qrow, hh);
  qr[0] = rope_frag(qn[0], p->rope + tok * 16, hh);
  qr[1] = qn[1]; qr[2] = qn[2]; qr[3] = qn[3];
  float gt[3];
#pragma unroll
  for (int br = 0; br < 3; ++br) gt[br] = sigmoidf_(bf2f(qrow[1792 - hq * 64 + hq * 3 + br]));
  f32x16 yacc[2], o[2];
#pragma unroll
  for (int db = 0; db < 2; ++db)
#pragma unroll
    for (int i = 0; i < 16; ++i) { yacc[db][i] = 0.f; o[db][i] = 0.f; }
  {
    const int nct = (t0 >> 10) + 1;
    const int cmax = (tok - 31) >> 4;
    const u16* kc = p->kcmp + (long)bg * 512 * 64;
    const u16* vc = p->vcmpT + (long)bg * 64 * 512;
    auto tf = [&](int i, const u16*& kp, long& ldk, const u16*& vp, long& ldv) {
      kp = kc + (long)i * 64 * 64; ldk = 64;
      vp = vc + i * 64; ldv = 512;
    };
    float m = -1e30f, l = 0.f;
    auto body1 = [&](int i, const u16* Ks, const u16* Vs) {
      const uint32_t vm = range_mask(i * 64, 0, cmax, hh);
      f32x16 s[2];
      qk_tile(Ks, qn, s, rl, hh);
      float mx = -1e30f;
#pragma unroll
      for (int kb = 0; kb < 2; ++kb)
#pragma unroll
        for (int ii = 0; ii < 16; ++ii) {
          float v = s[kb][ii] * SCL2;
          v = ((vm >> (kb * 16 + ii)) & 1u) ? v : -1e30f;
          s[kb][ii] = v;
          mx = fmaxf(mx, v);
        }
      mx = xmax32(mx);
      const float mn = fmaxf(m, mx);
      float rs = 0.f;
#pragma unroll
      for (int kb = 0; kb < 2; ++kb)
#pragma unroll
        for (int ii = 0; ii < 16; ++ii) rs += ((vm >> (kb * 16 + ii)) & 1u) ? fexp2(s[kb][ii] - mn) : 0.f;
      rs = xsum32(rs);
      l = l * fexp2(m - mn) + rs;
      m = mn;
    };
    kv_loop(kvb, nct, tid, tf, body1);
    const float invl = l > 0.f ? 1.f / l : 0.f;
    auto body2 = [&](int i, const u16* Ks, const u16* Vs) {
      const uint32_t vm = range_mask(i * 64, 0, cmax, hh);
      f32x16 s[2];
      qk_tile(Ks, qn, s, rl, hh);
#pragma unroll
      for (int kb = 0; kb < 2; ++kb)
#pragma unroll
        for (int ii = 0; ii < 16; ++ii) s[kb][ii] = ((vm >> (kb * 16 + ii)) & 1u) ? fexp2(__builtin_fmaf(s[kb][ii], SCL2, -m)) * invl : 0.f;
      pv_tile(Vs, s, o, rl, hh);
#pragma unroll
      for (int kb = 0; kb < 2; ++kb)
#pragma unroll
        for (int q4 = 0; q4 < 4; ++q4) {
          float mainv = s[kb][4 * q4] + s[kb][4 * q4 + 1] + s[kb][4 * q4 + 2] + 0.5f * s[kb][4 * q4 + 3];
          float sp = 0.5f * s[kb][4 * q4 + 3];
          mainv = sum8(mainv);
          sp = sum8(sp);
          if (r == 0) {
            const int j = 16 * i + 8 * kb + 2 * q4 + hh;
            impm[tokl * 132 + j] = mainv;
            imps[tokl * 132 + j + 1] = sp;
          }
        }
    };
    kv_loop(kvb, nct, tid, tf, body2);
#pragma unroll
    for (int db = 0; db < 2; ++db)
#pragma unroll
      for (int i = 0; i < 16; ++i) { yacc[db][i] = gt[0] * o[db][i]; o[db][i] = 0.f; }
  }
  __syncthreads();
  {
    const int tk = tid >> 4, jg = tid & 15, blk = (t0 + tk) >> 6;
    float v[8];
#pragma unroll
    for (int e = 0; e < 8; ++e) {
      const int j = jg * 8 + e;
      float x = impm[tk * 132 + j] + imps[tk * 132 + j];
      if (j == 0 || j == blk || j == blk - 1) x = 1e30f;
      if (j > blk) x = -INFINITY;
      v[e] = x;
      vals[tk * 132 + j] = x;
    }
    uint32_t key[8];
#pragma unroll
    for (int e = 0; e < 8; ++e) {
      const uint32_t uu = __float_as_uint(v[e]);
      key[e] = (uu & 0x80000000u) ? ~uu : (uu | 0x80000000u);
    }
    auto rowsum = [](int c) {
      c += __builtin_amdgcn_update_dpp(0, c, 0x128, 0xF, 0xF, true);
      c += __builtin_amdgcn_update_dpp(0, c, 0x124, 0xF, 0xF, true);
      c += __builtin_amdgcn_update_dpp(0, c, 0x122, 0xF, 0xF, true);
      c += __builtin_amdgcn_update_dpp(0, c, 0x121, 0xF, 0xF, true);
      return c;
    };
    uint32_t pfx = 0;
#pragma unroll 1
    for (int b = 31; b >= 0; --b) {
      const uint32_t cand = pfx | (1u << b);
      int c = 0;
#pragma unroll
      for (int e = 0; e < 8; ++e) c += (key[e] >= cand) ? 1 : 0;
      c = rowsum(c);
      if (c >= 16) pfx = cand;
    }
    int cgt = 0, teq = 0;
#pragma unroll
    for (int e = 0; e < 8; ++e) { cgt += (key[e] > pfx) ? 1 : 0; teq += (key[e] == pfx) ? 1 : 0; }
    cgt = rowsum(cgt);
    int tin = teq;
    tin += __builtin_amdgcn_update_dpp(0, tin, 0x111, 0xF, 0xF, true);
    tin += __builtin_amdgcn_update_dpp(0, tin, 0x112, 0xF, 0xF, true);
    tin += __builtin_amdgcn_update_dpp(0, tin, 0x114, 0xF, 0xF, true);
    tin += __builtin_amdgcn_update_dpp(0, tin, 0x118, 0xF, 0xF, true);
    int run = cgt + tin - teq;
    uint32_t bits = 0;
#pragma unroll
    for (int e = 0; e < 8; ++e) {
      const bool eq = key[e] == pfx;
      const bool sel = (key[e] > pfx) || (eq && run < 16);
      run += eq ? 1 : 0;
      bits |= (sel && (jg * 8 + e) <= blk) ? (1u << e) : 0u;
    }
    selb[tk * 16 + jg] = (unsigned char)bits;
    __syncthreads();
    if (tid < 32) {
      const uint32_t* w = (const uint32_t*)(selb + tid * 16);
      atomicOr(&un[0], w[0]); atomicOr(&un[1], w[1]); atomicOr(&un[2], w[2]); atomicOr(&un[3], w[3]);
    }
    __syncthreads();
    if (tid < 128) {
      const uint32_t u0 = un[0], u1 = un[1], u2 = un[2], u3 = un[3];
      const int w = tid >> 5, bpos = tid & 31;
      const uint32_t uw = w == 0 ? u0 : w == 1 ? u1 : w == 2 ? u2 : u3;
      const int below = (w > 0 ? __popc(u0) : 0) + (w > 1 ? __popc(u1) : 0) + (w > 2 ? __popc(u2) : 0);
      if ((uw >> bpos) & 1u) tl[below + __popc(uw & ((1u << bpos) - 1u))] = tid;
      if (tid == 0) un[4] = __popc(u0) + __popc(u1) + __popc(u2) + __popc(u3);
    }
    __syncthreads();
  }
  {
    const int ntl = (int)un[4];
    const u32x4 ms = *(const u32x4*)(selb + tokl * 16);
    const u16* kb_ = u + (long)b * SEQ * IN1P + 1280 + g * 64;
    const u16* vb_ = p->vt + (long)bg * 64 * SEQ;
    auto tf = [&](int i, const u16*& kp, long& ldk, const u16*& vp, long& ldv) {
      const int j = tl[i];
      kp = kb_ + (long)j * 64 * IN1P; ldk = IN1P;
      vp = vb_ + j * 64; ldv = SEQ;
    };
    float m = -1e30f, l = 0.f;
    auto body = [&](int i, const u16* Ks, const u16* Vs) {
      const int j = tl[i];
      const uint32_t w = j < 32 ? ms[0] : j < 64 ? ms[1] : j < 96 ? ms[2] : ms[3];
      uint32_t vm = ((w >> (j & 31)) & 1u) ? range_mask(j * 64, 0, tok, hh) : 0u;
      if (__ballot(vm != 0) != 0ull) {
        f32x16 s[2];
        qk_tile(Ks, qr, s, rl, hh);
        online_softmax(s, vm, m, l, o);
        pv_tile(Vs, s, o, rl, hh);
      }
    };
    {
      const int ng = (ntl + 3) >> 2;
      const int row = tid >> 3, seg = tid & 7;
      u32x4 kr[4], vr[4];
      auto issue = [&](int g4) {
#pragma unroll
        for (int t = 0; t < 4; ++t) {
          const int idx = g4 * 4 + t;
          if (idx < ntl) {
            const int j = tl[idx];
            kr[t] = *(const u32x4*)(kb_ + ((long)j * 64 + row) * IN1P + seg * 8);
            vr[t] = *(const u32x4*)(vb_ + (long)row * SEQ + j * 64 + seg * 8);
          }
        }
      };
      auto wr = [&](int g4, int buf) {
#pragma unroll
        for (int t = 0; t < 4; ++t) {
          if (g4 * 4 + t < ntl) {
            u16* kd = kvb + (buf * 4 + t) * 2 * KVT;
            *(u32x4*)(kd + row * KVS + seg * 8) = kr[t];
            *(u32x4*)(kd + KVT + row * KVS + seg * 8) = vr[t];
          }
        }
      };
      __syncthreads();
      issue(0);
      wr(0, 0);
      __syncthreads();
#pragma unroll 1
      for (int g4 = 0; g4 < ng; ++g4) {
        if (g4 + 1 < ng) issue(g4 + 1);
#pragma unroll 1
        for (int t = 0; t < 4; ++t) {
          const int idx = g4 * 4 + t;
          if (idx < ntl) {
            const u16* kd = kvb + ((g4 & 1) * 4 + t) * 2 * KVT;
            body(idx, kd, kd + KVT);
          }
        }
        if (g4 + 1 < ng) wr(g4 + 1, (g4 + 1) & 1);
        __syncthreads();
      }
    }
    const float sc = gt[1] / l;
#pragma unroll
    for (int db = 0; db < 2; ++db)
#pragma unroll
      for (int i = 0; i < 16; ++i) { yacc[db][i] += sc * o[db][i]; o[db][i] = 0.f; }
  }
  {
    const int jlo = (t0 > 511 ? t0 - 511 : 0) >> 6, jhi = (t0 + 31) >> 6;
    const u16* kb_ = u + (long)b * SEQ * IN1P + 1536 + g * 64;
    const u16* vb_ = p->vt + (long)(8 + bg) * 64 * SEQ;
    auto tf = [&](int i, const u16*& kp, long& ldk, const u16*& vp, long& ldv) {
      const int j = jlo + i;
      kp = kb_ + (long)j * 64 * IN1P; ldk = IN1P;
      vp = vb_ + j * 64; ldv = SEQ;
    };
    float m = -1e30f, l = 0.f;
    auto body = [&](int i, const u16* Ks, const u16* Vs) {
      const int j = jlo + i;
      const uint32_t vm = range_mask(j * 64, tok - 511, tok, hh);
      if (__ballot(vm != 0) != 0ull) {
        f32x16 s[2];
        qk_tile(Ks, qr, s, rl, hh);
        online_softmax(s, vm, m, l, o);
        pv_tile(Vs, s, o, rl, hh);
      }
    };
    kv_loop(kvb, jhi - jlo + 1, tid, tf, body);
    const float sc = gt[2] / l;
#pragma unroll
    for (int db = 0; db < 2; ++db)
#pragma unroll
      for (int i = 0; i < 16; ++i) yacc[db][i] += sc * o[db][i];
  }
  store_o(p->h + ((long)b * SEQ + tok) * DM + hq * 64, yacc, 1.f, hh);
}

DI void local_barrier(unsigned* ctr, unsigned target, int ws) {
  asm volatile("s_waitcnt vmcnt(0)" ::: "memory");
  __syncthreads();
  if (ws == 0 && lane_id_() == 0) {
    __hip_atomic_fetch_add(ctr, 1u, __ATOMIC_RELAXED, __HIP_MEMORY_SCOPE_AGENT);
    unsigned sp = 0;
    while (__hip_atomic_load(ctr, __ATOMIC_RELAXED, __HIP_MEMORY_SCOPE_AGENT) < target) {
      __builtin_amdgcn_s_sleep(1);
      if (++sp > (1u << 22)) break;
    }
    __builtin_amdgcn_fence(__ATOMIC_ACQUIRE, "agent");
    asm volatile("s_waitcnt vmcnt(0)" ::: "memory");
  }
  __syncthreads();
}

DI void phase_signal(unsigned* ctr, int ws) {
  asm volatile("s_waitcnt vmcnt(0)" ::: "memory");
  __syncthreads();
  if (ws == 0 && lane_id_() == 0) {
    __builtin_amdgcn_fence(__ATOMIC_RELEASE, "agent");
    asm volatile("s_waitcnt vmcnt(0)" ::: "memory");
    __hip_atomic_fetch_add(ctr, 1u, __ATOMIC_RELAXED, __HIP_MEMORY_SCOPE_AGENT);
  }
}
DI void phase_wait(unsigned* ctr, unsigned target, int ws) {
  if (ws == 0 && lane_id_() == 0) {
    unsigned sp = 0;
    while (__hip_atomic_load(ctr, __ATOMIC_RELAXED, __HIP_MEMORY_SCOPE_AGENT) < target) {
      __builtin_amdgcn_s_sleep(1);
      if (++sp > (1u << 22)) break;
    }
    __builtin_amdgcn_fence(__ATOMIC_ACQUIRE, "agent");
    asm volatile("s_waitcnt vmcnt(0)" ::: "memory");
  }
  __syncthreads();
}

__global__ void __launch_bounds__(NTHR) fwd_kernel(Params pk) {
  __shared__ __attribute__((aligned(1024))) char shm[151552];
  cg::grid_group grid = cg::this_grid();
  const PP p0 = (PP)__builtin_amdgcn_kernarg_segment_ptr();
  const int ws = __builtin_amdgcn_readfirstlane(threadIdx.x >> 6);
  prep_phase(ws, launder_p(p0), shm);
  grid.sync();
  int gx = blockIdx.x & 7, gslot = blockIdx.x >> 3;
  bool loc = false;
  unsigned lep = 0;
  {
    int* cs_ = (int*)(shm + 150024);
    if (ws == 0 && lane_id_() == 0) {
      const unsigned xcc = (unsigned)__builtin_amdgcn_s_getreg((3 << 11) | 20) & 0xFu;
      cs_[0] = (int)xcc;
      cs_[1] = (int)__hip_atomic_fetch_add(p0->xcnt + xcc, 1u, __ATOMIC_RELAXED, __HIP_MEMORY_SCOPE_AGENT);
      unsigned sp = 0, sum = 0;
      bool ok = false;
      for (;;) {
        sum = 0;
        ok = true;
        for (int j = 0; j < 16; ++j) {
          const unsigned c = __hip_atomic_load(p0->xcnt + j, __ATOMIC_RELAXED, __HIP_MEMORY_SCOPE_AGENT);
          sum += c;
          if (j < 8 ? (c != 32u) : (c != 0u)) ok = false;
        }
        if (sum == gridDim.x || ++sp > (1u << 20)) break;
        __builtin_amdgcn_s_sleep(1);
      }
      cs_[2] = (ok && sum == gridDim.x && gridDim.x == 256) ? 1 : 0;
    }
    __syncthreads();
    if (cs_[2]) { gx = cs_[0]; gslot = cs_[1]; loc = true; }
    __syncthreads();
  }
  auto seam = [&]() {
    if (loc) { ++lep; local_barrier(p0->lbar + gx * 64, lep * (gridDim.x >> 3), ws); }
    else grid.sync();
  };
  auto half = [&](const int l, const int s) __attribute__((always_inline)) {
    {
      PP p = launder_p(p0);
      const float* modl = p->mod + (long)l * 4 * 9216;
      const float* xin = (l == 0 && s == 0) ? p->x : p->out;
      norm_phase(ws, gx, gslot, xin, p->h, p->norm_g + (l * 3 + (s == 0 ? 0 : 2)) * DM, modl + (s == 0 ? 0 : 6) * DM, modl + (s == 0 ? 1 : 7) * DM);
      seam();
      p = launder_p(p0);
      {
        const u16* W = p->wt1 + (long)(l * 2 + s) * 5632 * 1024;
        u16* act = p->big;
        auto desc = [&](int pm, int pn) { return TileDesc{p->h + (long)pm * 256 * DM, DM, 64, W + (long)pn * 256 * DM, DM, DM / 64}; };
        auto epi = [&](int pm, int pn, Acc8& acc, int wr, int wc, int fr, int fq) {
#pragma unroll
          for (int ai = 0; ai < 2; ++ai)
#pragma unroll
            for (int bj = 0; bj < 2; ++bj)
#pragma unroll
              for (int m = 0; m < 4; ++m)
                {
                  float v[4];
#pragma unroll
                  for (int j = 0; j < 4; ++j) {
                    float a = acc[ai][bj][m][0][j], b = acc[ai][bj][m][1][j];
                    v[j] = a * __builtin_amdgcn_rcpf(1.f + __expf(-a)) * b;
                  }
                  const long row0 = (long)pm * 256 + ai * 128 + wr * 64 + m * 16 + fq * 4;
                  const int cole = pn * 128 + (bj * 4 + wc) * 16 + (fr & ~1);
                  store_pair_bf16(act + row0 * DFF + cole, DFF, fr & 1, v[0], v[1], v[2], v[3]);
                }
        };
        gemm_phase(ws, gx, gslot, shm, NT / 256, 5632 / 256, desc, epi);
      }
      seam();
      p = launder_p(p0);
      modl = p->mod + (long)l * 4 * 9216;
      xin = (l == 0 && s == 0) ? p->x : p->out;
      {
        const u16* W = p->wt2 + (long)(l * 2 + s) * 1024 * DFF;
        const float* gate = modl + (s == 0 ? 2 : 8) * DM;
        float* xo = p->out;
        auto desc = [&](int pm, int pn) { return TileDesc{p->big + (long)pm * 256 * DFF, DFF, 64, W + (long)pn * 256 * DFF, DFF, DFF / 64}; };
        auto epi = [&](int pm, int pn, Acc8& acc, int wr, int wc, int fr, int fq) {
          const int b = (pm * 256) >> 13;
#pragma unroll
          for (int bj = 0; bj < 2; ++bj)
#pragma unroll
            for (int n = 0; n < 2; ++n) {
              const int col = pn * 256 + bj * 128 + wc * 32 + n * 16 + fr;
              const float gv = 0.5f * gate[(long)b * 9216 + col];
#pragma unroll
              for (int ai = 0; ai < 2; ++ai)
#pragma unroll
                for (int m = 0; m < 4; ++m) {
                  const long row0 = (long)pm * 256 + ai * 128 + wr * 64 + m * 16 + fq * 4;
                  const f32x4 a = acc[ai][bj][m][n];
                  rmw_pair_f32(xo + row0 * DM + (col & ~1), xin + row0 * DM + (col & ~1), DM, col & 1, gv * a[0], gv * a[1], gv * a[2], gv * a[3]);
                  asm volatile("" ::: "memory");
                }
            }
        };
        gemm_phase(ws, gx, gslot, shm, NT / 256, DM / 256, desc, epi);
      }
      seam();
      if (s == 0) {
        p = launder_p(p0);
        modl = p->mod + (long)l * 4 * 9216;
        norm_phase(ws, gx, gslot, p->out, p->h, p->norm_g + (l * 3 + 1) * DM, modl + 3 * DM, modl + 4 * DM);
        seam();
        if (l == 0) {
          p = launder_p(p0);
          {
            u16* uu = p->big;
            u16* vt = p->vt;
            auto desc = [&](int pm, int pn) { return TileDesc{p->h + (long)pm * 256 * DM, DM, 64, p->wtin0 + (long)pn * 256 * DM, DM, DM / 64}; };
            auto epi = [&](int pm, int pn, Acc8& acc, int wr, int wc, int fr, int fq) {
#pragma unroll
              for (int ai = 0; ai < 2; ++ai)
#pragma unroll
                for (int bj = 0; bj < 2; ++bj)
#pragma unroll
                  for (int m = 0; m < 4; ++m)
#pragma unroll
                    for (int n = 0; n < 2; ++n) {
                      const int col = pn * 256 + bj * 128 + wc * 32 + n * 16 + fr;
                      const long row0 = (long)pm * 256 + ai * 128 + wr * 64 + m * 16 + fq * 4;
                      const f32x4 v = acc[ai][bj][m][n];
                      if (col >= 2048) {
                        const int vc = col - 2048, bb = (int)(row0 >> 13), t = (int)(row0 & 8191);
                        u32x2 pk = {pack2(v[0], v[1]), pack2(v[2], v[3])};
                        wt64(vt + ((long)(bb * 8 + (vc >> 6)) * 64 + (vc & 63)) * SEQ + t, pk);
                      } else {
                        store_pair_bf16(uu + row0 * IN0 + (col & ~1), IN0, col & 1, v[0], v[1], v[2], v[3]);
                      }
                    }
            };
            gemm_phase(ws, gx, gslot, shm, NT / 256, IN0 / 256, desc, epi);
          }
          grid.sync();
          p = launder_p(p0);
          kprep0_phase(ws, p, shm);
          phase_signal(p0->ctr + 16, ws);
          p = launder_p(p0);
#pragma unroll 1
          for (int it = grab(ws, p->ctr + 0, shm); it < 512;) {
            const int nx_ = grab_begin(ws, p->ctr + 0);
            lru_item<false>(ws, p, shm, it);
            it = grab_end(ws, nx_, shm);
          }
          phase_signal(p0->ctr + 17, ws);
          phase_wait(p0->ctr + 16, gridDim.x, ws);
          p = launder_p(p0);
#pragma unroll 1
          for (int it = grab(ws, p->ctr + 1, shm); it < 1024;) {
            const int nx_ = grab_begin(ws, p->ctr + 1);
            moba_gate_item(ws, p, shm, it);
            it = grab_end(ws, nx_, shm);
          }
          phase_signal(p0->ctr + 18, ws);
          phase_wait(p0->ctr + 17, gridDim.x, ws);
          p = launder_p(p0);
#pragma unroll 1
          for (int it = grab(ws, p->ctr + 3, shm); it < 512;) {
            const int nx_ = grab_begin(ws, p->ctr + 3);
            lru_item<true>(ws, p, shm, it);
            it = grab_end(ws, nx_, shm);
          }
          phase_wait(p0->ctr + 18, gridDim.x, ws);
          p = launder_p(p0);
          moba_gather_phase(ws, p, shm);
          phase_signal(p0->ctr + 19, ws);
          phase_wait(p0->ctr + 19, gridDim.x, ws);
          p = launder_p(p0);
#pragma unroll 1
          for (int it = grab(ws, p->ctr + 4, shm); it < 1024;) {
            const int nx_ = grab_begin(ws, p->ctr + 4);
            moba_own_item(ws, p, shm, it);
            it = grab_end(ws, nx_, shm);
          }
          grid.sync();
        }
        if (l == 1) {
          p = launder_p(p0);
          {
            u16* uu = p->big;
            u16* vt = p->vt;
            auto desc = [&](int pm, int pn) { return TileDesc{p->h + (long)pm * 256 * DM, DM, 64, p->wtin1 + (long)pn * 256 * DM, DM, DM / 64}; };
            auto epi = [&](int pm, int pn, Acc8& acc, int wr, int wc, int fr, int fq) {
#pragma unroll
              for (int ai = 0; ai < 2; ++ai)
#pragma unroll
                for (int bj = 0; bj < 2; ++bj) {
                  const int c64 = (pn * 256 + bj * 128 + wc * 32) >> 6;
                  const bool isv = (c64 == 22 || c64 == 23 || c64 == 26 || c64 == 27);
#pragma unroll
                  for (int m = 0; m < 4; ++m)
#pragma unroll
                    for (int n = 0; n < 2; ++n) {
                      const int col = pn * 256 + bj * 128 + wc * 32 + n * 16 + fr;
                      const long row0 = (long)pm * 256 + ai * 128 + wr * 64 + m * 16 + fq * 4;
                      const f32x4 v = acc[ai][bj][m][n];
                      if (isv) {
                        const int bb = (int)(row0 >> 13), t = (int)(row0 & 8191);
                        const int which = c64 >= 26 ? 1 : 0, gg = c64 & 1;
                        u32x2 pk = {pack2(v[0], v[1]), pack2(v[2], v[3])};
                        wt64(vt + ((long)(which * 8 + bb * 2 + gg) * 64 + (col & 63)) * SEQ + t, pk);
                      } else if (col < IN1) {
                        store_pair_bf16(uu + row0 * IN1P + (col & ~1), IN1P, col & 1, v[0], v[1], v[2], v[3]);
                      }
                    }
                }
            };
            gemm_phase(ws, gx, gslot, shm, NT / 256, IN1P / 256, desc, epi);
          }
          grid.sync();
          p = launder_p(p0);
          rope1_phase(ws, p);
          p = launder_p(p0);
          {
            float* pq = p->pq;
            auto desc = [&](int pm, int pn) {
              const int kv = pm >> 4, rr = pm & 15, bg = rr >> 1, j0 = (rr & 1) * 256;
              return TileDesc{p->big + ((long)(bg >> 1) * SEQ + 16 * j0) * IN1P + 1024 + kv * 128 + (bg & 1) * 64, 16 * IN1P, IN1P,
                              p->wtcmp + (long)kv * 256 * 1024, 1024, 16};
            };
            auto epi = [&](int pm, int pn, Acc8& acc, int wr, int wc, int fr, int fq) {
#pragma unroll
              for (int ai = 0; ai < 2; ++ai)
#pragma unroll
                for (int bj = 0; bj < 2; ++bj)
#pragma unroll
                  for (int m = 0; m < 4; ++m)
#pragma unroll
                    for (int n = 0; n < 2; ++n)
#pragma unroll
                      for (int j = 0; j < 4; ++j)
                        wt32f(pq + ((long)pm * 256 + ai * 128 + wr * 64 + m * 16 + fq * 4 + j) * 256 + bj * 128 + wc * 32 + n * 16 + fr, acc[ai][bj][m][n][j]);
            };
            gemm_phase(ws, gx, gslot, shm, 32, 1, desc, epi);
          }
          seam();
          p = launder_p(p0);
          cmpfin_phase(ws, gx, gslot, p, shm);
          grid.sync();
          p = launder_p(p0);
#pragma unroll 1
          for (int it = grab(ws, p->ctr + 5, shm); it < 2048;) {
            const int nx_ = grab_begin(ws, p->ctr + 5);
            nsa_item(ws, p, shm, it);
            it = grab_end(ws, nx_, shm);
          }
          grid.sync();
        }
        {
          p = launder_p(p0);
          modl = p->mod + (long)l * 4 * 9216;
          const u16* W = l == 0 ? p->wtout0 : p->wtout1;
          const float* gate = modl + 5 * DM;
          float* xo = p->out;
          auto desc = [&](int pm, int pn) { return TileDesc{p->h + (long)pm * 256 * DM, DM, 64, W + (long)pn * 256 * DM, DM, DM / 64}; };
          auto epi = [&](int pm, int pn, Acc8& acc, int wr, int wc, int fr, int fq) {
            const int b = (pm * 256) >> 13;
#pragma unroll
            for (int bj = 0; bj < 2; ++bj)
#pragma unroll
              for (int n = 0; n < 2; ++n) {
                const int col = pn * 256 + bj * 128 + wc * 32 + n * 16 + fr;
                const float gv = gate[(long)b * 9216 + col];
#pragma unroll
                for (int ai = 0; ai < 2; ++ai)
#pragma unroll
                  for (int m = 0; m < 4; ++m) {
                    const long row0 = (long)pm * 256 + ai * 128 + wr * 64 + m * 16 + fq * 4;
                    const f32x4 a = acc[ai][bj][m][n];
                    rmw_pair_f32(xo + row0 * DM + (col & ~1), xo + row0 * DM + (col & ~1), DM, col & 1, gv * a[0], gv * a[1], gv * a[2], gv * a[3]);
                    asm volatile("" ::: "memory");
                  }
              }
          };
          gemm_phase(ws, gx, gslot, shm, NT / 256, DM / 256, desc, epi);
          seam();
        }
      }
    }
  };
  half(0, 0);
  half(0, 1);
  half(1, 0);
  half(1, 1);
  { PP p = launder_p(p0); final_norm_phase(ws, gx, gslot, p->out, p->fng); }
}

extern "C" void kernel_launch(void* const* d_in, const int* in_sizes, int n_in, void* d_out, int out_size, void* d_ws, size_t ws_size,
                              hipStream_t stream) {
  Params p;
  memset(&p, 0, sizeof(p));
  const float** fp = (const float**)&p.x;
  for (int i = 0; i < 22; ++i) fp[i] = (const float*)d_in[i];
  p.out = (float*)d_out;
  char* ws = (char*)d_ws;
  size_t off = 0;
  auto take = [&](size_t bytes) { char* r = ws + off; off += (bytes + 255) & ~(size_t)255; return r; };
  p.wt1 = (u16*)take((size_t)4 * 5632 * 1024 * 2);
  p.wt2 = (u16*)take((size_t)4 * 1024 * DFF * 2);
  p.wtin0 = (u16*)take((size_t)IN0 * 1024 * 2);
  p.wtout0 = (u16*)take((size_t)1024 * 1024 * 2);
  p.wtin1 = (u16*)take((size_t)IN1P * 1024 * 2);
  p.wtout1 = (u16*)take((size_t)1024 * 1024 * 2);
  p.wtcmp = (u16*)take((size_t)2 * 256 * 1024 * 2);
  p.wat = (u16*)take((size_t)2 * 8 * 64 * 64 * 2);
  p.mod = (float*)take((size_t)2 * 4 * 9216 * 4);
  p.rope = (float*)take((size_t)SEQ * 16 * 4);
  p.cvec = (float*)take(2 * 128 * 4);
  p.cent = (float*)take((size_t)4 * 8 * 32 * 64 * 4);
  p.lrusum = (float*)take((size_t)4 * 128 * 512 * 2 * 4);
  p.pq = (float*)take((size_t)2 * 4096 * 256 * 4);
  p.h = (u16*)take((size_t)NT * 1024 * 2);
  p.big = (u16*)take((size_t)NT * DFF * 2);
  p.vt = (u16*)take((size_t)NT * 512 * 2);
  p.kcmp = (u16*)take((size_t)8 * 512 * 64 * 2);
  p.vcmpT = (u16*)take((size_t)8 * 512 * 64 * 2);
  p.mcnt = (unsigned*)take(1024 * 4);
  p.ctr = (unsigned*)take(64 * 4);
  p.xcnt = (unsigned*)take(64 * 4);
  p.lbar = (unsigned*)take(8 * 64 * 4);
  p.mlist = (unsigned*)take((size_t)32 * 126976 * 4);
  p.part = (u16*)take((size_t)NT * 8 * 3 * 144);
  int nj = 0, t0 = 0;
  auto add = [&](const float* src, u16* dst, int K, int N, int ldn, int perm, int npad) {
    TJob& j = p.jobs[nj++];
    j.src = src; j.dst = dst; j.K = K; j.N = N; j.ldn = ldn; j.perm = perm; j.tile0 = t0; j.ntn = npad / 64;
    t0 += (K / 64) * ((npad / 64 + 3) / 4);
  };
  for (int i = 0; i < 4; ++i) add(p.ffn_w1 + (size_t)i * 1024 * 5632, p.wt1 + (size_t)i * 5632 * 1024, 1024, 5632, 5632, 1, 5632);
  for (int i = 0; i < 4; ++i) add(p.ffn_w2 + (size_t)i * DFF * 1024, p.wt2 + (size_t)i * 1024 * DFF, DFF, 1024, 1024, 0, 1024);
  add(p.mix0_in_w, p.wtin0, 1024, IN0, IN0, 0, IN0);
  add(p.mix0_out_w, p.wtout0, 1024, 1024, 1024, 0, 1024);
  add(p.mix1_in_w, p.wtin1, 1024, IN1, IN1, 0, IN1P);
  add(p.mix1_out_w, p.wtout1, 1024, 1024, 1024, 0, 1024);
  for (int kv = 0; kv < 2; ++kv)
    for (int hf = 0; hf < 2; ++hf)
      add(p.cmp_w1 + ((size_t)kv * 2048 + hf * 1024) * 128, p.wtcmp + ((size_t)kv * 256 + hf * 128) * 1024, 1024, 128, 128, 0, 128);
  for (int n = 0; n < 8; ++n) add(p.wa + (size_t)n * 4096, p.wat + (size_t)n * 4096, 64, 64, 64, 0, 64);
  for (int n = 0; n < 8; ++n) add(p.wx + (size_t)n * 4096, p.wat + (size_t)(8 + n) * 4096, 64, 64, 64, 0, 64);
  p.njobs = nj;
  p.ntr_tiles = t0;

  static int grid_blocks = 0;
  if (!grid_blocks) {
    int dev = 0, cus = 0, per_cu = 0;
    (void)hipGetDevice(&dev);
    (void)hipDeviceGetAttribute(&cus, hipDeviceAttributeMultiprocessorCount, dev);
    (void)hipOccupancyMaxActiveBlocksPerMultiprocessor(&per_cu, fwd_kernel, NTHR, 0);
    if (per_cu < 1) per_cu = 1;
    grid_blocks = cus * 1;
  }
  void* args[] = {&p};
  hipError_t e = hipLaunchCooperativeKernel((void*)fwd_kernel, dim3(grid_blocks), dim3(NTHR), args, 0, stream);
  if (e != hipSuccess) fprintf(stderr, "cooperative launch failed: %s (grid %d)\n", hipGetErrorString(e), grid_blocks);
}
```
